# Optimizing an MI355X kernel written in HIP

```python
import math
import jax, jax.numpy as jnp
from jax import lax
import numpy as np

D_MODEL = 1024
BATCH = 32
SEQ = 2048
DEPTH = 1
DEC_BATCH = 8
DEC_SEQ = 64
PAST_LEN = 4096

CHUNK = 64
N_MOD = 9
D_FF = 2816
GMLP_CHUNK = 128
D_A = D_MODEL
GMLP_GROUPS = 8
GMLP_GROUP_DIM = D_A // GMLP_GROUPS
MLA_HEADS = 8
QK_NOPE = 64
QK_ROPE = 32
QK_HEAD = QK_NOPE + QK_ROPE
V_HEAD = 64
D_B = MLA_HEADS * V_HEAD
Q_RANK = 384
KV_RANK = 256
ROPE_THETA = 10000.0
Q_BLOCK = 128
EPS = 1e-6
NEG = -1e30
IN_SPLITS = (D_A, D_A, Q_RANK, KV_RANK, QK_ROPE, 2 * D_MODEL)
N_IN = 2 * D_A + Q_RANK + KV_RANK + QK_ROPE + 2 * D_MODEL

kernel_name = 'hybrid_gmlp_mla_macaron_streaming_step'


def rms_norm(x, g):
    x32 = x.astype(jnp.float32)
    y = x32 * lax.rsqrt(jnp.mean(x32 * x32, axis=-1, keepdims=True) + EPS)
    return (y * g.astype(jnp.float32)).astype(x.dtype)


def modulate(x, g, shift, scale):
    return rms_norm(x, g) * (1 + scale) + shift


def rope(x, pos):
    half = x.shape[-1] // 2
    freqs = ROPE_THETA ** (-jnp.arange(half, dtype=jnp.float32) / half)
    ang = pos[:, None] * freqs[None, :]
    cos = jnp.cos(ang)[None, :, None, :]
    sin = jnp.sin(ang)[None, :, None, :]
    x32 = x.astype(jnp.float32)
    x1, x2 = x32[..., :half], x32[..., half:]
    return jnp.concatenate([x1 * cos - x2 * sin, x1 * sin + x2 * cos], axis=-1).astype(x.dtype)


def split_cols(z, sizes):
    parts = []
    o = 0
    for s in sizes:
        parts.append(z[..., o:o + s])
        o += s
    return parts


def swiglu(h, w_up, w_down):
    gu = h @ w_up
    return (jax.nn.silu(gu[..., :D_FF]) * gu[..., D_FF:]) @ w_down


def gmlp_branch(z_u, z_v, g_v, ws, b):
    u = jax.nn.gelu(z_u)
    v = rms_norm(jax.nn.gelu(z_v), g_v)
    B, T, _ = v.shape
    L = min(T, GMLP_CHUNK)
    n = T // L
    mask = jnp.tril(jnp.ones((L, L), dtype=bool))
    w = jnp.where(mask[None], ws[:, :L, :L], 0).astype(v.dtype)
    vg = v.reshape(B, n, L, GMLP_GROUPS, GMLP_GROUP_DIM)
    mixed = jnp.einsum('gts,bnsgc->bntgc', w, vg) + b[:, :L].T[None, None, :, :, None]
    return u * mixed.reshape(B, T, D_A), v


def mla_queries(z_q, pos, p):
    B, T, _ = z_q.shape
    q = (rms_norm(z_q, p['g_q_lat']) @ p['w_uq']).reshape(B, T, MLA_HEADS, QK_HEAD)
    q = jnp.concatenate([q[..., :QK_NOPE], rope(q[..., QK_NOPE:], pos)], axis=-1)
    return rms_norm(q, p['g_qnorm'])


def mla_keys_values(ckv, krope, p):
    B, T, _ = ckv.shape
    k_nope = jnp.einsum('btr,rhd->bthd', ckv, p['w_uk'].reshape(KV_RANK, MLA_HEADS, QK_NOPE))
    k_rope = jnp.broadcast_to(krope[:, :, None, :], (B, T, MLA_HEADS, QK_ROPE))
    k = rms_norm(jnp.concatenate([k_nope, k_rope], axis=-1), p['g_knorm'])
    v = jnp.einsum('btr,rhd->bthd', ckv, p['w_uv'].reshape(KV_RANK, MLA_HEADS, V_HEAD))
    return k, v


def attend_block_causal(q, k, v):
    B, T, H, _ = q.shape
    nq = T // Q_BLOCK
    scale = QK_HEAD ** -0.5
    qb = q.reshape(B, nq, Q_BLOCK, H, QK_HEAD).transpose(1, 0, 2, 3, 4)
    kchunk = jnp.arange(T) // CHUNK
    qchunk = kchunk.reshape(nq, Q_BLOCK)

    def block(args):
        qi, qc = args
        s = jnp.einsum('bqhd,bkhd->bhqk', qi, k, preferred_element_type=jnp.float32) * scale
        s = jnp.where(kchunk[None, None, None, :] <= qc[None, None, :, None], s, NEG)
        pr = jax.nn.softmax(s, axis=-1).astype(v.dtype)
        return jnp.einsum('bhqk,bkhd->bqhd', pr, v)

    o = lax.map(block, (qb, qchunk))
    return o.transpose(1, 0, 2, 3, 4).reshape(B, T, H * V_HEAD)


def attend_all(q, k, v):
    B, T, H, _ = q.shape
    s = jnp.einsum('bqhd,bkhd->bhqk', q, k, preferred_element_type=jnp.float32) * (QK_HEAD ** -0.5)
    pr = jax.nn.softmax(s, axis=-1).astype(v.dtype)
    return jnp.einsum('bhqk,bkhd->bqhd', pr, v).reshape(B, T, H * V_HEAD)


def layer(x, c, pos, past_ckv, past_krope, p):
    B, T, _ = x.shape
    m = (jax.nn.silu(c) @ p['w_mod'] + p['b_mod']).reshape(B, N_MOD, D_MODEL)[:, :, None, :]
    sh1, sc1, gt1, sh2, sc2, gt2, sh3, sc3, gt3 = [m[:, i] for i in range(N_MOD)]
    x = x + 0.5 * gt1 * swiglu(modulate(x, p['g_ffn1'], sh1, sc1), p['w_ffn1_up'], p['w_ffn1_down'])
    h = modulate(x, p['g_mix'], sh2, sc2)
    z = h @ p['w_in']
    z_u, z_v, z_q, z_kv, z_kr, z_g = split_cols(z, IN_SPLITS)
    o_a, v_a = gmlp_branch(z_u, z_v, p['g_gmlp_v'], p['gmlp_ws'], p['gmlp_b'])
    q = mla_queries(z_q, pos, p)
    ckv = rms_norm(z_kv, p['g_kv_lat'])
    krope = rope(z_kr[:, :, None, :], pos)[:, :, 0, :]
    if past_ckv is None:
        k, v = mla_keys_values(ckv, krope, p)
        o_b = attend_block_causal(q, k, v)
    else:
        k, v = mla_keys_values(jnp.concatenate([past_ckv, ckv], axis=1),
                               jnp.concatenate([past_krope, krope], axis=1), p)
        o_b = attend_all(q, k, v)
    gates = jax.nn.sigmoid(z_g + p['b_gate'])
    merged = gates[..., :D_MODEL] * (o_a @ p['w_branch_a']) + gates[..., D_MODEL:] * (o_b @ p['w_branch_b'])
    x = x + gt2 * (merged @ p['w_out'])
    x = x + 0.5 * gt3 * swiglu(modulate(x, p['g_ffn2'], sh3, sc3), p['w_ffn2_up'], p['w_ffn2_down'])
    return x, ckv, krope, v_a


def setup_inputs(seed: int = 0) -> dict:
    key = jax.random.key(seed)
    ks = jax.random.split(key, 32)

    def nrm(i, shape, scale):
        return jax.random.normal(ks[i], shape, jnp.float32) * scale

    def w(i, fan_in, fan_out, mult=1.0):
        return nrm(i, (DEPTH, fan_in, fan_out), mult * fan_in ** -0.5)

    def gain(i, n):
        return 1.0 + nrm(i, (DEPTH, n), 0.02)

    return {
        'x_prompt': nrm(0, (BATCH, SEQ, D_MODEL), 1.0),
        'x_sample': nrm(1, (DEC_BATCH, DEC_SEQ, D_MODEL), 1.0),
        'c_prompt': nrm(2, (BATCH, D_MODEL), 1.0),
        'c_sample': nrm(3, (DEC_BATCH, D_MODEL), 1.0),
        'cache_ckv': nrm(4, (DEPTH, DEC_BATCH, PAST_LEN, KV_RANK), 1.0),
        'cache_krope': nrm(5, (DEPTH, DEC_BATCH, PAST_LEN, QK_ROPE), 1.0),
        'w_mod': w(6, D_MODEL, N_MOD * D_MODEL, 0.5),
        'b_mod': nrm(7, (DEPTH, N_MOD * D_MODEL), 0.01),
        'g_ffn1': gain(8, D_MODEL),
        'w_ffn1_up': w(9, D_MODEL, 2 * D_FF),
        'w_ffn1_down': w(10, D_FF, D_MODEL),
        'g_mix': gain(11, D_MODEL),
        'w_in': w(12, D_MODEL, N_IN),
        'g_gmlp_v': gain(13, D_A),
        'gmlp_ws': nrm(14, (DEPTH, GMLP_GROUPS, GMLP_CHUNK, GMLP_CHUNK), GMLP_CHUNK ** -0.5),
        'gmlp_b': 1.0 + nrm(15, (DEPTH, GMLP_GROUPS, GMLP_CHUNK), 0.02),
        'g_q_lat': gain(16, Q_RANK),
        'w_uq': w(17, Q_RANK, MLA_HEADS * QK_HEAD),
        'g_kv_lat': gain(18, KV_RANK),
        'w_uk': w(19, KV_RANK, MLA_HEADS * QK_NOPE),
        'w_uv': w(20, KV_RANK, MLA_HEADS * V_HEAD),
        'g_qnorm': gain(21, QK_HEAD),
        'g_knorm': gain(22, QK_HEAD),
        'b_gate': nrm(23, (DEPTH, 2 * D_MODEL), 0.01),
        'w_branch_a': w(24, D_A, D_MODEL),
        'w_branch_b': w(25, D_B, D_MODEL),
        'w_out': w(26, D_MODEL, D_MODEL),
        'g_ffn2': gain(27, D_MODEL),
        'w_ffn2_up': w(28, D_MODEL, 2 * D_FF),
        'w_ffn2_down': w(29, D_FF, D_MODEL),
    }


def reference(x_prompt, x_sample, c_prompt, c_sample, cache_ckv, cache_krope,
              w_mod, b_mod, g_ffn1, w_ffn1_up, w_ffn1_down, g_mix, w_in, g_gmlp_v, gmlp_ws, gmlp_b,
              g_q_lat, w_uq, g_kv_lat, w_uk, w_uv, g_qnorm, g_knorm, b_gate, w_branch_a, w_branch_b,
              w_out, g_ffn2, w_ffn2_up, w_ffn2_down):
    t_p = x_prompt.shape[1]
    t_s = x_sample.shape[1]
    past = cache_ckv.shape[2]
    pos_p = jnp.arange(t_p, dtype=jnp.float32)
    pos_s = jnp.arange(t_s, dtype=jnp.float32) + jnp.float32(past)
    xp, xs = x_prompt, x_sample
    ckv_p_l, kr_p_l, ckv_s_l, kr_s_l, vg_s_l = [], [], [], [], []
    for l in range(DEPTH):
        lp = {
            'w_mod': w_mod[l], 'b_mod': b_mod[l], 'g_ffn1': g_ffn1[l], 'w_ffn1_up': w_ffn1_up[l],
            'w_ffn1_down': w_ffn1_down[l], 'g_mix': g_mix[l], 'w_in': w_in[l], 'g_gmlp_v': g_gmlp_v[l],
            'gmlp_ws': gmlp_ws[l], 'gmlp_b': gmlp_b[l], 'g_q_lat': g_q_lat[l], 'w_uq': w_uq[l],
            'g_kv_lat': g_kv_lat[l], 'w_uk': w_uk[l], 'w_uv': w_uv[l], 'g_qnorm': g_qnorm[l],
            'g_knorm': g_knorm[l], 'b_gate': b_gate[l], 'w_branch_a': w_branch_a[l],
            'w_branch_b': w_branch_b[l], 'w_out': w_out[l], 'g_ffn2': g_ffn2[l],
            'w_ffn2_up': w_ffn2_up[l], 'w_ffn2_down': w_ffn2_down[l],
        }
        xp, ckv_p, kr_p, _ = layer(xp, c_prompt, pos_p, None, None, lp)
        xs, ckv_s, kr_s, vg_s = layer(xs, c_sample, pos_s, cache_ckv[l], cache_krope[l], lp)
        ckv_p_l.append(ckv_p)
        kr_p_l.append(kr_p)
        ckv_s_l.append(ckv_s)
        kr_s_l.append(kr_s)
        vg_s_l.append(vg_s)
    new_ckv_prompt = jnp.stack(ckv_p_l, axis=0)
    new_krope_prompt = jnp.stack(kr_p_l, axis=0)
    new_ckv_sample = jnp.stack(ckv_s_l, axis=0)
    new_krope_sample = jnp.stack(kr_s_l, axis=0)
    new_gmlp_v_sample = jnp.stack(vg_s_l, axis=0)
    return (xp, xs, new_ckv_prompt, new_krope_prompt, new_ckv_sample, new_krope_sample, new_gmlp_v_sample)
```

```cpp
#include <hip/hip_runtime.h>
#include <hip/hip_cooperative_groups.h>
#include <cstdio>
#include <cstdint>
namespace cg = cooperative_groups;

namespace pg8 {
#define PG8_LAS __attribute__((address_space(3)))
typedef unsigned short bf16_t;
typedef short bf16x8 __attribute__((ext_vector_type(8)));
typedef float f32x4 __attribute__((ext_vector_type(4)));
typedef unsigned u32x4 __attribute__((ext_vector_type(4)));
constexpr int BM = 256, BK = 64, HALF = 128, HTB = HALF * BK * 2  , STAGE_BYTES = 8 * HTB, NXCD = 8, WGM = 8;

__host__ __device__ __forceinline__ int lds_byte(int r, int c) { const int st = (r >> 4) * 2 + (c >> 5), rr = r & 15, cc = c & 31, ob = rr * 64 + cc * 2; return st * 1024 + (ob ^ (((ob >> 9) & 1) << 5)); }
__host__ __device__ __forceinline__ void stage_rc(int b, int& R, int& C) { const int st = b / 1024, sb = b % 1024, swz = sb ^ (((sb >> 9) & 1) << 5); R = (st >> 1) * 16 + swz / 64; C = (st & 1) * 32 + (swz % 64) / 2; }
__host__ __device__ __forceinline__ int perm32(int rho) { const int n = rho >> 4, i = rho & 15; return 8 * (i >> 2) + 4 * n + (i & 3); }

struct Unit { int pm, pn; };
struct Gemm { const bf16_t* A; const bf16_t* Bt; int M, N, K, lda; };

struct StaticOrder {
    int nM, nN, nwg, G, c;
    __host__ __device__ void init(int M, int N, int G_, int c_) { nM = M / BM; nN = N / BM; nwg = nM * nN; G = G_; c = c_; }
    __host__ __device__ bool next(int i, Unit& u) const {
        const long L = (long)i * G + c; if (L >= nwg) return false;
        int wgid = (int)L; { const int q = nwg / NXCD, r = nwg % NXCD, xcd = wgid % NXCD, off = wgid / NXCD; wgid = (xcd < r ? xcd * (q + 1) : r * (q + 1) + (xcd - r) * q) + off; }
        const int nig = WGM * nN, gid = wgid / nig, fm = gid * WGM, gsz = (nM - fm) < WGM ? (nM - fm) : WGM;
        u.pm = fm + ((wgid % nig) % gsz); u.pn = (wgid % nig) / gsz; return true;
    }
    __device__ __forceinline__ void a_ready(const Unit&) const {}
    __device__ __forceinline__ void done(const Unit&) const {}
};
__device__ __forceinline__ unsigned cvt_pk_bf16(float lo, float hi) { unsigned r; asm volatile("v_cvt_pk_bf16_f32 %0, %1, %2" : "=v"(r) : "v"(lo), "v"(hi)); return r; }

template <class Epi, class Sched>
__device__ __forceinline__ void gemm_phase(PG8_LAS unsigned char* lds, const Gemm g, const Sched& S, const Epi& E) {
    int tid_ = threadIdx.x; asm volatile("" : "+v"(tid_));
    const int tid = tid_, wid = __builtin_amdgcn_readfirstlane(tid >> 6), lane = tid & 63, wr = wid >> 2, wc = wid & 3, fr = lane & 15, fq = lane >> 4;
    const int K = g.K, nt = K / BK;
    unsigned voffA[2], voffB[2];
#pragma unroll
    for (int i = 0; i < 2; ++i) { int R, C; stage_rc(tid * 16 + i * 8192, R, C); const int Rb = Epi::PERM ? ((R & ~31) + perm32(R & 31)) : R;
        voffA[i] = (unsigned)(R * g.lda + C) * 2u; voffB[i] = (unsigned)(Rb * K + C) * 2u; }
    const size_t kstep = (size_t)(BK * 2);
    const size_t hstep = (size_t)HALF * K * 2, hstepA = (size_t)HALF * g.lda * 2;
    const size_t tstep = 2 * hstep, tstepA = 2 * hstepA;
    const unsigned ldsw = (unsigned)wid * 1024u;
    const int aoff = lds_byte(wr * 64 + fr, fq * 8), boff = lds_byte(wc * 32 + fr, fq * 8);
#define PG8_SA(b, h) (((b) * 2 + (h)) * HTB)
#define PG8_SB(b, h) ((4 + (b) * 2 + (h)) * HTB)
#define PG8_STAGE(bufoff, gbase, voff) do { _Pragma("unroll") for (int _i = 0; _i < 2; ++_i) \
        __builtin_amdgcn_global_load_lds((const unsigned*)((const char*)(gbase) + (voff)[_i]), (PG8_LAS unsigned*)(lds + (bufoff) + ldsw + _i * 8192), 16, 0, 0); } while (0)
#define PG8_LDA(dst, b, h) do { _Pragma("unroll") for (int m = 0; m < 4; ++m) _Pragma("unroll") for (int k = 0; k < 2; ++k) dst[m][k] = *(const PG8_LAS bf16x8*)(lds + PG8_SA(b, h) + aoff + m * 2048 + k * 1024); } while (0)
#define PG8_LDB(dst, b, h) do { _Pragma("unroll") for (int n = 0; n < 2; ++n) _Pragma("unroll") for (int k = 0; k < 2; ++k) dst[n][k] = *(const PG8_LAS bf16x8*)(lds + PG8_SB(b, h) + boff + n * 2048 + k * 1024); } while (0)
#define PG8_MMA(ai, bj, At, Bt) do { __builtin_amdgcn_s_setprio(1); _Pragma("unroll") for (int m = 0; m < 4; ++m) _Pragma("unroll") for (int n = 0; n < 2; ++n) _Pragma("unroll") for (int k = 0; k < 2; ++k) \
        acc[ai][bj][m][n] = __builtin_amdgcn_mfma_f32_16x16x32_bf16(Bt[n][k], At[m][k], acc[ai][bj][m][n], 0, 0, 0); __builtin_amdgcn_s_setprio(0); } while (0)
#define PG8_WAIT_V(n) asm volatile("s_waitcnt vmcnt(" #n ")" ::: "memory")
#define PG8_WAIT_L(n) asm volatile("s_waitcnt lgkmcnt(" #n ")" ::: "memory")
#define PG8_BAR __builtin_amdgcn_s_barrier()
#define PG8_SCHED __builtin_amdgcn_sched_barrier(0)
    Unit cur, nxt; int ui = 0;
    if (!S.next(0, cur)) return;
    f32x4 acc[2][2][4][2];
#pragma unroll
    for (int a = 0; a < 2; ++a)
#pragma unroll
        for (int b = 0; b < 2; ++b)
#pragma unroll
            for (int m = 0; m < 4; ++m)
#pragma unroll
                for (int n = 0; n < 2; ++n) acc[a][b][m][n] = (f32x4){0.f, 0.f, 0.f, 0.f};
    bf16x8 At[4][2], B0[2][2], B1[2][2];
    const char* cA = (const char*)g.A + (size_t)cur.pm * tstepA; const char* cB = (const char*)g.Bt + (size_t)cur.pn * tstep;
    S.a_ready(cur);
    PG8_STAGE(PG8_SB(0, 0), cB, voffB); PG8_STAGE(PG8_SA(0, 0), cA, voffA); PG8_STAGE(PG8_SB(0, 1), cB + hstep, voffB); PG8_STAGE(PG8_SA(0, 1), cA + hstepA, voffA);
    if (wr == 1) PG8_BAR;
    PG8_WAIT_V(4); PG8_BAR;
    PG8_STAGE(PG8_SB(1, 0), cB + kstep, voffB); PG8_STAGE(PG8_SA(1, 0), cA + kstep, voffA); PG8_STAGE(PG8_SB(1, 1), cB + hstep + kstep, voffB);
    PG8_WAIT_V(6); PG8_BAR;
    for (;;) {
        const bool has_next = S.next(ui + 1, nxt);
        const char* nA = has_next ? (const char*)g.A + (size_t)nxt.pm * tstepA : cA; const char* nB = has_next ? (const char*)g.Bt + (size_t)nxt.pn * tstep : cB;
        for (int t = 0; t < nt; t += 2) {
            const bool last = (t == nt - 2);
            const char* a1 = cA + (size_t)(t + 1) * kstep;
            const char* a2 = last ? nA : cA + (size_t)(t + 2) * kstep; const char* b2 = last ? nB : cB + (size_t)(t + 2) * kstep;
            const char* a3 = a2 + kstep; const char* b3 = b2 + kstep;
            if (last && has_next) S.a_ready(nxt);
            PG8_LDB(B0, 0, 0); PG8_SCHED; PG8_LDA(At, 0, 0); PG8_STAGE(PG8_SA(1, 1), a1 + hstepA, voffA);
            PG8_WAIT_L(8); PG8_BAR; PG8_WAIT_L(0); PG8_MMA(0, 0, At, B0); PG8_BAR; PG8_SCHED;
            PG8_LDB(B1, 0, 1); PG8_STAGE(PG8_SB(0, 0), b2, voffB);
            PG8_BAR; PG8_WAIT_L(0); PG8_MMA(0, 1, At, B1); PG8_BAR;
            PG8_LDA(At, 0, 1); PG8_STAGE(PG8_SA(0, 0), a2, voffA);
            PG8_BAR; PG8_WAIT_L(0); PG8_MMA(1, 0, At, B0); PG8_BAR; PG8_SCHED;
            PG8_STAGE(PG8_SB(0, 1), b2 + hstep, voffB);
            PG8_WAIT_V(6); PG8_BAR; PG8_MMA(1, 1, At, B1); PG8_BAR;
            PG8_LDB(B0, 1, 0); PG8_SCHED; PG8_LDA(At, 1, 0); PG8_STAGE(PG8_SA(0, 1), a2 + hstepA, voffA);
            PG8_WAIT_L(8); PG8_BAR; PG8_WAIT_L(0); PG8_MMA(0, 0, At, B0); PG8_BAR; PG8_SCHED;
            PG8_LDB(B1, 1, 1); PG8_STAGE(PG8_SB(1, 0), b3, voffB);
            PG8_BAR; PG8_WAIT_L(0); PG8_MMA(0, 1, At, B1); PG8_BAR;
            PG8_LDA(At, 1, 1); PG8_STAGE(PG8_SA(1, 0), a3, voffA);
            PG8_BAR; PG8_WAIT_L(0); PG8_MMA(1, 0, At, B0); PG8_BAR; PG8_SCHED;
            PG8_STAGE(PG8_SB(1, 1), b3 + hstep, voffB);
            PG8_WAIT_V(6); PG8_BAR; PG8_MMA(1, 1, At, B1); PG8_BAR;
        }
        if constexpr (!Epi::AFTER_DRAIN) { E(acc, cur, wr, wc, fr, fq); S.done(cur); }
        if (!has_next) break;
#pragma unroll
        for (int a = 0; a < 2; ++a)
#pragma unroll
            for (int b = 0; b < 2; ++b)
#pragma unroll
                for (int m = 0; m < 4; ++m)
#pragma unroll
                    for (int n = 0; n < 2; ++n) acc[a][b][m][n] = (f32x4){0.f, 0.f, 0.f, 0.f};
        cur = nxt; cA = nA; cB = nB; ++ui;
    }
    PG8_WAIT_V(0);
    if (wr == 0) PG8_BAR;
    PG8_BAR;
    if constexpr (Epi::AFTER_DRAIN) { E.fused(acc, cur, wr, wc, fr, fq, lds, wid, lane); S.done(cur); }
#undef PG8_SA
#undef PG8_SB
#undef PG8_STAGE
#undef PG8_LDA
#undef PG8_LDB
#undef PG8_MMA
#undef PG8_WAIT_V
#undef PG8_WAIT_L
#undef PG8_BAR
#undef PG8_SCHED
}

}

#define LAS __attribute__((address_space(3)))
using pg8::bf16_t; using pg8::bf16x8; using pg8::f32x4; using pg8::u32x4;
typedef float f32x16 __attribute__((ext_vector_type(16)));
typedef float f32x2 __attribute__((ext_vector_type(2)));
typedef unsigned u32x2 __attribute__((ext_vector_type(2)));
typedef __bf16 bf16x2v __attribute__((ext_vector_type(2)));

constexpr int DM = 1024, MP = 65536, MS = 512, MT = MP + MS  , MC = 32768, MKV = MT + MC  ;
constexpr int DFF = 2816, NINP = 4864, NMODC = 9216;
constexpr float EPSF = 1e-6f;
constexpr int LDS_BYTES = 131072 + 256;
constexpr int NSTEPS = 19;

constexpr size_t al256(size_t x) { return (x + 255) & ~(size_t)255; }
constexpr size_t O_CTL = 0;
constexpr size_t O_MOD = 256;
constexpr size_t O_RV  = al256(O_MOD + (size_t)40 * NMODC * 4);
constexpr size_t O_W1U = al256(O_RV + (size_t)MT * 4);
constexpr size_t O_W1D = O_W1U + (size_t)2 * DFF * DM * 2;
constexpr size_t O_W2U = O_W1D + (size_t)DM * DFF * 2;
constexpr size_t O_W2D = O_W2U + (size_t)2 * DFF * DM * 2;
constexpr size_t O_WIN = O_W2D + (size_t)DM * DFF * 2;
constexpr size_t O_WUQ = O_WIN + (size_t)NINP * DM * 2;
constexpr size_t O_WUK = O_WUQ + (size_t)768 * 384 * 2;
constexpr size_t O_WUV = O_WUK + (size_t)512 * 256 * 2;
constexpr size_t O_WBA = O_WUV + (size_t)512 * 256 * 2;
constexpr size_t O_WBB = O_WBA + (size_t)1024 * 1024 * 2;
constexpr size_t O_WO  = O_WBB + (size_t)1024 * 512 * 2;
constexpr size_t O_WS  = O_WO + (size_t)1024 * 1024 * 2;
constexpr size_t O_H   = al256(O_WS + (size_t)8 * 128 * 128 * 2);
constexpr size_t O_ZA  = O_H + (size_t)MT * 1024 * 2;
constexpr size_t O_G   = O_ZA + (size_t)MT * 2048 * 2;
constexpr size_t O_ZS  = O_G + (size_t)MT * 2048 * 2;
constexpr size_t O_KF  = O_ZS + (size_t)MT * 768 * 2;
constexpr size_t O_CKV = O_KF + (size_t)MKV * 768 * 2;
constexpr size_t O_KR  = O_CKV + (size_t)MKV * 256 * 2;
constexpr size_t WS_END = O_KR + (size_t)MKV * 32 * 4;
constexpr size_t O_ACT = O_ZA;
constexpr size_t O_QR  = O_ZA;
constexpr size_t O_VT  = O_ZA + (size_t)MT * 768 * 2;
constexpr size_t O_T   = O_ZA;
constexpr size_t O_MG  = O_ZA + (size_t)MT * 1024 * 2;
constexpr size_t O_OB  = O_ZS;
constexpr size_t O_OA  = O_H;
static_assert((size_t)MT * 768 * 2 + (size_t)512 * MKV * 2 <= (size_t)MT * 2048 * 2, "QR+VT must fit in ZA");
static_assert((size_t)MT * DFF * 2 <= (size_t)MT * 4096 * 2, "ACT must fit in ZA+G");

constexpr size_t OUT_Y = 0;
constexpr size_t OUT_CKVP = (size_t)MT * 1024;
constexpr size_t OUT_KRP = OUT_CKVP + (size_t)MP * 256;
constexpr size_t OUT_CKVS = OUT_KRP + (size_t)MP * 32;
constexpr size_t OUT_KRS = OUT_CKVS + (size_t)MS * 256;
constexpr size_t OUT_GV = OUT_KRS + (size_t)MS * 32;

enum { I_XP = 0, I_XS, I_CP, I_CS, I_CCKV, I_CKR, I_WMOD, I_BMOD, I_GFFN1, I_W1U, I_W1D, I_GMIX, I_WIN, I_GGV, I_GWS, I_GB, I_GQL, I_WUQ, I_GKVL, I_WUK, I_WUV,
       I_GQN, I_GKN, I_BGATE, I_WBA, I_WBB, I_WO, I_GFFN2, I_W2U, I_W2D };

struct Params {
    const float* in[30];
    float* out;
    unsigned char* ws;
    int ph_lo, ph_hi;
};

__device__ __forceinline__ unsigned pk2(float lo, float hi) { f32x2 v = {lo, hi}; bf16x2v b = __builtin_convertvector(v, bf16x2v); return __builtin_bit_cast(unsigned, b); }
__device__ __forceinline__ float bflo(unsigned w) { return __uint_as_float(w << 16); }
__device__ __forceinline__ float bfhi(unsigned w) { return __uint_as_float(w & 0xffff0000u); }
__device__ __forceinline__ float bf2f(bf16_t b) { return __uint_as_float((unsigned)b << 16); }
__device__ __forceinline__ bf16_t f2bf(float x) { return (bf16_t)(pk2(x, 0.f) & 0xffffu); }
__device__ __forceinline__ float wave_sum(float v) {
#pragma unroll
    for (int o = 1; o < 64; o <<= 1) v += __shfl_xor(v, o);
    return v;
}
__device__ __forceinline__ float fast_exp2(float x) { return __builtin_amdgcn_exp2f(x); }
__device__ __forceinline__ float sigmoidf_(float x) { return __builtin_amdgcn_rcpf(1.0f + fast_exp2(-1.4426950408889634f * x)); }
__device__ __forceinline__ float siluf_(float x) { return x * sigmoidf_(x); }
__device__ __forceinline__ float gelu_tanh(float x) { const float y = 1.5957691216057308f * (x + 0.044715f * x * x * x); return x * sigmoidf_(y); }
__device__ __forceinline__ int batch_of(int row) { return row < MP ? (row >> 11) : 32 + ((row - MP) >> 6); }
__device__ __forceinline__ float pos_of(int row) { return row < MP ? (float)(row & 2047) : (float)(4096 + ((row - MP) & 63)); }
__device__ __forceinline__ void rope_sc(float pos, int i, float& sn, float& cs) {
    const float freq = exp2f(-(float)i * (13.287712379549449f / 16.0f));
    const float ang = pos * freq;
    float rev = ang * 0.15915494309189535f; rev = rev - floorf(rev);
    sn = __builtin_amdgcn_sinf(rev); cs = __builtin_amdgcn_cosf(rev);
}

enum { EM_SWIGLU = 0, EM_RESID, EM_WIN, EM_PLAIN, EM_KNOPE, EM_BRA, EM_BRB };
struct Epi {
    static constexpr bool PERM = true, AFTER_DRAIN = false;
    int mode;
    bf16_t* O; int ldc;
    const bf16_t* G; const bf16_t* T;
    float* Y; const float* xp; const float* xs; const float* MODv; int gidx; float coef;
    const float* bgate; bf16_t* ZA; bf16_t* Gw; bf16_t* ZS;
    __device__ __forceinline__ void operator()(const f32x4 (&acc)[2][2][4][2], const pg8::Unit& u, int wr, int wc, int fr, int fq) const {
        const int row0 = u.pm * 256 + wr * 64 + fr, cl = wc * 32 + 8 * fq;
        if (mode == EM_SWIGLU) {
#pragma unroll
            for (int ai = 0; ai < 2; ++ai)
#pragma unroll
                for (int m = 0; m < 4; ++m) {
                    const int r = row0 + ai * 128 + m * 16;
                    float o[8];
#pragma unroll
                    for (int n = 0; n < 2; ++n)
#pragma unroll
                        for (int j = 0; j < 4; ++j) { const float g = acc[ai][0][m][n][j], uu = acc[ai][1][m][n][j]; o[4 * n + j] = siluf_(g) * uu; }
                    u32x4 w; w.x = pk2(o[0], o[1]); w.y = pk2(o[2], o[3]); w.z = pk2(o[4], o[5]); w.w = pk2(o[6], o[7]);
                    *(u32x4*)(O + (size_t)r * DFF + u.pn * 128 + cl) = w;
                }
        } else if (mode == EM_RESID) {
#pragma unroll
            for (int ai = 0; ai < 2; ++ai)
#pragma unroll
                for (int m = 0; m < 4; ++m) {
                    const int r = row0 + ai * 128 + m * 16;
                    const float* base = (r < MP) ? xp + (size_t)r * DM : xs + (size_t)(r - MP) * DM;
                    float* yo = Y + (size_t)r * DM;
                    const float* gt = MODv + (size_t)batch_of(r) * NMODC + gidx * DM;
#pragma unroll
                    for (int bj = 0; bj < 2; ++bj) {
                        const int c = u.pn * 256 + bj * 128 + cl;
#pragma unroll
                        for (int n = 0; n < 2; ++n) {
                            const f32x4 bs = *(const f32x4*)(base + c + 4 * n); const f32x4 gg = *(const f32x4*)(gt + c + 4 * n);
                            *(f32x4*)(yo + c + 4 * n) = bs + (gg * coef) * acc[ai][bj][m][n];
                        }
                    }
                    asm volatile("" ::: "memory");
                }
        } else if (mode == EM_WIN) {
            const int sel = u.pn < 8 ? 0 : (u.pn < 16 ? 1 : 2);
#pragma unroll
            for (int ai = 0; ai < 2; ++ai)
#pragma unroll
                for (int m = 0; m < 4; ++m) {
                    const int r = row0 + ai * 128 + m * 16;
#pragma unroll
                    for (int bj = 0; bj < 2; ++bj) {
                        float o[8];
#pragma unroll
                        for (int n = 0; n < 2; ++n)
#pragma unroll
                            for (int j = 0; j < 4; ++j) o[4 * n + j] = acc[ai][bj][m][n][j];
                        bf16_t* dst;
                        if (sel == 0) {
                            const int c = u.pn * 256 + bj * 128 + cl;
#pragma unroll
                            for (int j = 0; j < 8; ++j) o[j] = gelu_tanh(o[j]);
                            dst = ZA + (size_t)r * 2048 + c;
                        } else if (sel == 1) {
                            const int c = (u.pn - 8) * 256 + bj * 128 + cl;
                            const f32x4 b0 = *(const f32x4*)(bgate + c), b1 = *(const f32x4*)(bgate + c + 4);
#pragma unroll
                            for (int j = 0; j < 4; ++j) { o[j] = sigmoidf_(o[j] + b0[j]); o[4 + j] = sigmoidf_(o[4 + j] + b1[j]); }
                            dst = Gw + (size_t)r * 2048 + c;
                        } else {
                            const int c = (u.pn - 16) * 256 + bj * 128 + cl;
                            dst = ZS + (size_t)r * 768 + c;
                        }
                        u32x4 w; w.x = pk2(o[0], o[1]); w.y = pk2(o[2], o[3]); w.z = pk2(o[4], o[5]); w.w = pk2(o[6], o[7]);
                        *(u32x4*)dst = w;
                    }
                }
        } else if (mode == EM_PLAIN || mode == EM_KNOPE) {
#pragma unroll
            for (int ai = 0; ai < 2; ++ai)
#pragma unroll
                for (int m = 0; m < 4; ++m) {
                    const int r = row0 + ai * 128 + m * 16;
#pragma unroll
                    for (int bj = 0; bj < 2; ++bj) {
                        const int c = u.pn * 256 + bj * 128 + cl;
                        const f32x4 v0 = acc[ai][bj][m][0], v1 = acc[ai][bj][m][1];
                        u32x4 w; w.x = pk2(v0[0], v0[1]); w.y = pk2(v0[2], v0[3]); w.z = pk2(v1[0], v1[1]); w.w = pk2(v1[2], v1[3]);
                        bf16_t* dst = (mode == EM_PLAIN) ? O + (size_t)r * ldc + c : O + (size_t)r * 768 + (c >> 6) * 96 + (c & 63);
                        *(u32x4*)dst = w;
                    }
                }
        } else {
#pragma unroll
            for (int ai = 0; ai < 2; ++ai)
#pragma unroll
                for (int m = 0; m < 4; ++m) {
                    const int r = row0 + ai * 128 + m * 16;
#pragma unroll
                    for (int bj = 0; bj < 2; ++bj) {
                        const int c = u.pn * 256 + bj * 128 + cl;
                        const u32x4 gw = *(const u32x4*)(G + (size_t)r * 2048 + (mode == EM_BRB ? 1024 : 0) + c);
                        const f32x4 v0 = acc[ai][bj][m][0], v1 = acc[ai][bj][m][1];
                        float o[8];
                        o[0] = bflo(gw.x) * v0[0]; o[1] = bfhi(gw.x) * v0[1]; o[2] = bflo(gw.y) * v0[2]; o[3] = bfhi(gw.y) * v0[3];
                        o[4] = bflo(gw.z) * v1[0]; o[5] = bfhi(gw.z) * v1[1]; o[6] = bflo(gw.w) * v1[2]; o[7] = bfhi(gw.w) * v1[3];
                        if (mode == EM_BRB) {
                            const u32x4 tw = *(const u32x4*)(T + (size_t)r * 1024 + c);
                            o[0] += bflo(tw.x); o[1] += bfhi(tw.x); o[2] += bflo(tw.y); o[3] += bfhi(tw.y);
                            o[4] += bflo(tw.z); o[5] += bfhi(tw.z); o[6] += bflo(tw.w); o[7] += bfhi(tw.w);
                        }
                        u32x4 w; w.x = pk2(o[0], o[1]); w.y = pk2(o[2], o[3]); w.z = pk2(o[4], o[5]); w.w = pk2(o[6], o[7]);
                        *(u32x4*)(O + (size_t)r * 1024 + c) = w;
                    }
                    asm volatile("" ::: "memory");
                }
        }
    }
};

template <class MapF>
__device__ __forceinline__ void conv_wT(const float* __restrict__ W, int K, int Nsrc, bf16_t* __restrict__ Bt, int Ndst, MapF map, size_t gtid, size_t gsz) {
    const size_t total = (size_t)Ndst * (size_t)(K / 8);
    for (size_t i = gtid; i < total; i += gsz) {
        const int n = (int)(i % (size_t)Ndst), kb = (int)(i / (size_t)Ndst);
        const int src = map(n);
        u32x4 o = {0u, 0u, 0u, 0u};
        if (src >= 0) {
            const float* p = W + (size_t)(kb * 8) * Nsrc + src;
            const float v0 = p[0], v1 = p[(size_t)Nsrc], v2 = p[(size_t)2 * Nsrc], v3 = p[(size_t)3 * Nsrc], v4 = p[(size_t)4 * Nsrc], v5 = p[(size_t)5 * Nsrc], v6 = p[(size_t)6 * Nsrc], v7 = p[(size_t)7 * Nsrc];
            o.x = pk2(v0, v1); o.y = pk2(v2, v3); o.z = pk2(v4, v5); o.w = pk2(v6, v7);
        }
        *(u32x4*)(Bt + (size_t)n * K + kb * 8) = o;
    }
}
struct MapId { __device__ __forceinline__ int operator()(int n) const { return n; } };
struct MapUp { __device__ __forceinline__ int operator()(int n) const { const int t = n >> 8, l = n & 255; return l < 128 ? t * 128 + l : DFF + t * 128 + (l - 128); } };
struct MapIn { __device__ __forceinline__ int operator()(int n) const { return n < 2048 ? n : (n < 4096 ? 2720 + (n - 2048) : (n < 4768 ? 2048 + (n - 4096) : -1)); } };

__device__ __forceinline__ void prep_phase(const Params& P, LAS unsigned char* lds) {
    int tid_ = threadIdx.x; asm volatile("" : "+v"(tid_));
    const int tid = tid_, lane = tid & 63, wid = __builtin_amdgcn_readfirstlane(tid >> 6);
    const size_t gtid = (size_t)blockIdx.x * 512 + tid, gsz = (size_t)gridDim.x * 512;
    unsigned char* ws = P.ws;
    if (gtid < 64) ((unsigned*)(ws + O_CTL))[gtid] = 0u;
    if (blockIdx.x < NMODC / 64) {
        const int n0 = blockIdx.x * 64;
        const float* cp = P.in[I_CP]; const float* cs = P.in[I_CS]; const float* wm = P.in[I_WMOD];
        LAS float* sc = (LAS float*)lds;
        float acc[40];
#pragma unroll
        for (int b = 0; b < 40; ++b) acc[b] = 0.f;
        for (int half = 0; half < 2; ++half) {
            __syncthreads();
            for (int i = tid; i < 40 * 512; i += 512) { const int b = i >> 9, k = i & 511; const float c = b < 32 ? cp[b * 1024 + half * 512 + k] : cs[(b - 32) * 1024 + half * 512 + k]; sc[i] = siluf_(c); }
            __syncthreads();
            for (int kk = 0; kk < 64; kk += 4) {
                const int kl = wid * 64 + kk; const size_t kg = (size_t)(half * 512 + kl);
                const float w0 = wm[kg * NMODC + n0 + lane], w1 = wm[(kg + 1) * NMODC + n0 + lane], w2 = wm[(kg + 2) * NMODC + n0 + lane], w3 = wm[(kg + 3) * NMODC + n0 + lane];
#pragma unroll
                for (int b = 0; b < 40; ++b) { const f32x4 s = *(const LAS f32x4*)(sc + b * 512 + kl); acc[b] += s.x * w0 + s.y * w1 + s.z * w2 + s.w * w3; }
            }
        }
        __syncthreads();
        LAS float* red = (LAS float*)lds;
#pragma unroll
        for (int b = 0; b < 40; ++b) red[(wid * 40 + b) * 64 + lane] = acc[b];
        __syncthreads();
        float* MODv = (float*)(ws + O_MOD); const float* bm = P.in[I_BMOD];
        for (int i = tid; i < 40 * 64; i += 512) { const int b = i >> 6, l = i & 63; float s = bm[n0 + l];
#pragma unroll
            for (int w = 0; w < 8; ++w) s += red[(w * 40 + b) * 64 + l];
            MODv[(size_t)b * NMODC + n0 + l] = s; }
        __syncthreads();
    }
    conv_wT(P.in[I_W1U], 1024, 2 * DFF, (bf16_t*)(ws + O_W1U), 2 * DFF, MapUp(), gtid, gsz);
    conv_wT(P.in[I_W2U], 1024, 2 * DFF, (bf16_t*)(ws + O_W2U), 2 * DFF, MapUp(), gtid, gsz);
    conv_wT(P.in[I_W1D], DFF, 1024, (bf16_t*)(ws + O_W1D), 1024, MapId(), gtid, gsz);
    conv_wT(P.in[I_W2D], DFF, 1024, (bf16_t*)(ws + O_W2D), 1024, MapId(), gtid, gsz);
    conv_wT(P.in[I_WIN], 1024, 4768, (bf16_t*)(ws + O_WIN), NINP, MapIn(), gtid, gsz);
    conv_wT(P.in[I_WUQ], 384, 768, (bf16_t*)(ws + O_WUQ), 768, MapId(), gtid, gsz);
    conv_wT(P.in[I_WUK], 256, 512, (bf16_t*)(ws + O_WUK), 512, MapId(), gtid, gsz);
    conv_wT(P.in[I_WUV], 256, 512, (bf16_t*)(ws + O_WUV), 512, MapId(), gtid, gsz);
    conv_wT(P.in[I_WBA], 1024, 1024, (bf16_t*)(ws + O_WBA), 1024, MapId(), gtid, gsz);
    conv_wT(P.in[I_WBB], 512, 1024, (bf16_t*)(ws + O_WBB), 1024, MapId(), gtid, gsz);
    conv_wT(P.in[I_WO], 1024, 1024, (bf16_t*)(ws + O_WO), 1024, MapId(), gtid, gsz);
    { const float* w = P.in[I_GWS]; bf16_t* o = (bf16_t*)(ws + O_WS);
      for (size_t i = gtid; i < (size_t)8 * 128 * 128; i += gsz) { const int s = (int)(i & 127), t = (int)((i >> 7) & 127); o[i] = f2bf(s <= t ? w[i] : 0.f); } }
    { const float* c = P.in[I_CCKV]; bf16_t* o = (bf16_t*)(ws + O_CKV) + (size_t)MT * 256;
      for (size_t i = gtid; i < (size_t)MC * 256 / 4; i += gsz) { const f32x4 v = *(const f32x4*)(c + 4 * i); u32x2 w; w.x = pk2(v.x, v.y); w.y = pk2(v.z, v.w); *(u32x2*)(o + 4 * i) = w; }
      const float* kr = P.in[I_CKR]; float* ko = (float*)(ws + O_KR) + (size_t)MT * 32;
      for (size_t i = gtid; i < (size_t)MC * 32 / 4; i += gsz) *(f32x4*)(ko + 4 * i) = *(const f32x4*)(kr + 4 * i); }
}

__device__ __forceinline__ void modulate_phase(const float* xp, const float* xs, const float* g, const float* MODv, int ish, int isc, bf16_t* H) {
    int tid_ = threadIdx.x; asm volatile("" : "+v"(tid_));
    const int tid = tid_, lane = tid & 63, wid = tid >> 6;
    const int gw = blockIdx.x * 8 + wid, ngw = gridDim.x * 8;
    for (int row = gw; row < MT; row += ngw) {
        const float* x = row < MP ? xp + (size_t)row * DM : xs + (size_t)(row - MP) * DM;
        const float* mb = MODv + (size_t)batch_of(row) * NMODC;
        f32x4 v[4]; float ss = 0.f;
#pragma unroll
        for (int j = 0; j < 4; ++j) { v[j] = *(const f32x4*)(x + 4 * lane + 256 * j); ss += (v[j].x * v[j].x + v[j].y * v[j].y) + (v[j].z * v[j].z + v[j].w * v[j].w); }
        ss = wave_sum(ss);
        const float r = rsqrtf(ss * (1.0f / 1024.0f) + EPSF);
#pragma unroll
        for (int j = 0; j < 4; ++j) {
            const int c = 4 * lane + 256 * j;
            const f32x4 gg = *(const f32x4*)(g + c), sc = *(const f32x4*)(mb + isc * DM + c), sh = *(const f32x4*)(mb + ish * DM + c);
            const f32x4 o = (v[j] * r) * gg * (sc + 1.0f) + sh;
            u32x2 w; w.x = pk2(o.x, o.y); w.y = pk2(o.z, o.w);
            *(u32x2*)(H + (size_t)row * DM + c) = w;
        }
    }
}

__device__ __forceinline__ void rowpost_phase(const Params& P) {
    int tid_ = threadIdx.x; asm volatile("" : "+v"(tid_));
    const int tid = tid_, lane = tid & 63, wid = tid >> 6;
    const int gw = blockIdx.x * 8 + wid, ngw = gridDim.x * 8;
    unsigned char* ws = P.ws;
    const bf16_t* ZA = (const bf16_t*)(ws + O_ZA); bf16_t* ZS = (bf16_t*)(ws + O_ZS); float* RV = (float*)(ws + O_RV);
    bf16_t* CKV = (bf16_t*)(ws + O_CKV); float* KR = (float*)(ws + O_KR);
    const float* gql = P.in[I_GQL]; const float* gkv = P.in[I_GKVL];
    for (int row = gw; row < MT; row += ngw) {
        { const u32x4* p = (const u32x4*)(ZA + (size_t)row * 2048 + 1024 + 16 * lane); const u32x4 a = p[0], b = p[1]; float ss = 0.f;
          const unsigned w[8] = {a.x, a.y, a.z, a.w, b.x, b.y, b.z, b.w};
#pragma unroll
          for (int j = 0; j < 8; ++j) { const float lo = bflo(w[j]), hi = bfhi(w[j]); ss += lo * lo + hi * hi; }
          ss = wave_sum(ss); if (lane == 0) RV[row] = rsqrtf(ss * (1.0f / 1024.0f) + EPSF); }
        bf16_t* zs = ZS + (size_t)row * 768;
        { u32x4 a = {0u, 0u, 0u, 0u}; if (lane < 48) a = *(const u32x4*)(zs + 8 * lane);
          float q[8] = {bflo(a.x), bfhi(a.x), bflo(a.y), bfhi(a.y), bflo(a.z), bfhi(a.z), bflo(a.w), bfhi(a.w)}; float ss = 0.f;
#pragma unroll
          for (int j = 0; j < 8; ++j) ss += q[j] * q[j];
          ss = wave_sum(ss); const float r = rsqrtf(ss * (1.0f / 384.0f) + EPSF);
          if (lane < 48) { const f32x4 g0 = *(const f32x4*)(gql + 8 * lane), g1 = *(const f32x4*)(gql + 8 * lane + 4);
            u32x4 w; w.x = pk2(q[0] * r * g0.x, q[1] * r * g0.y); w.y = pk2(q[2] * r * g0.z, q[3] * r * g0.w); w.z = pk2(q[4] * r * g1.x, q[5] * r * g1.y); w.w = pk2(q[6] * r * g1.z, q[7] * r * g1.w);
            *(u32x4*)(zs + 8 * lane) = w; } }
        { const u32x2 a = *(const u32x2*)(zs + 384 + 4 * lane); float v[4] = {bflo(a.x), bfhi(a.x), bflo(a.y), bfhi(a.y)};
          float ss = (v[0] * v[0] + v[1] * v[1]) + (v[2] * v[2] + v[3] * v[3]); ss = wave_sum(ss); const float r = rsqrtf(ss * (1.0f / 256.0f) + EPSF);
          const f32x4 g4 = *(const f32x4*)(gkv + 4 * lane); f32x4 o = {v[0] * r * g4.x, v[1] * r * g4.y, v[2] * r * g4.z, v[3] * r * g4.w};
          float* dst = row < MP ? P.out + OUT_CKVP + (size_t)row * 256 : P.out + OUT_CKVS + (size_t)(row - MP) * 256;
          *(f32x4*)(dst + 4 * lane) = o; u32x2 w; w.x = pk2(o.x, o.y); w.y = pk2(o.z, o.w); *(u32x2*)(CKV + (size_t)row * 256 + 4 * lane) = w; }
        { const float val = lane < 32 ? bf2f(zs[640 + lane]) : 0.f; const float partner = __shfl_xor(val, 16); float sn, cs; rope_sc(pos_of(row), lane & 15, sn, cs);
          const float o = (lane < 16) ? val * cs - partner * sn : partner * sn + val * cs;
          if (lane < 32) { KR[(size_t)row * 32 + lane] = o; float* dst = row < MP ? P.out + OUT_KRP + (size_t)row * 32 : P.out + OUT_KRS + (size_t)(row - MP) * 32; dst[lane] = o; } }
    }
}

__device__ __forceinline__ void gmlp_phase(const Params& P, LAS unsigned char* lds) {
    int tid_ = threadIdx.x; asm volatile("" : "+v"(tid_));
    const int tid = tid_, lane = tid & 63, wid = __builtin_amdgcn_readfirstlane(tid >> 6), l32 = lane & 31, hh = lane >> 5;
    unsigned char* ws = P.ws;
    const bf16_t* ZA = (const bf16_t*)(ws + O_ZA); const float* RV = (const float*)(ws + O_RV); const bf16_t* WS = (const bf16_t*)(ws + O_WS);
    bf16_t* OA = (bf16_t*)(ws + O_OA);
    const float* ggv = P.in[I_GGV]; const float* gb = P.in[I_GB];
    LAS bf16_t* vt = (LAS bf16_t*)lds;
    for (int item = blockIdx.x; item < 520 * 8; item += gridDim.x) {
        const int ci = item >> 3, g = item & 7; const bool sample = ci >= 512;
        const int row0 = sample ? MP + (ci - 512) * 64 : ci * 128, L = sample ? 64 : 128;
        __syncthreads();
#pragma unroll
        for (int p = 0; p < 4; ++p) {
            const int s = p * 32 + (tid >> 4), cp = tid & 15;
            if (s < L) {
                const int row = row0 + s;
                const u32x4 a = *(const u32x4*)(ZA + (size_t)row * 2048 + 1024 + g * 128 + 8 * cp);
                const float rv = RV[row];
                const f32x4 g0 = *(const f32x4*)(ggv + g * 128 + 8 * cp), g1 = *(const f32x4*)(ggv + g * 128 + 8 * cp + 4);
                float v[8] = {bflo(a.x) * rv * g0.x, bfhi(a.x) * rv * g0.y, bflo(a.y) * rv * g0.z, bfhi(a.y) * rv * g0.w, bflo(a.z) * rv * g1.x, bfhi(a.z) * rv * g1.y, bflo(a.w) * rv * g1.z, bfhi(a.w) * rv * g1.w};
                if (sample) { float* dst = P.out + OUT_GV + (size_t)(row - MP) * 1024 + g * 128 + 8 * cp; *(f32x4*)dst = (f32x4){v[0], v[1], v[2], v[3]}; *(f32x4*)(dst + 4) = (f32x4){v[4], v[5], v[6], v[7]}; }
#pragma unroll
                for (int j = 0; j < 8; ++j) vt[(8 * cp + j) * 136 + s] = f2bf(v[j]);
            }
        }
        __syncthreads();
        const int tb = wid & 3, ch = wid >> 2;
        if (32 * tb < L) {
            f32x16 acc0, acc1;
#pragma unroll
            for (int i = 0; i < 16; ++i) { acc0[i] = 0.f; acc1[i] = 0.f; }
            const bf16_t* wp = WS + ((size_t)g * 128 + 32 * tb + l32) * 128 + 8 * hh;
            const LAS bf16_t* b0p = vt + (64 * ch + l32) * 136 + 8 * hh; const LAS bf16_t* b1p = b0p + 32 * 136;
            const int nks = 2 * (tb + 1);
            for (int ks = 0; ks < nks; ++ks) {
                const bf16x8 a = *(const bf16x8*)(wp + 16 * ks);
                const bf16x8 b0 = *(const LAS bf16x8*)(b0p + 16 * ks), b1 = *(const LAS bf16x8*)(b1p + 16 * ks);
                acc0 = __builtin_amdgcn_mfma_f32_32x32x16_bf16(a, b0, acc0, 0, 0, 0);
                acc1 = __builtin_amdgcn_mfma_f32_32x32x16_bf16(a, b1, acc1, 0, 0, 0);
            }
#pragma unroll
            for (int nb = 0; nb < 2; ++nb) {
                const int c = g * 128 + 64 * ch + 32 * nb + l32;
#pragma unroll
                for (int i = 0; i < 16; ++i) {
                    const int t = 32 * tb + (i & 3) + 8 * (i >> 2) + 4 * hh; const int row = row0 + t;
                    const float uu = bf2f(ZA[(size_t)row * 2048 + c]); const float bias = gb[g * 128 + t];
                    const float a = nb == 0 ? acc0[i] : acc1[i];
                    OA[(size_t)row * 1024 + c] = f2bf(uu * (a + bias));
                }
            }
        }
    }
}

__device__ __forceinline__ void qkfinal_phase(const Params& P) {
    int tid_ = threadIdx.x; asm volatile("" : "+v"(tid_));
    const int tid = tid_, lane = tid & 63, wid = tid >> 6;
    const int gw = blockIdx.x * 8 + wid, ngw = gridDim.x * 8;
    unsigned char* ws = P.ws;
    bf16_t* QR = (bf16_t*)(ws + O_QR); bf16_t* KF = (bf16_t*)(ws + O_KF); const float* KR = (const float*)(ws + O_KR);
    const float* gqn = P.in[I_GQN]; const float* gkn = P.in[I_GKN];
    const int h = lane >> 3, sub = lane & 7;
    constexpr float QSCALE = 0.10206207261596575f * 1.4426950408889634f;
    for (int item = gw; item < MT + MKV; item += ngw) {
        const bool isq = item < MT; const int row = isq ? item : item - MT;
        bf16_t* p = (isq ? QR : KF) + (size_t)row * 768 + h * 96;
        const u32x4 a = *(const u32x4*)(p + 8 * sub);
        float nope[8] = {bflo(a.x), bfhi(a.x), bflo(a.y), bfhi(a.y), bflo(a.z), bfhi(a.z), bflo(a.w), bfhi(a.w)};
        float rp[4];
        if (isq) {
            const u32x2 b = *(const u32x2*)(p + 64 + 4 * sub);
            const float raw[4] = {bflo(b.x), bfhi(b.x), bflo(b.y), bfhi(b.y)};
            const float pos = pos_of(row);
#pragma unroll
            for (int j = 0; j < 4; ++j) { const float partner = __shfl_xor(raw[j], 4); float sn, cs; rope_sc(pos, (4 * sub + j) & 15, sn, cs);
                rp[j] = (sub < 4) ? raw[j] * cs - partner * sn : partner * sn + raw[j] * cs; }
        } else {
            const f32x4 b = *(const f32x4*)(KR + (size_t)row * 32 + 4 * sub); rp[0] = b.x; rp[1] = b.y; rp[2] = b.z; rp[3] = b.w;
        }
        float ss = 0.f;
#pragma unroll
        for (int j = 0; j < 8; ++j) ss += nope[j] * nope[j];
#pragma unroll
        for (int j = 0; j < 4; ++j) ss += rp[j] * rp[j];
        ss += __shfl_xor(ss, 1); ss += __shfl_xor(ss, 2); ss += __shfl_xor(ss, 4);
        const float r = rsqrtf(ss * (1.0f / 96.0f) + EPSF) * (isq ? QSCALE : 1.0f);
        const float* gn = isq ? gqn : gkn;
        const f32x4 g0 = *(const f32x4*)(gn + 8 * sub), g1 = *(const f32x4*)(gn + 8 * sub + 4), g2 = *(const f32x4*)(gn + 64 + 4 * sub);
        u32x4 w; w.x = pk2(nope[0] * r * g0.x, nope[1] * r * g0.y); w.y = pk2(nope[2] * r * g0.z, nope[3] * r * g0.w); w.z = pk2(nope[4] * r * g1.x, nope[5] * r * g1.y); w.w = pk2(nope[6] * r * g1.z, nope[7] * r * g1.w);
        u32x2 w2; w2.x = pk2(rp[0] * r * g2.x, rp[1] * r * g2.y); w2.y = pk2(rp[2] * r * g2.z, rp[3] * r * g2.w);
        *(u32x4*)(p + 8 * sub) = w; *(u32x2*)(p + 64 + 4 * sub) = w2;
    }
}

constexpr int N_ATT_ITEMS = 64 + 2048;
__device__ __forceinline__ void attn_phase(const Params& P, LAS unsigned char* lds) {
    int tid_ = threadIdx.x; asm volatile("" : "+v"(tid_));
    const int tid = tid_, lane = tid & 63, wid = __builtin_amdgcn_readfirstlane(tid >> 6), l32 = lane & 31, hh = lane >> 5;
    unsigned char* ws = P.ws;
    const bf16_t* QR = (const bf16_t*)(ws + O_QR); const bf16_t* KF = (const bf16_t*)(ws + O_KF); const bf16_t* VT = (const bf16_t*)(ws + O_VT);
    bf16_t* OB = (bf16_t*)(ws + O_OB);
    unsigned* counter = (unsigned*)(ws + O_CTL);
    LAS unsigned* slot = (LAS unsigned*)(lds + 45056);
    const int k0key = tid / 12, k0part = tid % 12, k1key = (tid + 512) / 12, k1part = (tid + 512) % 12; const bool has1 = tid < 256;
    const int vdv = tid >> 3, vpart = tid & 7;
    for (;;) {
        __syncthreads();
        if (tid == 0) *slot = atomicAdd(counter, 1u);
        __syncthreads();
        const int item = (int)*slot;
        if (item >= N_ATT_ITEMS) break;
        const bool sample = item < 64;
        int b, h, nt, qrow0, wlim;
        if (sample) { b = item >> 3; h = item & 7; nt = 65; qrow0 = MP + b * 64; wlim = 64; }
        else { const int j = item - 64, qb = 7 - (j >> 8), bh = j & 255; b = bh >> 3; h = bh & 7; nt = 4 * qb + 4; qrow0 = b * 2048 + qb * 256; wlim = 4 * qb + (wid >> 1); }
        const bool wvalid = sample ? (wid < 2) : true;
        bf16x8 qf[6];
        if (wvalid) { const bf16_t* qp = QR + (size_t)(qrow0 + 32 * wid + l32) * 768 + h * 96 + 8 * hh;
#pragma unroll
            for (int ks = 0; ks < 6; ++ks) qf[ks] = *(const bf16x8*)(qp + 16 * ks); }
        else {
#pragma unroll
            for (int ks = 0; ks < 6; ++ks) qf[ks] = (bf16x8){0, 0, 0, 0, 0, 0, 0, 0}; }
        f32x16 O0, O1;
#pragma unroll
        for (int i = 0; i < 16; ++i) { O0[i] = 0.f; O1[i] = 0.f; }
        float mrun = -1e30f, lrun = 0.f;
        u32x4 kr0, kr1 = {0u, 0u, 0u, 0u}, vr;
#define ATT_TROW(kt) (sample ? ((kt) < 64 ? MT + b * 4096 + (kt) * 64 : MP + b * 64) : b * 2048 + (kt) * 64)
#define ATT_ISSUE(kt) do { const size_t krow = (size_t)ATT_TROW(kt); \
            kr0 = *(const u32x4*)(KF + (krow + k0key) * 768 + h * 96 + k0part * 8); \
            if (has1) kr1 = *(const u32x4*)(KF + (krow + k1key) * 768 + h * 96 + k1part * 8); \
            vr = *(const u32x4*)(VT + (size_t)(h * 64 + vdv) * MKV + krow + vpart * 8); } while (0)
#define ATT_COMMIT(bufi) do { *(LAS u32x4*)(lds + (bufi) * 13312 + k0key * 208 + k0part * 16) = kr0; \
            if (has1) *(LAS u32x4*)(lds + (bufi) * 13312 + k1key * 208 + k1part * 16) = kr1; \
            *(LAS u32x4*)(lds + 26624 + (bufi) * 9216 + vdv * 144 + vpart * 16) = vr; } while (0)
        ATT_ISSUE(0); ATT_COMMIT(0);
        __syncthreads();
        for (int kt = 0; kt < nt; ++kt) {
            const int buf = kt & 1;
            if (kt + 1 < nt) ATT_ISSUE(kt + 1);
            if (wvalid && kt <= wlim) {
                const LAS unsigned char* kb = lds + buf * 13312 + l32 * 208 + hh * 16;
                const LAS unsigned char* vb = lds + 26624 + buf * 9216 + l32 * 144 + hh * 8;
                f32x16 S0, S1;
#pragma unroll
                for (int i = 0; i < 16; ++i) { S0[i] = 0.f; S1[i] = 0.f; }
#pragma unroll
                for (int ks = 0; ks < 6; ++ks) {
                    const bf16x8 a0 = *(const LAS bf16x8*)(kb + ks * 32), a1 = *(const LAS bf16x8*)(kb + 32 * 208 + ks * 32);
                    S0 = __builtin_amdgcn_mfma_f32_32x32x16_bf16(a0, qf[ks], S0, 0, 0, 0);
                    S1 = __builtin_amdgcn_mfma_f32_32x32x16_bf16(a1, qf[ks], S1, 0, 0, 0);
                }
                float mx = S0[0];
#pragma unroll
                for (int i = 1; i < 16; ++i) mx = fmaxf(mx, S0[i]);
#pragma unroll
                for (int i = 0; i < 16; ++i) mx = fmaxf(mx, S1[i]);
                mx = fmaxf(mx, __shfl_xor(mx, 32));
                const float mnew = fmaxf(mrun, mx), alpha = fast_exp2(mrun - mnew); mrun = mnew;
                float ps = 0.f;
#pragma unroll
                for (int i = 0; i < 16; ++i) { S0[i] = fast_exp2(S0[i] - mnew); ps += S0[i]; }
#pragma unroll
                for (int i = 0; i < 16; ++i) { S1[i] = fast_exp2(S1[i] - mnew); ps += S1[i]; }
                lrun = lrun * alpha + ps;
#pragma unroll
                for (int i = 0; i < 16; ++i) { O0[i] *= alpha; O1[i] *= alpha; }
#pragma unroll
                for (int kk = 0; kk < 4; ++kk) {
                    u32x4 pw;
                    if (kk == 0) { pw.x = pk2(S0[0], S0[1]); pw.y = pk2(S0[2], S0[3]); pw.z = pk2(S0[4], S0[5]); pw.w = pk2(S0[6], S0[7]); }
                    else if (kk == 1) { pw.x = pk2(S0[8], S0[9]); pw.y = pk2(S0[10], S0[11]); pw.z = pk2(S0[12], S0[13]); pw.w = pk2(S0[14], S0[15]); }
                    else if (kk == 2) { pw.x = pk2(S1[0], S1[1]); pw.y = pk2(S1[2], S1[3]); pw.z = pk2(S1[4], S1[5]); pw.w = pk2(S1[6], S1[7]); }
                    else { pw.x = pk2(S1[8], S1[9]); pw.y = pk2(S1[10], S1[11]); pw.z = pk2(S1[12], S1[13]); pw.w = pk2(S1[14], S1[15]); }
                    const bf16x8 pb = __builtin_bit_cast(bf16x8, pw);
                    const u32x2 lo0 = *(const LAS u32x2*)(vb + kk * 32), hi0 = *(const LAS u32x2*)(vb + kk * 32 + 16);
                    const u32x2 lo1 = *(const LAS u32x2*)(vb + 32 * 144 + kk * 32), hi1 = *(const LAS u32x2*)(vb + 32 * 144 + kk * 32 + 16);
                    const u32x4 va0 = {lo0.x, lo0.y, hi0.x, hi0.y}, va1 = {lo1.x, lo1.y, hi1.x, hi1.y};
                    O0 = __builtin_amdgcn_mfma_f32_32x32x16_bf16(__builtin_bit_cast(bf16x8, va0), pb, O0, 0, 0, 0);
                    O1 = __builtin_amdgcn_mfma_f32_32x32x16_bf16(__builtin_bit_cast(bf16x8, va1), pb, O1, 0, 0, 0);
                }
            }
            if (kt + 1 < nt) ATT_COMMIT(buf ^ 1);
            __syncthreads();
        }
#undef ATT_TROW
#undef ATT_ISSUE
#undef ATT_COMMIT
        if (wvalid) {
            const float ltot = lrun + __shfl_xor(lrun, 32); const float inv = 1.0f / ltot;
            bf16_t* op = OB + (size_t)(qrow0 + 32 * wid + l32) * 512 + h * 64 + 4 * hh;
#pragma unroll
            for (int g4 = 0; g4 < 4; ++g4) {
                u32x2 w0; w0.x = pk2(O0[4 * g4] * inv, O0[4 * g4 + 1] * inv); w0.y = pk2(O0[4 * g4 + 2] * inv, O0[4 * g4 + 3] * inv);
                u32x2 w1; w1.x = pk2(O1[4 * g4] * inv, O1[4 * g4 + 1] * inv); w1.y = pk2(O1[4 * g4 + 2] * inv, O1[4 * g4 + 3] * inv);
                *(u32x2*)(op + 8 * g4) = w0; *(u32x2*)(op + 32 + 8 * g4) = w1;
            }
        }
    }
}

__global__ void __launch_bounds__(512, 2) mk_forward(Params P) {
    extern __shared__ __attribute__((aligned(16))) unsigned char lds_raw[];
    LAS unsigned char* lds = (LAS unsigned char*)lds_raw;
    cg::grid_group grid = cg::this_grid();
    unsigned char* ws = P.ws;
    float* MODv = (float*)(ws + O_MOD);
    float* Y = P.out + OUT_Y;
    for (int step = P.ph_lo; step < P.ph_hi; ++step) {
        bool is_gemm = false, sync_after = true;
        pg8::Gemm g; g.A = nullptr; g.Bt = nullptr; g.M = 0; g.N = 0; g.K = 0; g.lda = 0;
        Epi E; E.mode = EM_PLAIN; E.O = nullptr; E.ldc = 0; E.G = (const bf16_t*)(ws + O_G); E.T = (const bf16_t*)(ws + O_T); E.Y = Y; E.xp = Y; E.xs = Y + (size_t)MP * DM;
        E.MODv = MODv; E.gidx = 0; E.coef = 1.0f; E.bgate = P.in[I_BGATE]; E.ZA = (bf16_t*)(ws + O_ZA); E.Gw = (bf16_t*)(ws + O_G); E.ZS = (bf16_t*)(ws + O_ZS);
        switch (step) {
        case 0: prep_phase(P, lds); break;
        case 1: modulate_phase(P.in[I_XP], P.in[I_XS], P.in[I_GFFN1], MODv, 0, 1, (bf16_t*)(ws + O_H)); break;
        case 2: is_gemm = true; g.A = (const bf16_t*)(ws + O_H); g.lda = 1024; g.Bt = (const bf16_t*)(ws + O_W1U); g.M = MT; g.N = 2 * DFF; g.K = 1024; E.mode = EM_SWIGLU; E.O = (bf16_t*)(ws + O_ACT); break;
        case 3: is_gemm = true; g.A = (const bf16_t*)(ws + O_ACT); g.lda = DFF; g.Bt = (const bf16_t*)(ws + O_W1D); g.M = MT; g.N = 1024; g.K = DFF; E.mode = EM_RESID; E.xp = P.in[I_XP]; E.xs = P.in[I_XS]; E.gidx = 2; E.coef = 0.5f; break;
        case 4: modulate_phase(Y, Y + (size_t)MP * DM, P.in[I_GMIX], MODv, 3, 4, (bf16_t*)(ws + O_H)); break;
        case 5: is_gemm = true; g.A = (const bf16_t*)(ws + O_H); g.lda = 1024; g.Bt = (const bf16_t*)(ws + O_WIN); g.M = MT; g.N = NINP; g.K = 1024; E.mode = EM_WIN; break;
        case 6: rowpost_phase(P); break;
        case 7: gmlp_phase(P, lds); break;
        case 8: is_gemm = true; sync_after = false; g.A = (const bf16_t*)(ws + O_ZS); g.lda = 768; g.Bt = (const bf16_t*)(ws + O_WUQ); g.M = MT; g.N = 768; g.K = 384; E.mode = EM_PLAIN; E.O = (bf16_t*)(ws + O_QR); E.ldc = 768; break;
        case 9: is_gemm = true; sync_after = false; g.A = (const bf16_t*)(ws + O_CKV); g.lda = 256; g.Bt = (const bf16_t*)(ws + O_WUK); g.M = MKV; g.N = 512; g.K = 256; E.mode = EM_KNOPE; E.O = (bf16_t*)(ws + O_KF); break;
        case 10: is_gemm = true; g.A = (const bf16_t*)(ws + O_WUV); g.lda = 256; g.Bt = (const bf16_t*)(ws + O_CKV); g.M = 512; g.N = MKV; g.K = 256; E.mode = EM_PLAIN; E.O = (bf16_t*)(ws + O_VT); E.ldc = MKV; break;
        case 11: qkfinal_phase(P); break;
        case 12: attn_phase(P, lds); break;
        case 13: is_gemm = true; g.A = (const bf16_t*)(ws + O_OA); g.lda = 1024; g.Bt = (const bf16_t*)(ws + O_WBA); g.M = MT; g.N = 1024; g.K = 1024; E.mode = EM_BRA; E.O = (bf16_t*)(ws + O_T); break;
        case 14: is_gemm = true; g.A = (const bf16_t*)(ws + O_OB); g.lda = 512; g.Bt = (const bf16_t*)(ws + O_WBB); g.M = MT; g.N = 1024; g.K = 512; E.mode = EM_BRB; E.O = (bf16_t*)(ws + O_MG); break;
        case 15: is_gemm = true; g.A = (const bf16_t*)(ws + O_MG); g.lda = 1024; g.Bt = (const bf16_t*)(ws + O_WO); g.M = MT; g.N = 1024; g.K = 1024; E.mode = EM_RESID; E.gidx = 5; E.coef = 1.0f; break;
        case 16: modulate_phase(Y, Y + (size_t)MP * DM, P.in[I_GFFN2], MODv, 6, 7, (bf16_t*)(ws + O_H)); break;
        case 17: is_gemm = true; g.A = (const bf16_t*)(ws + O_H); g.lda = 1024; g.Bt = (const bf16_t*)(ws + O_W2U); g.M = MT; g.N = 2 * DFF; g.K = 1024; E.mode = EM_SWIGLU; E.O = (bf16_t*)(ws + O_ACT); break;
        case 18: is_gemm = true; g.A = (const bf16_t*)(ws + O_ACT); g.lda = DFF; g.Bt = (const bf16_t*)(ws + O_W2D); g.M = MT; g.N = 1024; g.K = DFF; E.mode = EM_RESID; E.gidx = 8; E.coef = 0.5f; break;
        default: break;
        }
        if (is_gemm) {
            pg8::StaticOrder S; S.init(g.M, g.N, (int)gridDim.x, (int)blockIdx.x);
            pg8::gemm_phase<Epi, pg8::StaticOrder>(lds, g, S, E);
        }
        if (sync_after && step + 1 < P.ph_hi) grid.sync();
    }
}

extern "C" void kernel_launch(void* const* d_in, const int* in_sizes, int n_in, void* d_out, int out_size, void* d_ws, size_t ws_size, hipStream_t stream) {
    static int grid = 0;
    if (grid == 0) {
        if (n_in != 30 || ws_size < WS_END) { fprintf(stderr, "kernel_launch: unexpected n_in %d or ws_size %zu (< %zu)\n", n_in, ws_size, (size_t)WS_END); grid = -1; return; }
        int dev = 0, cus = 0, per_cu = 0;
        hipGetDevice(&dev);
        hipDeviceGetAttribute(&cus, hipDeviceAttributeMultiprocessorCount, dev);
        if (hipFuncSetAttribute((const void*)mk_forward, hipFuncAttributeMaxDynamicSharedMemorySize, LDS_BYTES) != hipSuccess) fprintf(stderr, "kernel_launch: hipFuncSetAttribute failed\n");
        if (hipOccupancyMaxActiveBlocksPerMultiprocessor(&per_cu, (const void*)mk_forward, 512, LDS_BYTES) != hipSuccess || per_cu < 1) fprintf(stderr, "kernel_launch: occupancy query says %d blocks per CU\n", per_cu);
        (void)hipGetLastError();
        grid = cus > 0 ? cus : 256;
    }
    if (grid < 0) return;
    Params p{};
    for (int i = 0; i < 30; ++i) p.in[i] = (const float*)d_in[i];
    p.out = (float*)d_out; p.ws = (unsigned char*)d_ws; p.ph_lo = 0; p.ph_hi = NSTEPS;
    void* args[] = {&p};
    hipError_t e = hipLaunchCooperativeKernel((const void*)mk_forward, dim3(grid), dim3(512), args, LDS_BYTES, stream);
    if (e != hipSuccess) fprintf(stderr, "kernel_launch: cooperative launch failed: %s (grid %d)\n", hipGetErrorString(e), grid);
}
```

```cpp
#include <hip/hip_runtime.h>
#include <hip/hip_cooperative_groups.h>
#include <cstdio>
#include <cstdint>
namespace cg = cooperative_groups;

namespace pg8 {
#define PG8_LAS __attribute__((address_space(3)))
typedef unsigned short bf16_t;
typedef short bf16x8 __attribute__((ext_vector_type(8)));
typedef float f32x4 __attribute__((ext_vector_type(4)));
typedef unsigned u32x4 __attribute__((ext_vector_type(4)));
constexpr int BM = 256, BK = 64, HALF = 128, HTB = HALF * BK * 2  , STAGE_BYTES = 8 * HTB, NXCD = 8, WGM = 8;

__host__ __device__ __forceinline__ int lds_byte(int r, int c) { const int st = (r >> 4) * 2 + (c >> 5), rr = r & 15, cc = c & 31, ob = rr * 64 + cc * 2; return st * 1024 + (ob ^ (((ob >> 9) & 1) << 5)); }
__host__ __device__ __forceinline__ void stage_rc(int b, int& R, int& C) { const int st = b / 1024, sb = b % 1024, swz = sb ^ (((sb >> 9) & 1) << 5); R = (st >> 1) * 16 + swz / 64; C = (st & 1) * 32 + (swz % 64) / 2; }
__host__ __device__ __forceinline__ int perm32(int rho) { const int n = rho >> 4, i = rho & 15; return 8 * (i >> 2) + 4 * n + (i & 3); }

struct Unit { int pm, pn; };
struct Gemm { const bf16_t* A; const bf16_t* Bt; int M, N, K, lda; };

struct StaticOrder {
    int nM, nN, nwg, G, c;
    __host__ __device__ void init(int M, int N, int G_, int c_) { nM = M / BM; nN = N / BM; nwg = nM * nN; G = G_; c = c_; }
    __host__ __device__ bool next(int i, Unit& u) const {
        const long L = (long)i * G + c; if (L >= nwg) return false;
        int wgid = (int)L; { const int q = nwg / NXCD, r = nwg % NXCD, xcd = wgid % NXCD, off = wgid / NXCD; wgid = (xcd < r ? xcd * (q + 1) : r * (q + 1) + (xcd - r) * q) + off; }
        const int nig = WGM * nN, gid = wgid / nig, fm = gid * WGM, gsz = (nM - fm) < WGM ? (nM - fm) : WGM;
        u.pm = fm + ((wgid % nig) % gsz); u.pn = (wgid % nig) / gsz; return true;
    }
    __device__ __forceinline__ void a_ready(const Unit&) const {}
    __device__ __forceinline__ void done(const Unit&) const {}
};
__device__ __forceinline__ unsigned cvt_pk_bf16(float lo, float hi) { unsigned r; asm volatile("v_cvt_pk_bf16_f32 %0, %1, %2" : "=v"(r) : "v"(lo), "v"(hi)); return r; }

template <class Epi, class Sched>
__device__ __forceinline__ void gemm_phase(PG8_LAS unsigned char* lds, const Gemm g, const Sched& S, const Epi& E) {
    int tid_ = threadIdx.x; asm volatile("" : "+v"(tid_));
    const int tid = tid_, wid = __builtin_amdgcn_readfirstlane(tid >> 6), lane = tid & 63, wr = wid >> 2, wc = wid & 3, fr = lane & 15, fq = lane >> 4;
    const int K = g.K, nt = K / BK;
    unsigned voffA[2], voffB[2];
#pragma unroll
    for (int i = 0; i < 2; ++i) { int R, C; stage_rc(tid * 16 + i * 8192, R, C); const int Rb = Epi::PERM ? ((R & ~31) + perm32(R & 31)) : R;
        voffA[i] = (unsigned)(R * g.lda + C) * 2u; voffB[i] = (unsigned)(Rb * K + C) * 2u; }
    const size_t kstep = (size_t)(BK * 2);
    const size_t hstep = (size_t)HALF * K * 2, hstepA = (size_t)HALF * g.lda * 2;
    const size_t tstep = 2 * hstep, tstepA = 2 * hstepA;
    const unsigned ldsw = (unsigned)wid * 1024u;
    const int aoff = lds_byte(wr * 64 + fr, fq * 8), boff = lds_byte(wc * 32 + fr, fq * 8);
#define PG8_SA(b, h) (((b) * 2 + (h)) * HTB)
#define PG8_SB(b, h) ((4 + (b) * 2 + (h)) * HTB)
#define PG8_STAGE(bufoff, gbase, voff) do { _Pragma("unroll") for (int _i = 0; _i < 2; ++_i) \
        __builtin_amdgcn_global_load_lds((const unsigned*)((const char*)(gbase) + (voff)[_i]), (PG8_LAS unsigned*)(lds + (bufoff) + ldsw + _i * 8192), 16, 0, 0); } while (0)
#define PG8_LDA(dst, b, h) do { _Pragma("unroll") for (int m = 0; m < 4; ++m) _Pragma("unroll") for (int k = 0; k < 2; ++k) dst[m][k] = *(const PG8_LAS bf16x8*)(lds + PG8_SA(b, h) + aoff + m * 2048 + k * 1024); } while (0)
#define PG8_LDB(dst, b, h) do { _Pragma("unroll") for (int n = 0; n < 2; ++n) _Pragma("unroll") for (int k = 0; k < 2; ++k) dst[n][k] = *(const PG8_LAS bf16x8*)(lds + PG8_SB(b, h) + boff + n * 2048 + k * 1024); } while (0)
#define PG8_MMA(ai, bj, At, Bt) do { __builtin_amdgcn_s_setprio(1); _Pragma("unroll") for (int m = 0; m < 4; ++m) _Pragma("unroll") for (int n = 0; n < 2; ++n) _Pragma("unroll") for (int k = 0; k < 2; ++k) \
        acc[ai][bj][m][n] = __builtin_amdgcn_mfma_f32_16x16x32_bf16(Bt[n][k], At[m][k], acc[ai][bj][m][n], 0, 0, 0); __builtin_amdgcn_s_setprio(0); } while (0)
#define PG8_WAIT_V(n) asm volatile("s_waitcnt vmcnt(" #n ")" ::: "memory")
#define PG8_WAIT_L(n) asm volatile("s_waitcnt lgkmcnt(" #n ")" ::: "memory")
#define PG8_BAR __builtin_amdgcn_s_barrier()
#define PG8_SCHED __builtin_amdgcn_sched_barrier(0)
    Unit cur, nxt; int ui = 0;
    if (!S.next(0, cur)) return;
    f32x4 acc[2][2][4][2];
#pragma unroll
    for (int a = 0; a < 2; ++a)
#pragma unroll
        for (int b = 0; b < 2; ++b)
#pragma unroll
            for (int m = 0; m < 4; ++m)
#pragma unroll
                for (int n = 0; n < 2; ++n) acc[a][b][m][n] = (f32x4){0.f, 0.f, 0.f, 0.f};
    bf16x8 At[4][2], B0[2][2], B1[2][2];
    const char* cA = (const char*)g.A + (size_t)cur.pm * tstepA; const char* cB = (const char*)g.Bt + (size_t)cur.pn * tstep;
    S.a_ready(cur);
    PG8_STAGE(PG8_SB(0, 0), cB, voffB); PG8_STAGE(PG8_SA(0, 0), cA, voffA); PG8_STAGE(PG8_SB(0, 1), cB + hstep, voffB); PG8_STAGE(PG8_SA(0, 1), cA + hstepA, voffA);
    if (wr == 1) PG8_BAR;
    PG8_WAIT_V(4); PG8_BAR;
    PG8_STAGE(PG8_SB(1, 0), cB + kstep, voffB); PG8_STAGE(PG8_SA(1, 0), cA + kstep, voffA); PG8_STAGE(PG8_SB(1, 1), cB + hstep + kstep, voffB);
    PG8_WAIT_V(6); PG8_BAR;
    for (;;) {
        const bool has_next = S.next(ui + 1, nxt);
        const char* nA = has_next ? (const char*)g.A + (size_t)nxt.pm * tstepA : cA; const char* nB = has_next ? (const char*)g.Bt + (size_t)nxt.pn * tstep : cB;
        for (int t = 0; t < nt; t += 2) {
            const bool last = (t == nt - 2);
            const char* a1 = cA + (size_t)(t + 1) * kstep;
            const char* a2 = last ? nA : cA + (size_t)(t + 2) * kstep; const char* b2 = last ? nB : cB + (size_t)(t + 2) * kstep;
            const char* a3 = a2 + kstep; const char* b3 = b2 + kstep;
            if (last && has_next) S.a_ready(nxt);
            PG8_LDB(B0, 0, 0); PG8_SCHED; PG8_LDA(At, 0, 0); PG8_STAGE(PG8_SA(1, 1), a1 + hstepA, voffA);
            PG8_WAIT_L(8); PG8_BAR; PG8_WAIT_L(0); PG8_MMA(0, 0, At, B0); PG8_BAR; PG8_SCHED;
            PG8_LDB(B1, 0, 1); PG8_STAGE(PG8_SB(0, 0), b2, voffB);
            PG8_BAR; PG8_WAIT_L(0); PG8_MMA(0, 1, At, B1); PG8_BAR;
            PG8_LDA(At, 0, 1); PG8_STAGE(PG8_SA(0, 0), a2, voffA);
            PG8_BAR; PG8_WAIT_L(0); PG8_MMA(1, 0, At, B0); PG8_BAR; PG8_SCHED;
            PG8_STAGE(PG8_SB(0, 1), b2 + hstep, voffB);
            PG8_WAIT_V(6); PG8_BAR; PG8_MMA(1, 1, At, B1); PG8_BAR;
            PG8_LDB(B0, 1, 0); PG8_SCHED; PG8_LDA(At, 1, 0); PG8_STAGE(PG8_SA(0, 1), a2 + hstepA, voffA);
            PG8_WAIT_L(8); PG8_BAR; PG8_WAIT_L(0); PG8_MMA(0, 0, At, B0); PG8_BAR; PG8_SCHED;
            PG8_LDB(B1, 1, 1); PG8_STAGE(PG8_SB(1, 0), b3, voffB);
            PG8_BAR; PG8_WAIT_L(0); PG8_MMA(0, 1, At, B1); PG8_BAR;
            PG8_LDA(At, 1, 1); PG8_STAGE(PG8_SA(1, 0), a3, voffA);
            PG8_BAR; PG8_WAIT_L(0); PG8_MMA(1, 0, At, B0); PG8_BAR; PG8_SCHED;
            PG8_STAGE(PG8_SB(1, 1), b3 + hstep, voffB);
            PG8_WAIT_V(6); PG8_BAR; PG8_MMA(1, 1, At, B1); PG8_BAR;
        }
        if constexpr (!Epi::AFTER_DRAIN) { E(acc, cur, wr, wc, fr, fq); S.done(cur); }
        if (!has_next) break;
#pragma unroll
        for (int a = 0; a < 2; ++a)
#pragma unroll
            for (int b = 0; b < 2; ++b)
#pragma unroll
                for (int m = 0; m < 4; ++m)
#pragma unroll
                    for (int n = 0; n < 2; ++n) acc[a][b][m][n] = (f32x4){0.f, 0.f, 0.f, 0.f};
        cur = nxt; cA = nA; cB = nB; ++ui;
    }
    PG8_WAIT_V(0);
    if (wr == 0) PG8_BAR;
    PG8_BAR;
    if constexpr (Epi::AFTER_DRAIN) { E.fused(acc, cur, wr, wc, fr, fq, lds, wid, lane); S.done(cur); }
#undef PG8_SA
#undef PG8_SB
#undef PG8_STAGE
#undef PG8_LDA
#undef PG8_LDB
#undef PG8_MMA
#undef PG8_WAIT_V
#undef PG8_WAIT_L
#undef PG8_BAR
#undef PG8_SCHED
}

}

#define LAS __attribute__((address_space(3)))
using pg8::bf16_t; using pg8::bf16x8; using pg8::f32x4; using pg8::u32x4;
typedef float f32x16 __attribute__((ext_vector_type(16)));
typedef float f32x2 __attribute__((ext_vector_type(2)));
typedef unsigned u32x2 __attribute__((ext_vector_type(2)));
typedef __bf16 bf16x2v __attribute__((ext_vector_type(2)));

constexpr int DM = 1024, MP = 65536, MS = 512, MT = MP + MS  , MC = 32768, MKV = MT + MC  ;
constexpr int DFF = 2816, NINP = 4864, NMODC = 9216;
constexpr float EPSF = 1e-6f;
constexpr int LDS_BYTES = 131072 + 256;
constexpr int NSTEPS = 19;
#define STAGGER_MODE 0
#define PROBE_DUP -1

constexpr size_t al256(size_t x) { return (x + 255) & ~(size_t)255; }
constexpr size_t O_CTL = 0;
constexpr size_t O_MOD = 256;
constexpr size_t O_RV  = al256(O_MOD + (size_t)40 * NMODC * 4);
constexpr size_t O_W1U = al256(O_RV + (size_t)MT * 4);
constexpr size_t O_W1D = O_W1U + (size_t)2 * DFF * DM * 2;
constexpr size_t O_W2U = O_W1D + (size_t)DM * DFF * 2;
constexpr size_t O_W2D = O_W2U + (size_t)2 * DFF * DM * 2;
constexpr size_t O_WIN = O_W2D + (size_t)DM * DFF * 2;
constexpr size_t O_WUQ = O_WIN + (size_t)NINP * DM * 2;
constexpr size_t O_WUK = O_WUQ + (size_t)768 * 384 * 2;
constexpr size_t O_WUV = O_WUK + (size_t)512 * 256 * 2;
constexpr size_t O_WBA = O_WUV + (size_t)512 * 256 * 2;
constexpr size_t O_WBB = O_WBA + (size_t)1024 * 1024 * 2;
constexpr size_t O_WO  = O_WBB + (size_t)1024 * 512 * 2;
constexpr size_t O_WS  = O_WO + (size_t)1024 * 1024 * 2;
constexpr size_t O_H   = al256(O_WS + (size_t)8 * 128 * 128 * 2);
constexpr size_t O_ZA  = O_H + (size_t)MT * 1024 * 2;
constexpr size_t O_G   = O_ZA + (size_t)MT * 2048 * 2;
constexpr size_t O_ZS  = O_G + (size_t)MT * 2048 * 2;
constexpr size_t O_KF  = O_ZS + (size_t)MT * 768 * 2;
constexpr size_t O_CKV = O_KF + (size_t)MKV * 768 * 2;
constexpr size_t O_KR  = O_CKV + (size_t)MKV * 256 * 2;
constexpr size_t O_KRSS = O_KR + (size_t)MKV * 32 * 4;
constexpr size_t O_BAR = al256(O_KRSS + (size_t)MKV * 4);
constexpr size_t O_T2 = O_BAR + 16384;
constexpr size_t WS_END = O_T2 + (size_t)MS * 1024 * 2;
constexpr size_t O_ACT = O_ZA;
constexpr size_t O_QR  = O_ZA;
constexpr size_t O_VT  = O_ZA + (size_t)MT * 768 * 2;
constexpr size_t O_T   = O_ZA;
constexpr size_t O_MG  = O_ZA + (size_t)MT * 1024 * 2;
constexpr size_t O_OB  = O_ZS;
constexpr size_t O_X2  = O_ZS;
constexpr size_t O_OA  = O_H;
static_assert((size_t)MT * 768 * 2 + (size_t)512 * MKV * 2 <= (size_t)MT * 2048 * 2, "QR+VT must fit in ZA");
static_assert((size_t)MT * DFF * 2 <= (size_t)MT * 4096 * 2, "ACT must fit in ZA+G");

constexpr size_t OUT_Y = 0;
constexpr size_t OUT_CKVP = (size_t)MT * 1024;
constexpr size_t OUT_KRP = OUT_CKVP + (size_t)MP * 256;
constexpr size_t OUT_CKVS = OUT_KRP + (size_t)MP * 32;
constexpr size_t OUT_KRS = OUT_CKVS + (size_t)MS * 256;
constexpr size_t OUT_GV = OUT_KRS + (size_t)MS * 32;

enum { I_XP = 0, I_XS, I_CP, I_CS, I_CCKV, I_CKR, I_WMOD, I_BMOD, I_GFFN1, I_W1U, I_W1D, I_GMIX, I_WIN, I_GGV, I_GWS, I_GB, I_GQL, I_WUQ, I_GKVL, I_WUK, I_WUV,
       I_GQN, I_GKN, I_BGATE, I_WBA, I_WBB, I_WO, I_GFFN2, I_W2U, I_W2D };

struct Params {
    const float* in[30];
    float* out;
    unsigned char* ws;
    int ph_lo, ph_hi;
};

__device__ __forceinline__ unsigned pk2(float lo, float hi) { f32x2 v = {lo, hi}; bf16x2v b = __builtin_convertvector(v, bf16x2v); return __builtin_bit_cast(unsigned, b); }
__device__ __forceinline__ float bflo(unsigned w) { return __uint_as_float(w << 16); }
__device__ __forceinline__ float bfhi(unsigned w) { return __uint_as_float(w & 0xffff0000u); }
__device__ __forceinline__ float bf2f(bf16_t b) { return __uint_as_float((unsigned)b << 16); }
__device__ __forceinline__ bf16_t f2bf(float x) { return (bf16_t)(pk2(x, 0.f) & 0xffffu); }
__device__ __forceinline__ float wave_sum(float v) {
#pragma unroll
    for (int o = 1; o < 64; o <<= 1) v += __shfl_xor(v, o);
    return v;
}
__device__ __forceinline__ float fast_exp2(float x) { return __builtin_amdgcn_exp2f(x); }
__device__ __forceinline__ float sigmoidf_(float x) { return __builtin_amdgcn_rcpf(1.0f + fast_exp2(-1.4426950408889634f * x)); }
__device__ __forceinline__ float siluf_(float x) { return x * sigmoidf_(x); }
__device__ __forceinline__ float gelu_tanh(float x) { const float y = 1.5957691216057308f * (x + 0.044715f * x * x * x); return x * sigmoidf_(y); }
__device__ __forceinline__ int batch_of(int row) { return row < MP ? (row >> 11) : 32 + ((row - MP) >> 6); }
__device__ __forceinline__ float pos_of(int row) { return row < MP ? (float)(row & 2047) : (float)(4096 + ((row - MP) & 63)); }
__device__ __forceinline__ void rope_sc(float pos, int i, float& sn, float& cs) {
    const float freq = exp2f(-(float)i * (13.287712379549449f / 16.0f));
    const float ang = pos * freq;
    float rev = ang * 0.15915494309189535f; rev = rev - floorf(rev);
    sn = __builtin_amdgcn_sinf(rev); cs = __builtin_amdgcn_cosf(rev);
}

enum { EM_SWIGLU = 0, EM_RESID, EM_WIN, EM_PLAIN, EM_KNOPE, EM_BRA, EM_BRB, EM_RESID_B2B, EM_RESID_B2F };
struct Epi {
    static constexpr bool PERM = true, AFTER_DRAIN = false;
    int mode, sub, gidx, row_off; float coef;
    unsigned char* ws; float* Y; const float* xp; const float* xs; const float* bgate;
    __device__ __forceinline__ void operator()(const f32x4 (&acc)[2][2][4][2], const pg8::Unit& u, int wr, int wc, int fr, int fq) const {
        const int row0 = row_off + u.pm * 256 + wr * 64 + fr, cl = wc * 32 + 8 * fq;
        const float* MODv = (const float*)(ws + O_MOD);
        bf16_t* O = (bf16_t*)(ws + (mode == EM_SWIGLU ? O_ACT : mode == EM_KNOPE ? O_KF : mode == EM_BRA ? O_T : mode == EM_BRB ? O_MG : (sub == 0 ? O_QR : O_VT)));
        if (mode == EM_BRA && (row_off + u.pm * 256) >= MP) O = (bf16_t*)(ws + O_T2) - (size_t)MP * 1024;
        const int ldc = sub == 0 ? 768 : MKV;
        const bool srows = (row_off + u.pm * 256) >= MP;
        const bf16_t* G = (const bf16_t*)(ws + O_G); const bf16_t* T = srows ? (const bf16_t*)(ws + O_T2) - (size_t)MP * 1024 : (const bf16_t*)(ws + O_T);
        bf16_t* ZA = (bf16_t*)(ws + O_ZA); bf16_t* Gw = (bf16_t*)(ws + O_G); bf16_t* ZS = (bf16_t*)(ws + O_ZS);
        const bf16_t* xb = (mode == EM_RESID_B2B) ? (const bf16_t*)Y : (const bf16_t*)(ws + O_X2);
        bf16_t* yb = (mode == EM_RESID) ? (bf16_t*)Y : (bf16_t*)(ws + O_X2);
        if (mode == EM_SWIGLU) {
#pragma unroll
            for (int ai = 0; ai < 2; ++ai)
#pragma unroll
                for (int m = 0; m < 4; ++m) {
                    const int r = row0 + ai * 128 + m * 16;
                    float o[8];
#pragma unroll
                    for (int n = 0; n < 2; ++n)
#pragma unroll
                        for (int j = 0; j < 4; ++j) { const float g = acc[ai][0][m][n][j], uu = acc[ai][1][m][n][j]; o[4 * n + j] = siluf_(g) * uu; }
                    u32x4 w; w.x = pk2(o[0], o[1]); w.y = pk2(o[2], o[3]); w.z = pk2(o[4], o[5]); w.w = pk2(o[6], o[7]);
                    *(u32x4*)(O + (size_t)r * DFF + u.pn * 128 + cl) = w;
                }
        } else if (mode == EM_RESID) {
            const int c0 = u.pn * 256 + cl;
#pragma unroll
            for (int ai = 0; ai < 2; ++ai) {
                f32x4 gg[2][2];
                const float* gt = MODv + (size_t)batch_of(row0 + ai * 128) * NMODC + gidx * DM;
#pragma unroll
                for (int bj = 0; bj < 2; ++bj)
#pragma unroll
                    for (int n = 0; n < 2; ++n) gg[bj][n] = *(const f32x4*)(gt + c0 + bj * 128 + 4 * n) * coef;
#pragma unroll
                for (int mh = 0; mh < 2; ++mh) {
                    f32x4 bs[2][2][2];
#pragma unroll
                    for (int mm = 0; mm < 2; ++mm) { const int r = row0 + ai * 128 + (2 * mh + mm) * 16; const float* base = (r < MP) ? xp + (size_t)r * DM : xs + (size_t)(r - MP) * DM;
#pragma unroll
                        for (int bj = 0; bj < 2; ++bj)
#pragma unroll
                            for (int n = 0; n < 2; ++n) bs[mm][bj][n] = *(const f32x4*)(base + c0 + bj * 128 + 4 * n); }
                    asm volatile("" ::: "memory");
#pragma unroll
                    for (int mm = 0; mm < 2; ++mm) { const int m = 2 * mh + mm; const int r = row0 + ai * 128 + m * 16;
#pragma unroll
                        for (int bj = 0; bj < 2; ++bj) {
                            const f32x4 o0 = bs[mm][bj][0] + gg[bj][0] * acc[ai][bj][m][0], o1 = bs[mm][bj][1] + gg[bj][1] * acc[ai][bj][m][1];
                            u32x4 w; w.x = pk2(o0[0], o0[1]); w.y = pk2(o0[2], o0[3]); w.z = pk2(o1[0], o1[1]); w.w = pk2(o1[2], o1[3]);
                            *(u32x4*)(yb + (size_t)r * DM + c0 + bj * 128) = w;
                        } }
                    asm volatile("" ::: "memory");
                }
            }
        } else if (mode == EM_RESID_B2B || mode == EM_RESID_B2F) {
            const int c0 = u.pn * 256 + cl;
            const bool tof32 = (mode == EM_RESID_B2F);
#pragma unroll
            for (int ai = 0; ai < 2; ++ai) {
                u32x4 bs[4][2]; f32x4 gg[2][2];
                const bf16_t* xrow = xb + (size_t)(row0 + ai * 128) * DM + c0;
#pragma unroll
                for (int m = 0; m < 4; ++m)
#pragma unroll
                    for (int bj = 0; bj < 2; ++bj) bs[m][bj] = *(const u32x4*)(xrow + (size_t)m * 16 * DM + bj * 128);
                const float* gt = MODv + (size_t)batch_of(row0 + ai * 128) * NMODC + gidx * DM;
#pragma unroll
                for (int bj = 0; bj < 2; ++bj)
#pragma unroll
                    for (int n = 0; n < 2; ++n) gg[bj][n] = *(const f32x4*)(gt + c0 + bj * 128 + 4 * n) * coef;
                asm volatile("" ::: "memory");
#pragma unroll
                for (int m = 0; m < 4; ++m) {
                    const int r = row0 + ai * 128 + m * 16;
#pragma unroll
                    for (int bj = 0; bj < 2; ++bj) {
                        const u32x4 bw = bs[m][bj];
                        const f32x4 b0 = {bflo(bw.x), bfhi(bw.x), bflo(bw.y), bfhi(bw.y)}, b1 = {bflo(bw.z), bfhi(bw.z), bflo(bw.w), bfhi(bw.w)};
                        const f32x4 o0 = b0 + gg[bj][0] * acc[ai][bj][m][0], o1 = b1 + gg[bj][1] * acc[ai][bj][m][1];
                        if (tof32) { float* yo = Y + (size_t)r * DM + c0 + bj * 128; *(f32x4*)yo = o0; *(f32x4*)(yo + 4) = o1; }
                        else { u32x4 w; w.x = pk2(o0[0], o0[1]); w.y = pk2(o0[2], o0[3]); w.z = pk2(o1[0], o1[1]); w.w = pk2(o1[2], o1[3]);
                               *(u32x4*)(yb + (size_t)r * DM + c0 + bj * 128) = w; }
                    }
                }
                asm volatile("" ::: "memory");
            }
        } else if (mode == EM_WIN) {
            const int sel = u.pn < 8 ? 0 : (u.pn < 16 ? 1 : 2);
#pragma unroll
            for (int ai = 0; ai < 2; ++ai)
#pragma unroll
                for (int m = 0; m < 4; ++m) {
                    const int r = row0 + ai * 128 + m * 16;
#pragma unroll
                    for (int bj = 0; bj < 2; ++bj) {
                        float o[8];
#pragma unroll
                        for (int n = 0; n < 2; ++n)
#pragma unroll
                            for (int j = 0; j < 4; ++j) o[4 * n + j] = acc[ai][bj][m][n][j];
                        bf16_t* dst;
                        if (sel == 0) {
                            const int c = u.pn * 256 + bj * 128 + cl;
                            dst = ZA + (size_t)r * 2048 + c;
                        } else if (sel == 1) {
                            const int c = (u.pn - 8) * 256 + bj * 128 + cl;
                            const f32x4 b0 = *(const f32x4*)(bgate + c), b1 = *(const f32x4*)(bgate + c + 4);
#pragma unroll
                            for (int j = 0; j < 4; ++j) { o[j] = sigmoidf_(o[j] + b0[j]); o[4 + j] = sigmoidf_(o[4 + j] + b1[j]); }
                            dst = Gw + (size_t)r * 2048 + c;
                        } else {
                            const int c = (u.pn - 16) * 256 + bj * 128 + cl;
                            dst = ZS + (size_t)r * 768 + c;
                        }
                        u32x4 w; w.x = pk2(o[0], o[1]); w.y = pk2(o[2], o[3]); w.z = pk2(o[4], o[5]); w.w = pk2(o[6], o[7]);
                        *(u32x4*)dst = w;
                    }
                }
        } else if (mode == EM_KNOPE) {
            const int head = u.pn * 4 + wc;
            const float* gkn = bgate;
            const float* KRp = (const float*)(ws + O_KR); const float* KSS = (const float*)(ws + O_KRSS);
            f32x4 gn[2][2], gr[2];
#pragma unroll
            for (int bj = 0; bj < 2; ++bj) { gn[bj][0] = *(const f32x4*)(gkn + bj * 32 + 8 * fq); gn[bj][1] = *(const f32x4*)(gkn + bj * 32 + 8 * fq + 4); }
            gr[0] = *(const f32x4*)(gkn + 64 + 8 * fq); gr[1] = *(const f32x4*)(gkn + 64 + 8 * fq + 4);
#pragma unroll
            for (int ai = 0; ai < 2; ++ai)
#pragma unroll
                for (int m = 0; m < 4; ++m) {
                    const int r = row0 + ai * 128 + m * 16;
                    const f32x4 k0 = *(const f32x4*)(KRp + (size_t)r * 32 + 8 * fq), k1 = *(const f32x4*)(KRp + (size_t)r * 32 + 8 * fq + 4);
                    const float krss = KSS[r];
                    float ss = 0.f;
#pragma unroll
                    for (int bj = 0; bj < 2; ++bj)
#pragma unroll
                        for (int n = 0; n < 2; ++n) { const f32x4 v = acc[ai][bj][m][n]; ss += (v[0] * v[0] + v[1] * v[1]) + (v[2] * v[2] + v[3] * v[3]); }
                    ss += __shfl_xor(ss, 16); ss += __shfl_xor(ss, 32);
                    const float rinv = rsqrtf((ss + krss) * (1.0f / 96.0f) + EPSF);
                    bf16_t* dst = O + (size_t)r * 768 + head * 96;
#pragma unroll
                    for (int bj = 0; bj < 2; ++bj) {
                        const f32x4 v0 = acc[ai][bj][m][0] * gn[bj][0] * rinv, v1 = acc[ai][bj][m][1] * gn[bj][1] * rinv;
                        u32x4 w; w.x = pk2(v0[0], v0[1]); w.y = pk2(v0[2], v0[3]); w.z = pk2(v1[0], v1[1]); w.w = pk2(v1[2], v1[3]);
                        *(u32x4*)(dst + bj * 32 + 8 * fq) = w;
                    }
                    { const f32x4 v0 = k0 * gr[0] * rinv, v1 = k1 * gr[1] * rinv;
                      u32x4 w; w.x = pk2(v0[0], v0[1]); w.y = pk2(v0[2], v0[3]); w.z = pk2(v1[0], v1[1]); w.w = pk2(v1[2], v1[3]);
                      *(u32x4*)(dst + 64 + 8 * fq) = w; }
                }
        } else if (mode == EM_PLAIN) {
#pragma unroll
            for (int ai = 0; ai < 2; ++ai)
#pragma unroll
                for (int m = 0; m < 4; ++m) {
                    const int r = row0 + ai * 128 + m * 16;
#pragma unroll
                    for (int bj = 0; bj < 2; ++bj) {
                        const int c = u.pn * 256 + bj * 128 + cl;
                        const f32x4 v0 = acc[ai][bj][m][0], v1 = acc[ai][bj][m][1];
                        u32x4 w; w.x = pk2(v0[0], v0[1]); w.y = pk2(v0[2], v0[3]); w.z = pk2(v1[0], v1[1]); w.w = pk2(v1[2], v1[3]);
                        *(u32x4*)(O + (size_t)r * ldc + c) = w;
                    }
                }
        } else {
            const int c0 = u.pn * 256 + cl;
            const bool isb = (mode == EM_BRB);
#pragma unroll
            for (int ai = 0; ai < 2; ++ai) {
                u32x4 gs[4][2], ts[4][2];
                const bf16_t* grow = G + (size_t)(row0 + ai * 128) * 2048 + (isb ? 1024 : 0) + c0;
                const bf16_t* trow = T + (size_t)(row0 + ai * 128) * 1024 + c0;
#pragma unroll
                for (int m = 0; m < 4; ++m)
#pragma unroll
                    for (int bj = 0; bj < 2; ++bj) { gs[m][bj] = *(const u32x4*)(grow + (size_t)m * 16 * 2048 + bj * 128);
                        ts[m][bj] = isb ? *(const u32x4*)(trow + (size_t)m * 16 * 1024 + bj * 128) : (u32x4){0u, 0u, 0u, 0u}; }
                asm volatile("" ::: "memory");
#pragma unroll
                for (int m = 0; m < 4; ++m) { const int r = row0 + ai * 128 + m * 16;
#pragma unroll
                    for (int bj = 0; bj < 2; ++bj) {
                        const u32x4 gw = gs[m][bj], tw = ts[m][bj];
                        const f32x4 v0 = acc[ai][bj][m][0], v1 = acc[ai][bj][m][1];
                        float o[8];
                        o[0] = bflo(gw.x) * v0[0]; o[1] = bfhi(gw.x) * v0[1]; o[2] = bflo(gw.y) * v0[2]; o[3] = bfhi(gw.y) * v0[3];
                        o[4] = bflo(gw.z) * v1[0]; o[5] = bfhi(gw.z) * v1[1]; o[6] = bflo(gw.w) * v1[2]; o[7] = bfhi(gw.w) * v1[3];
                        if (isb) { o[0] += bflo(tw.x); o[1] += bfhi(tw.x); o[2] += bflo(tw.y); o[3] += bfhi(tw.y);
                                   o[4] += bflo(tw.z); o[5] += bfhi(tw.z); o[6] += bflo(tw.w); o[7] += bfhi(tw.w); }
                        u32x4 w; w.x = pk2(o[0], o[1]); w.y = pk2(o[2], o[3]); w.z = pk2(o[4], o[5]); w.w = pk2(o[6], o[7]);
                        *(u32x4*)(O + (size_t)r * 1024 + c0 + bj * 128) = w;
                    } }
                asm volatile("" ::: "memory");
            }
        }
    }
};

template <class MapF>
__device__ __forceinline__ void conv_wT(const float* __restrict__ W, int K, int Nsrc, bf16_t* __restrict__ Bt, int Ndst, MapF map, size_t gtid, size_t gsz) {
    const size_t total = (size_t)Ndst * (size_t)(K / 8);
    for (size_t i = gtid; i < total; i += gsz) {
        const int n = (int)(i % (size_t)Ndst), kb = (int)(i / (size_t)Ndst);
        const int src = map(n);
        u32x4 o = {0u, 0u, 0u, 0u};
        if (src >= 0) {
            const float* p = W + (size_t)(kb * 8) * Nsrc + src;
            const float v0 = p[0], v1 = p[(size_t)Nsrc], v2 = p[(size_t)2 * Nsrc], v3 = p[(size_t)3 * Nsrc], v4 = p[(size_t)4 * Nsrc], v5 = p[(size_t)5 * Nsrc], v6 = p[(size_t)6 * Nsrc], v7 = p[(size_t)7 * Nsrc];
            o.x = pk2(v0, v1); o.y = pk2(v2, v3); o.z = pk2(v4, v5); o.w = pk2(v6, v7);
        }
        *(u32x4*)(Bt + (size_t)n * K + kb * 8) = o;
    }
}
struct MapId { __device__ __forceinline__ int operator()(int n) const { return n; } };
struct MapUp { __device__ __forceinline__ int operator()(int n) const { const int t = n >> 8, l = n & 255; return l < 128 ? t * 128 + l : DFF + t * 128 + (l - 128); } };
struct MapUk { __device__ __forceinline__ int operator()(int n) const { const int pn = n >> 8, bj = (n >> 7) & 1, wc = (n >> 5) & 3, x = n & 31; return (pn * 4 + wc) * 64 + bj * 32 + x; } };
struct MapIn { __device__ __forceinline__ int operator()(int n) const { return n < 2048 ? n : (n < 4096 ? 2720 + (n - 2048) : (n < 4768 ? 2048 + (n - 4096) : -1)); } };

__device__ __forceinline__ void prep_phase(const Params& P, LAS unsigned char* lds) {
    int tid_ = threadIdx.x; asm volatile("" : "+v"(tid_));
    const int tid = tid_, lane = tid & 63, wid = __builtin_amdgcn_readfirstlane(tid >> 6);
    const size_t gtid = (size_t)blockIdx.x * 512 + tid, gsz = (size_t)gridDim.x * 512;
    unsigned char* ws = P.ws;
    if (gtid < 64) ((unsigned*)(ws + O_CTL))[gtid] = 0u;
    if (blockIdx.x < NMODC / 64) {
        const int n0 = blockIdx.x * 64;
        const float* cp = P.in[I_CP]; const float* cs = P.in[I_CS]; const float* wm = P.in[I_WMOD];
        LAS float* sc = (LAS float*)lds;
        float acc[40];
#pragma unroll
        for (int b = 0; b < 40; ++b) acc[b] = 0.f;
        for (int half = 0; half < 2; ++half) {
            __syncthreads();
            for (int i = tid; i < 40 * 512; i += 512) { const int b = i >> 9, k = i & 511; const float c = b < 32 ? cp[b * 1024 + half * 512 + k] : cs[(b - 32) * 1024 + half * 512 + k]; sc[i] = siluf_(c); }
            __syncthreads();
            for (int kk = 0; kk < 64; kk += 4) {
                const int kl = wid * 64 + kk; const size_t kg = (size_t)(half * 512 + kl);
                const float w0 = wm[kg * NMODC + n0 + lane], w1 = wm[(kg + 1) * NMODC + n0 + lane], w2 = wm[(kg + 2) * NMODC + n0 + lane], w3 = wm[(kg + 3) * NMODC + n0 + lane];
#pragma unroll
                for (int b = 0; b < 40; ++b) { const f32x4 s = *(const LAS f32x4*)(sc + b * 512 + kl); acc[b] += s.x * w0 + s.y * w1 + s.z * w2 + s.w * w3; }
            }
        }
        __syncthreads();
        LAS float* red = (LAS float*)lds;
#pragma unroll
        for (int b = 0; b < 40; ++b) red[(wid * 40 + b) * 64 + lane] = acc[b];
        __syncthreads();
        float* MODv = (float*)(ws + O_MOD); const float* bm = P.in[I_BMOD];
        for (int i = tid; i < 40 * 64; i += 512) { const int b = i >> 6, l = i & 63; float s = bm[n0 + l];
#pragma unroll
            for (int w = 0; w < 8; ++w) s += red[(w * 40 + b) * 64 + l];
            MODv[(size_t)b * NMODC + n0 + l] = s; }
        __syncthreads();
    }
    conv_wT(P.in[I_W1U], 1024, 2 * DFF, (bf16_t*)(ws + O_W1U), 2 * DFF, MapUp(), gtid, gsz);
    conv_wT(P.in[I_W2U], 1024, 2 * DFF, (bf16_t*)(ws + O_W2U), 2 * DFF, MapUp(), gtid, gsz);
    conv_wT(P.in[I_W1D], DFF, 1024, (bf16_t*)(ws + O_W1D), 1024, MapId(), gtid, gsz);
    conv_wT(P.in[I_W2D], DFF, 1024, (bf16_t*)(ws + O_W2D), 1024, MapId(), gtid, gsz);
    conv_wT(P.in[I_WIN], 1024, 4768, (bf16_t*)(ws + O_WIN), NINP, MapIn(), gtid, gsz);
    conv_wT(P.in[I_WUQ], 384, 768, (bf16_t*)(ws + O_WUQ), 768, MapId(), gtid, gsz);
    conv_wT(P.in[I_WUK], 256, 512, (bf16_t*)(ws + O_WUK), 512, MapUk(), gtid, gsz);
    conv_wT(P.in[I_WUV], 256, 512, (bf16_t*)(ws + O_WUV), 512, MapId(), gtid, gsz);
    conv_wT(P.in[I_WBA], 1024, 1024, (bf16_t*)(ws + O_WBA), 1024, MapId(), gtid, gsz);
    conv_wT(P.in[I_WBB], 512, 1024, (bf16_t*)(ws + O_WBB), 1024, MapId(), gtid, gsz);
    conv_wT(P.in[I_WO], 1024, 1024, (bf16_t*)(ws + O_WO), 1024, MapId(), gtid, gsz);
    { const float* w = P.in[I_GWS]; bf16_t* o = (bf16_t*)(ws + O_WS);
      for (size_t i = gtid; i < (size_t)8 * 128 * 128; i += gsz) { const int s = (int)(i & 127), t = (int)((i >> 7) & 127); o[i] = f2bf(s <= t ? w[i] : 0.f); } }
    { const float* c = P.in[I_CCKV]; bf16_t* o = (bf16_t*)(ws + O_CKV) + (size_t)MT * 256;
      for (size_t i = gtid; i < (size_t)MC * 256 / 4; i += gsz) { const f32x4 v = *(const f32x4*)(c + 4 * i); u32x2 w; w.x = pk2(v.x, v.y); w.y = pk2(v.z, v.w); *(u32x2*)(o + 4 * i) = w; }
      const float* kr = P.in[I_CKR]; float* ko = (float*)(ws + O_KR) + (size_t)MT * 32; float* kss = (float*)(ws + O_KRSS) + MT;
      for (size_t i = gtid; i < (size_t)MC; i += gsz) { float ss = 0.f;
#pragma unroll
          for (int j = 0; j < 8; ++j) { const f32x4 v = *(const f32x4*)(kr + 32 * i + 4 * j); *(f32x4*)(ko + 32 * i + 4 * j) = v; ss += (v.x * v.x + v.y * v.y) + (v.z * v.z + v.w * v.w); }
          kss[i] = ss; } }
}

__device__ __forceinline__ void modulate_phase(const float* xp, const float* xs, const float* g, const float* MODv, int ish, int isc, bf16_t* H) {
    int tid_ = threadIdx.x; asm volatile("" : "+v"(tid_));
    const int tid = tid_, lane = tid & 63, wid = tid >> 6;
    const int gw = blockIdx.x * 8 + wid, ngw = gridDim.x * 8;
    f32x4 v[4][4], vn[4][4];
#define MOD_LOAD(dst, rb) do { _Pragma("unroll") for (int q = 0; q < 4; ++q) { const int row_ = (rb) + q * ngw; \
            if (row_ < MT) { const float* x_ = row_ < MP ? xp + (size_t)row_ * DM : xs + (size_t)(row_ - MP) * DM; \
                _Pragma("unroll") for (int j = 0; j < 4; ++j) dst[q][j] = *(const f32x4*)(x_ + 4 * lane + 256 * j); } \
            else { _Pragma("unroll") for (int j = 0; j < 4; ++j) dst[q][j] = (f32x4){0.f, 0.f, 0.f, 0.f}; } } } while (0)
    MOD_LOAD(v, gw);
    for (int rowb = gw; rowb < MT; rowb += 4 * ngw) {
        if (rowb + 4 * ngw < MT) MOD_LOAD(vn, rowb + 4 * ngw);
        float ss[4];
#pragma unroll
        for (int q = 0; q < 4; ++q) { float t = 0.f;
#pragma unroll
            for (int j = 0; j < 4; ++j) t += (v[q][j].x * v[q][j].x + v[q][j].y * v[q][j].y) + (v[q][j].z * v[q][j].z + v[q][j].w * v[q][j].w);
            ss[q] = wave_sum(t); }
#pragma unroll
        for (int q = 0; q < 4; ++q) {
            const int row = rowb + q * ngw;
            if (row < MT) {
                const float* mb = MODv + (size_t)batch_of(row) * NMODC;
                const float r = rsqrtf(ss[q] * (1.0f / 1024.0f) + EPSF);
#pragma unroll
                for (int j = 0; j < 4; ++j) {
                    const int c = 4 * lane + 256 * j;
                    const f32x4 gg = *(const f32x4*)(g + c), sc = *(const f32x4*)(mb + isc * DM + c), sh = *(const f32x4*)(mb + ish * DM + c);
                    const f32x4 o = (v[q][j] * r) * gg * (sc + 1.0f) + sh;
                    u32x2 w; w.x = pk2(o.x, o.y); w.y = pk2(o.z, o.w);
                    *(u32x2*)(H + (size_t)row * DM + c) = w;
                }
            }
        }
#pragma unroll
        for (int q = 0; q < 4; ++q)
#pragma unroll
            for (int j = 0; j < 4; ++j) v[q][j] = vn[q][j];
    }
#undef MOD_LOAD
}

__device__ __forceinline__ void modulate16_phase(const bf16_t* X, const float* g, const float* MODv, int ish, int isc, bf16_t* H, int row_begin, int row_end, int blk_first) {
    int tid_ = threadIdx.x; asm volatile("" : "+v"(tid_));
    const int tid = tid_, lane = tid & 63, wid = tid >> 6;
    if ((int)blockIdx.x < blk_first) return;
    const int gw = ((int)blockIdx.x - blk_first) * 8 + wid, ngw = ((int)gridDim.x - blk_first) * 8;
    for (int rowb = row_begin + gw; rowb < row_end; rowb += 4 * ngw) {
        u32x4 v[4][2]; float ss[4];
#pragma unroll
        for (int q = 0; q < 4; ++q) {
            const int row = min(rowb + q * ngw, row_end - 1);
#pragma unroll
            for (int j = 0; j < 2; ++j) v[q][j] = *(const u32x4*)(X + (size_t)row * DM + 8 * lane + 512 * j);
        }
#pragma unroll
        for (int q = 0; q < 4; ++q) { float t = 0.f;
#pragma unroll
            for (int j = 0; j < 2; ++j) { const unsigned w[4] = {v[q][j].x, v[q][j].y, v[q][j].z, v[q][j].w};
#pragma unroll
                for (int e = 0; e < 4; ++e) { const float lo = bflo(w[e]), hi = bfhi(w[e]); t += lo * lo + hi * hi; } }
            ss[q] = wave_sum(t); }
#pragma unroll
        for (int q = 0; q < 4; ++q) {
            const int row = rowb + q * ngw;
            if (row < row_end) {
                const float* mb = MODv + (size_t)batch_of(row) * NMODC;
                const float r = rsqrtf(ss[q] * (1.0f / 1024.0f) + EPSF);
#pragma unroll
                for (int j = 0; j < 2; ++j) {
                    const int c = 8 * lane + 512 * j;
                    const unsigned w[4] = {v[q][j].x, v[q][j].y, v[q][j].z, v[q][j].w};
                    unsigned ow[4];
#pragma unroll
                    for (int e = 0; e < 2; ++e) {
                        const f32x4 gg = *(const f32x4*)(g + c + 4 * e), sc = *(const f32x4*)(mb + isc * DM + c + 4 * e), sh = *(const f32x4*)(mb + ish * DM + c + 4 * e);
                        const f32x4 x = {bflo(w[2 * e]), bfhi(w[2 * e]), bflo(w[2 * e + 1]), bfhi(w[2 * e + 1])};
                        const f32x4 o = (x * r) * gg * (sc + 1.0f) + sh;
                        ow[2 * e] = pk2(o.x, o.y); ow[2 * e + 1] = pk2(o.z, o.w);
                    }
                    *(u32x4*)(H + (size_t)row * DM + c) = (u32x4){ow[0], ow[1], ow[2], ow[3]};
                }
            }
        }
    }
}

__device__ __forceinline__ void rowpost_phase(const Params& P) {
    int tid_ = threadIdx.x; asm volatile("" : "+v"(tid_));
    const int tid = tid_, lane = tid & 63, wid = tid >> 6;
    const int gw = blockIdx.x * 8 + wid, ngw = gridDim.x * 8;
    unsigned char* ws = P.ws;
    const bf16_t* ZA = (const bf16_t*)(ws + O_ZA); bf16_t* ZS = (bf16_t*)(ws + O_ZS); float* RV = (float*)(ws + O_RV);
    bf16_t* CKV = (bf16_t*)(ws + O_CKV); float* KR = (float*)(ws + O_KR);
    const float* gql = P.in[I_GQL]; const float* gkv = P.in[I_GKVL];
    for (int rowb = gw; rowb < MT; rowb += 2 * ngw) {
        u32x4 va[2], vb[2], qa[2]; u32x2 ka[2]; float kr[2];
#pragma unroll
        for (int q = 0; q < 2; ++q) {
            const int row = min(rowb + q * ngw, MT - 1);
            const u32x4* p = (const u32x4*)(ZA + (size_t)row * 2048 + 1024 + 16 * lane); va[q] = p[0]; vb[q] = p[1];
            const bf16_t* zs = ZS + (size_t)row * 768;
            qa[q] = (u32x4){0u, 0u, 0u, 0u}; if (lane < 48) qa[q] = *(const u32x4*)(zs + 8 * lane);
            ka[q] = *(const u32x2*)(zs + 384 + 4 * lane);
            kr[q] = lane < 32 ? bf2f(zs[640 + lane]) : 0.f;
        }
#pragma unroll
        for (int q = 0; q < 2; ++q) {
            const int row = rowb + q * ngw;
            if (row < MT) {
                bf16_t* zs = ZS + (size_t)row * 768;
                { const unsigned w[8] = {va[q].x, va[q].y, va[q].z, va[q].w, vb[q].x, vb[q].y, vb[q].z, vb[q].w}; float ss = 0.f;
#pragma unroll
                  for (int j = 0; j < 8; ++j) { const float lo = gelu_tanh(bflo(w[j])), hi = gelu_tanh(bfhi(w[j])); ss += lo * lo + hi * hi; }
                  ss = wave_sum(ss); if (lane == 0) RV[row] = rsqrtf(ss * (1.0f / 1024.0f) + EPSF); }
                { const u32x4 a = qa[q];
                  float qv[8] = {bflo(a.x), bfhi(a.x), bflo(a.y), bfhi(a.y), bflo(a.z), bfhi(a.z), bflo(a.w), bfhi(a.w)}; float ss = 0.f;
#pragma unroll
                  for (int j = 0; j < 8; ++j) ss += qv[j] * qv[j];
                  ss = wave_sum(ss); const float r = rsqrtf(ss * (1.0f / 384.0f) + EPSF);
                  if (lane < 48) { const f32x4 g0 = *(const f32x4*)(gql + 8 * lane), g1 = *(const f32x4*)(gql + 8 * lane + 4);
                    u32x4 w; w.x = pk2(qv[0] * r * g0.x, qv[1] * r * g0.y); w.y = pk2(qv[2] * r * g0.z, qv[3] * r * g0.w); w.z = pk2(qv[4] * r * g1.x, qv[5] * r * g1.y); w.w = pk2(qv[6] * r * g1.z, qv[7] * r * g1.w);
                    *(u32x4*)(zs + 8 * lane) = w; } }
                { const u32x2 a = ka[q]; float v[4] = {bflo(a.x), bfhi(a.x), bflo(a.y), bfhi(a.y)};
                  float ss = (v[0] * v[0] + v[1] * v[1]) + (v[2] * v[2] + v[3] * v[3]); ss = wave_sum(ss); const float r = rsqrtf(ss * (1.0f / 256.0f) + EPSF);
                  const f32x4 g4 = *(const f32x4*)(gkv + 4 * lane); f32x4 o = {v[0] * r * g4.x, v[1] * r * g4.y, v[2] * r * g4.z, v[3] * r * g4.w};
                  float* dst = row < MP ? P.out + OUT_CKVP + (size_t)row * 256 : P.out + OUT_CKVS + (size_t)(row - MP) * 256;
                  *(f32x4*)(dst + 4 * lane) = o; u32x2 w; w.x = pk2(o.x, o.y); w.y = pk2(o.z, o.w); *(u32x2*)(CKV + (size_t)row * 256 + 4 * lane) = w; }
                { const float val = kr[q]; const float partner = __shfl_xor(val, 16); float sn, cs; rope_sc(pos_of(row), lane & 15, sn, cs);
                  const float o = (lane < 16) ? val * cs - partner * sn : partner * sn + val * cs;
                  if (lane < 32) { KR[(size_t)row * 32 + lane] = o; float* dst = row < MP ? P.out + OUT_KRP + (size_t)row * 32 : P.out + OUT_KRS + (size_t)(row - MP) * 32; dst[lane] = o; }
                  const float oss = wave_sum(lane < 32 ? o * o : 0.f); if (lane == 0) ((float*)(ws + O_KRSS))[row] = oss; }
            }
        }
    }
}

__device__ __forceinline__ void gmlp_phase(const Params& P, LAS unsigned char* lds) {
    int tid_ = threadIdx.x; asm volatile("" : "+v"(tid_));
    const int tid = tid_, lane = tid & 63, wid = __builtin_amdgcn_readfirstlane(tid >> 6), l32 = lane & 31, hh = lane >> 5;
    unsigned char* ws = P.ws;
    const bf16_t* ZA = (const bf16_t*)(ws + O_ZA); const float* RV = (const float*)(ws + O_RV); const bf16_t* WS = (const bf16_t*)(ws + O_WS);
    bf16_t* OA = (bf16_t*)(ws + O_OA);
    const float* ggv = P.in[I_GGV]; const float* gb = P.in[I_GB];
    LAS bf16_t* vt = (LAS bf16_t*)lds;
    LAS float* mx = (LAS float*)(lds + 34816);
    const int sr = tid >> 4, cp = tid & 15;
    for (int item = blockIdx.x; item < 520 * 8; item += gridDim.x) {
        const int ci = item >> 3, g = item & 7; const bool sample = ci >= 512;
        const int row0 = sample ? MP + (ci - 512) * 64 : ci * 128, L = sample ? 64 : 128;
        u32x4 gvr[4], ur[4]; float rvr[4];
#pragma unroll
        for (int p = 0; p < 4; ++p) {
            const int s = p * 32 + sr; const int row = row0 + (s < L ? s : 0);
            gvr[p] = *(const u32x4*)(ZA + (size_t)row * 2048 + 1024 + g * 128 + 8 * cp);
            ur[p] = *(const u32x4*)(ZA + (size_t)row * 2048 + g * 128 + 8 * cp);
            rvr[p] = RV[row];
        }
        const f32x4 g0 = *(const f32x4*)(ggv + g * 128 + 8 * cp), g1 = *(const f32x4*)(ggv + g * 128 + 8 * cp + 4);
        __syncthreads();
#pragma unroll
        for (int p = 0; p < 4; ++p) {
            const int s = p * 32 + sr;
            if (s < L) {
                const int row = row0 + s; const u32x4 a = gvr[p]; const float rv = rvr[p];
                float v[8] = {gelu_tanh(bflo(a.x)) * rv * g0.x, gelu_tanh(bfhi(a.x)) * rv * g0.y, gelu_tanh(bflo(a.y)) * rv * g0.z, gelu_tanh(bfhi(a.y)) * rv * g0.w, gelu_tanh(bflo(a.z)) * rv * g1.x, gelu_tanh(bfhi(a.z)) * rv * g1.y, gelu_tanh(bflo(a.w)) * rv * g1.z, gelu_tanh(bfhi(a.w)) * rv * g1.w};
                if (sample) { float* dst = P.out + OUT_GV + (size_t)(row - MP) * 1024 + g * 128 + 8 * cp; *(f32x4*)dst = (f32x4){v[0], v[1], v[2], v[3]}; *(f32x4*)(dst + 4) = (f32x4){v[4], v[5], v[6], v[7]}; }
#pragma unroll
                for (int j = 0; j < 8; ++j) vt[(8 * cp + j) * 136 + s] = f2bf(v[j]);
            }
        }
        __syncthreads();
        const int tb = wid & 3, ch = wid >> 2;
        if (32 * tb < L) {
            f32x16 acc0, acc1;
#pragma unroll
            for (int i = 0; i < 16; ++i) { acc0[i] = 0.f; acc1[i] = 0.f; }
            const bf16_t* wp = WS + ((size_t)g * 128 + 32 * tb + l32) * 128 + 8 * hh;
            const LAS bf16_t* b0p = vt + (64 * ch + l32) * 136 + 8 * hh; const LAS bf16_t* b1p = b0p + 32 * 136;
            const int nks = 2 * (tb + 1);
            for (int ks = 0; ks < nks; ++ks) {
                const bf16x8 a = *(const bf16x8*)(wp + 16 * ks);
                const bf16x8 b0 = *(const LAS bf16x8*)(b0p + 16 * ks), b1 = *(const LAS bf16x8*)(b1p + 16 * ks);
                acc0 = __builtin_amdgcn_mfma_f32_32x32x16_bf16(a, b0, acc0, 0, 0, 0);
                acc1 = __builtin_amdgcn_mfma_f32_32x32x16_bf16(a, b1, acc1, 0, 0, 0);
            }
#pragma unroll
            for (int i = 0; i < 16; ++i) {
                const int t = 32 * tb + (i & 3) + 8 * (i >> 2) + 4 * hh;
                mx[t * 132 + 64 * ch + l32] = acc0[i]; mx[t * 132 + 64 * ch + 32 + l32] = acc1[i];
            }
        }
        __syncthreads();
#pragma unroll
        for (int p = 0; p < 4; ++p) {
            const int t = p * 32 + sr;
            if (t < L) {
                const int row = row0 + t; const float bias = gb[g * 128 + t];
                const f32x4 m0 = *(const LAS f32x4*)(mx + t * 132 + 8 * cp), m1 = *(const LAS f32x4*)(mx + t * 132 + 8 * cp + 4);
                const u32x4 a = ur[p];
                u32x4 w;
                w.x = pk2(gelu_tanh(bflo(a.x)) * (m0.x + bias), gelu_tanh(bfhi(a.x)) * (m0.y + bias)); w.y = pk2(gelu_tanh(bflo(a.y)) * (m0.z + bias), gelu_tanh(bfhi(a.y)) * (m0.w + bias));
                w.z = pk2(gelu_tanh(bflo(a.z)) * (m1.x + bias), gelu_tanh(bfhi(a.z)) * (m1.y + bias)); w.w = pk2(gelu_tanh(bflo(a.w)) * (m1.z + bias), gelu_tanh(bfhi(a.w)) * (m1.w + bias));
                *(u32x4*)(OA + (size_t)row * 1024 + g * 128 + 8 * cp) = w;
            }
        }
    }
}

__device__ __forceinline__ void qkfinal_phase(const Params& P) {
    int tid_ = threadIdx.x; asm volatile("" : "+v"(tid_));
    const int tid = tid_, lane = tid & 63, wid = tid >> 6;
    const int gw = blockIdx.x * 8 + wid, ngw = gridDim.x * 8;
    unsigned char* ws = P.ws;
    bf16_t* QR = (bf16_t*)(ws + O_QR); bf16_t* KF = (bf16_t*)(ws + O_KF); const float* KR = (const float*)(ws + O_KR);
    const float* gqn = P.in[I_GQN]; const float* gkn = P.in[I_GKN];
    const int h = lane >> 3, sub = lane & 7;
    constexpr float QSCALE = 0.10206207261596575f * 1.4426950408889634f;
    for (int itemb = gw; itemb < MT + MKV; itemb += 4 * ngw) {
        u32x4 na[4]; u32x2 qb[4]; f32x4 kb[4];
#pragma unroll
        for (int q = 0; q < 4; ++q) {
            const int item = min(itemb + q * ngw, MT + MKV - 1);
            const bool isq = item < MT; const int row = isq ? item : item - MT;
            const bf16_t* p = (isq ? QR : KF) + (size_t)row * 768 + h * 96;
            na[q] = *(const u32x4*)(p + 8 * sub);
            qb[q] = (u32x2){0u, 0u}; kb[q] = (f32x4){0.f, 0.f, 0.f, 0.f};
            if (isq) qb[q] = *(const u32x2*)(p + 64 + 4 * sub); else kb[q] = *(const f32x4*)(KR + (size_t)row * 32 + 4 * sub);
        }
#pragma unroll
        for (int q = 0; q < 4; ++q) {
            const int item = itemb + q * ngw;
            if (item < MT + MKV) {
                const bool isq = item < MT; const int row = isq ? item : item - MT;
                bf16_t* p = (isq ? QR : KF) + (size_t)row * 768 + h * 96;
                const u32x4 a = na[q];
                float nope[8] = {bflo(a.x), bfhi(a.x), bflo(a.y), bfhi(a.y), bflo(a.z), bfhi(a.z), bflo(a.w), bfhi(a.w)};
                float rp[4];
                if (isq) {
                    const u32x2 b = qb[q];
                    const float raw[4] = {bflo(b.x), bfhi(b.x), bflo(b.y), bfhi(b.y)};
                    const float pos = pos_of(row);
#pragma unroll
                    for (int j = 0; j < 4; ++j) { const float partner = __shfl_xor(raw[j], 4); float sn, cs; rope_sc(pos, (4 * sub + j) & 15, sn, cs);
                        rp[j] = (sub < 4) ? raw[j] * cs - partner * sn : partner * sn + raw[j] * cs; }
                } else { rp[0] = kb[q].x; rp[1] = kb[q].y; rp[2] = kb[q].z; rp[3] = kb[q].w; }
                float ss = 0.f;
#pragma unroll
                for (int j = 0; j < 8; ++j) ss += nope[j] * nope[j];
#pragma unroll
                for (int j = 0; j < 4; ++j) ss += rp[j] * rp[j];
                ss += __shfl_xor(ss, 1); ss += __shfl_xor(ss, 2); ss += __shfl_xor(ss, 4);
                const float r = rsqrtf(ss * (1.0f / 96.0f) + EPSF) * (isq ? QSCALE : 1.0f);
                const float* gn = isq ? gqn : gkn;
                const f32x4 g0 = *(const f32x4*)(gn + 8 * sub), g1 = *(const f32x4*)(gn + 8 * sub + 4), g2 = *(const f32x4*)(gn + 64 + 4 * sub);
                u32x4 w; w.x = pk2(nope[0] * r * g0.x, nope[1] * r * g0.y); w.y = pk2(nope[2] * r * g0.z, nope[3] * r * g0.w); w.z = pk2(nope[4] * r * g1.x, nope[5] * r * g1.y); w.w = pk2(nope[6] * r * g1.z, nope[7] * r * g1.w);
                u32x2 w2; w2.x = pk2(rp[0] * r * g2.x, rp[1] * r * g2.y); w2.y = pk2(rp[2] * r * g2.z, rp[3] * r * g2.w);
                *(u32x4*)(p + 8 * sub) = w; *(u32x2*)(p + 64 + 4 * sub) = w2;
            }
        }
    }
}

constexpr int N_ATT_ITEMS = 64 + 2048;
__device__ __forceinline__ void attn_phase(const Params& P, LAS unsigned char* lds, int cidx) {
    int tid_ = threadIdx.x; asm volatile("" : "+v"(tid_));
    const int tid = tid_, lane = tid & 63, wid = __builtin_amdgcn_readfirstlane(tid >> 6), l32 = lane & 31, hh = lane >> 5;
    unsigned char* ws = P.ws;
    const bf16_t* QR = (const bf16_t*)(ws + O_QR); const bf16_t* KF = (const bf16_t*)(ws + O_KF); const bf16_t* VT = (const bf16_t*)(ws + O_VT);
    bf16_t* OB = (bf16_t*)(ws + O_OB);
    unsigned* counter = (unsigned*)(ws + O_CTL) + cidx;
    LAS unsigned* slot = (LAS unsigned*)(lds + 45056);
    const int k0key = tid / 12, k0part = tid % 12, k1key = (tid + 512) / 12, k1part = (tid + 512) % 12; const bool has1 = tid < 256;
    const int vdv = tid >> 3, vpart = tid & 7;
    for (;;) {
        __syncthreads();
        if (tid == 0) *slot = atomicAdd(counter, 1u);
        __syncthreads();
        const int item = (int)*slot;
        if (item >= N_ATT_ITEMS) break;
        const bool sample = item < 64;
        int b, h, nt, qrow0, wlim;
        if (sample) { b = item >> 3; h = item & 7; nt = 65; qrow0 = MP + b * 64; wlim = 64; }
        else { const int j = item - 64, qb = 7 - (j >> 8), bh = j & 255; b = bh >> 3; h = bh & 7; nt = 4 * qb + 4; qrow0 = b * 2048 + qb * 256; wlim = 4 * qb + (wid >> 1); }
        const bool wvalid = sample ? (wid < 2) : true;
        bf16x8 qf[6];
        if (wvalid) { const int qrow = qrow0 + 32 * wid + l32; const bf16_t* qp = QR + (size_t)qrow * 768 + h * 96 + 8 * hh;
            u32x4 qraw[6];
#pragma unroll
            for (int ks = 0; ks < 6; ++ks) qraw[ks] = *(const u32x4*)(qp + 16 * ks);
            float qv[6][8];
#pragma unroll
            for (int ks = 0; ks < 6; ++ks) { qv[ks][0] = bflo(qraw[ks].x); qv[ks][1] = bfhi(qraw[ks].x); qv[ks][2] = bflo(qraw[ks].y); qv[ks][3] = bfhi(qraw[ks].y);
                qv[ks][4] = bflo(qraw[ks].z); qv[ks][5] = bfhi(qraw[ks].z); qv[ks][6] = bflo(qraw[ks].w); qv[ks][7] = bfhi(qraw[ks].w); }
            const float pos = pos_of(qrow);
#pragma unroll
            for (int j = 0; j < 8; ++j) { float sn, cs; rope_sc(pos, 8 * hh + j, sn, cs); const float x1 = qv[4][j], x2 = qv[5][j]; qv[4][j] = x1 * cs - x2 * sn; qv[5][j] = x1 * sn + x2 * cs; }
            float ss = 0.f;
#pragma unroll
            for (int ks = 0; ks < 6; ++ks)
#pragma unroll
                for (int j = 0; j < 8; ++j) ss += qv[ks][j] * qv[ks][j];
            ss += __shfl_xor(ss, 32);
            const float rq = rsqrtf(ss * (1.0f / 96.0f) + EPSF) * (0.10206207261596575f * 1.4426950408889634f);
            const float* gqn = P.in[I_GQN];
#pragma unroll
            for (int ks = 0; ks < 6; ++ks) { const f32x4 g0 = *(const f32x4*)(gqn + 16 * ks + 8 * hh), g1 = *(const f32x4*)(gqn + 16 * ks + 8 * hh + 4);
                u32x4 w; w.x = pk2(qv[ks][0] * rq * g0.x, qv[ks][1] * rq * g0.y); w.y = pk2(qv[ks][2] * rq * g0.z, qv[ks][3] * rq * g0.w);
                w.z = pk2(qv[ks][4] * rq * g1.x, qv[ks][5] * rq * g1.y); w.w = pk2(qv[ks][6] * rq * g1.z, qv[ks][7] * rq * g1.w);
                qf[ks] = __builtin_bit_cast(bf16x8, w); } }
        else {
#pragma unroll
            for (int ks = 0; ks < 6; ++ks) qf[ks] = (bf16x8){0, 0, 0, 0, 0, 0, 0, 0}; }
        f32x16 O0, O1;
#pragma unroll
        for (int i = 0; i < 16; ++i) { O0[i] = 0.f; O1[i] = 0.f; }
        float mrun = -1e30f, lrun = 0.f;
        u32x4 kr0, kr1 = {0u, 0u, 0u, 0u}, vr;
#define ATT_TROW(kt) (sample ? ((kt) < 64 ? MT + b * 4096 + (kt) * 64 : MP + b * 64) : b * 2048 + (kt) * 64)
#define ATT_ISSUE(kt) do { const size_t krow = (size_t)ATT_TROW(kt); \
            kr0 = *(const u32x4*)(KF + (krow + k0key) * 768 + h * 96 + k0part * 8); \
            if (has1) kr1 = *(const u32x4*)(KF + (krow + k1key) * 768 + h * 96 + k1part * 8); \
            vr = *(const u32x4*)(VT + (size_t)(h * 64 + vdv) * MKV + krow + vpart * 8); } while (0)
#define ATT_COMMIT(bufi) do { *(LAS u32x4*)(lds + (bufi) * 13312 + k0key * 208 + k0part * 16) = kr0; \
            if (has1) *(LAS u32x4*)(lds + (bufi) * 13312 + k1key * 208 + k1part * 16) = kr1; \
            *(LAS u32x4*)(lds + 26624 + (bufi) * 9216 + vdv * 144 + vpart * 16) = vr; } while (0)
        ATT_ISSUE(0); ATT_COMMIT(0);
        __syncthreads();
        for (int kt = 0; kt < nt; ++kt) {
            const int buf = kt & 1;
            if (kt + 1 < nt) ATT_ISSUE(kt + 1);
            if (wvalid && kt <= wlim) {
                const LAS unsigned char* kb = lds + buf * 13312 + l32 * 208 + hh * 16;
                const LAS unsigned char* vb = lds + 26624 + buf * 9216 + l32 * 144 + hh * 8;
                f32x16 S0, S1;
#pragma unroll
                for (int i = 0; i < 16; ++i) { S0[i] = 0.f; S1[i] = 0.f; }
#pragma unroll
                for (int ks = 0; ks < 6; ++ks) {
                    const bf16x8 a0 = *(const LAS bf16x8*)(kb + ks * 32), a1 = *(const LAS bf16x8*)(kb + 32 * 208 + ks * 32);
                    S0 = __builtin_amdgcn_mfma_f32_32x32x16_bf16(a0, qf[ks], S0, 0, 0, 0);
                    S1 = __builtin_amdgcn_mfma_f32_32x32x16_bf16(a1, qf[ks], S1, 0, 0, 0);
                }
                float mx = S0[0];
#pragma unroll
                for (int i = 1; i < 16; ++i) mx = fmaxf(mx, S0[i]);
#pragma unroll
                for (int i = 0; i < 16; ++i) mx = fmaxf(mx, S1[i]);
                mx = fmaxf(mx, __shfl_xor(mx, 32));
                const float mnew = fmaxf(mrun, mx), alpha = fast_exp2(mrun - mnew); mrun = mnew;
                float ps = 0.f;
#pragma unroll
                for (int i = 0; i < 16; ++i) { S0[i] = fast_exp2(S0[i] - mnew); ps += S0[i]; }
#pragma unroll
                for (int i = 0; i < 16; ++i) { S1[i] = fast_exp2(S1[i] - mnew); ps += S1[i]; }
                lrun = lrun * alpha + ps;
#pragma unroll
                for (int i = 0; i < 16; ++i) { O0[i] *= alpha; O1[i] *= alpha; }
#pragma unroll
                for (int kk = 0; kk < 4; ++kk) {
                    u32x4 pw;
                    if (kk == 0) { pw.x = pk2(S0[0], S0[1]); pw.y = pk2(S0[2], S0[3]); pw.z = pk2(S0[4], S0[5]); pw.w = pk2(S0[6], S0[7]); }
                    else if (kk == 1) { pw.x = pk2(S0[8], S0[9]); pw.y = pk2(S0[10], S0[11]); pw.z = pk2(S0[12], S0[13]); pw.w = pk2(S0[14], S0[15]); }
                    else if (kk == 2) { pw.x = pk2(S1[0], S1[1]); pw.y = pk2(S1[2], S1[3]); pw.z = pk2(S1[4], S1[5]); pw.w = pk2(S1[6], S1[7]); }
                    else { pw.x = pk2(S1[8], S1[9]); pw.y = pk2(S1[10], S1[11]); pw.z = pk2(S1[12], S1[13]); pw.w = pk2(S1[14], S1[15]); }
                    const bf16x8 pb = __builtin_bit_cast(bf16x8, pw);
                    const u32x2 lo0 = *(const LAS u32x2*)(vb + kk * 32), hi0 = *(const LAS u32x2*)(vb + kk * 32 + 16);
                    const u32x2 lo1 = *(const LAS u32x2*)(vb + 32 * 144 + kk * 32), hi1 = *(const LAS u32x2*)(vb + 32 * 144 + kk * 32 + 16);
                    const u32x4 va0 = {lo0.x, lo0.y, hi0.x, hi0.y}, va1 = {lo1.x, lo1.y, hi1.x, hi1.y};
                    O0 = __builtin_amdgcn_mfma_f32_32x32x16_bf16(__builtin_bit_cast(bf16x8, va0), pb, O0, 0, 0, 0);
                    O1 = __builtin_amdgcn_mfma_f32_32x32x16_bf16(__builtin_bit_cast(bf16x8, va1), pb, O1, 0, 0, 0);
                }
            }
            if (kt + 1 < nt) ATT_COMMIT(buf ^ 1);
            __syncthreads();
        }
#undef ATT_TROW
#undef ATT_ISSUE
#undef ATT_COMMIT
        if (wvalid) {
            const float ltot = lrun + __shfl_xor(lrun, 32); const float inv = 1.0f / ltot;
            bf16_t* op = OB + (size_t)(qrow0 + 32 * wid + l32) * 512 + h * 64 + 4 * hh;
#pragma unroll
            for (int g4 = 0; g4 < 4; ++g4) {
                u32x2 w0; w0.x = pk2(O0[4 * g4] * inv, O0[4 * g4 + 1] * inv); w0.y = pk2(O0[4 * g4 + 2] * inv, O0[4 * g4 + 3] * inv);
                u32x2 w1; w1.x = pk2(O1[4 * g4] * inv, O1[4 * g4 + 1] * inv); w1.y = pk2(O1[4 * g4 + 2] * inv, O1[4 * g4 + 3] * inv);
                *(u32x2*)(op + 8 * g4) = w0; *(u32x2*)(op + 32 + 8 * g4) = w1;
            }
        }
    }
}

#define XB_TMO      128
#define XB_XCNT(j)  (256  + 64 * (j))
#define XB_XSUB(j)  (1280 + 64 * (j))
#define XB_XGEN(j)  (2304 + 64 * (j))
#define XB_TOP      3328
#define XB_TOPGEN   3392
#define XCD_BAR_WORDS 3456
#define XB_SPIN_CAP (1u << 18)

__device__ __forceinline__ unsigned xb_ld(unsigned* p)              { return __hip_atomic_load(p, __ATOMIC_RELAXED, __HIP_MEMORY_SCOPE_AGENT); }
__device__ __forceinline__ unsigned xb_add(unsigned* p, unsigned v) { return __hip_atomic_fetch_add(p, v, __ATOMIC_RELAXED, __HIP_MEMORY_SCOPE_AGENT); }
__device__ __forceinline__ unsigned xb_xcc_id() { return (unsigned)__builtin_amdgcn_s_getreg((3 << 11) | 20) & 0xFu; }
#define XB_SPIN(cond, bar) do { unsigned _sp = 0; while (cond) { __builtin_amdgcn_s_sleep(1); \
    if ((++_sp & 255u) == 0u) { if (xb_ld(&(bar)[XB_TMO])) break; if (_sp > XB_SPIN_CAP) { atomicAdd(&(bar)[XB_TMO], 1u); break; } } } } while (0)

struct XcdBarrier {
    unsigned* bar; unsigned x;
    volatile LAS unsigned* st;
};

__device__ __forceinline__ XcdBarrier xcd_barrier_post(unsigned* bar, volatile LAS unsigned* st) {
    XcdBarrier b; b.bar = bar; b.x = xb_xcc_id(); b.st = st;
    if (threadIdx.x == 0) (void)xb_add(&bar[XB_XCNT(b.x)], 1u);
    return b;
}
__device__ __forceinline__ void xcd_barrier_complete(unsigned* bar, unsigned x, unsigned& nloc, unsigned& nx) {
    const unsigned G = gridDim.x * gridDim.y * gridDim.z;
    unsigned sum, cnt, mine, sp = 0u;
    for (;;) {
        sum = 0u; cnt = 0u; mine = 0u;
#pragma unroll
        for (unsigned j = 0; j < 16; ++j) { const unsigned c = xb_ld(&bar[XB_XCNT(j)]); sum += c; cnt += (c > 0u) ? 1u : 0u; mine = (j == x) ? c : mine; }
        if (sum == G) break;
        __builtin_amdgcn_s_sleep(1);
        if ((++sp & 255u) == 0u) { if (xb_ld(&bar[XB_TMO])) break; if (sp > XB_SPIN_CAP) { atomicAdd(&bar[XB_TMO], 1u); break; } }
    }
    nloc = mine > 0u ? mine : 1u; nx = cnt > 0u ? cnt : 1u;
}

__device__ __forceinline__ void xcd_barrier(const XcdBarrier& b) {
    asm volatile("s_waitcnt vmcnt(0)" ::: "memory");
    __syncthreads();
    if (threadIdx.x == 0) {
        unsigned* bar = b.bar;
        __builtin_amdgcn_s_waitcnt(0);
        unsigned nloc = b.st[0], nx = b.st[1];
        if (nloc == 0u) { xcd_barrier_complete(bar, b.x, nloc, nx); b.st[0] = nloc; b.st[1] = nx; }
        const unsigned old = xb_add(&bar[XB_XSUB(b.x)], 1u);
        const unsigned gen = old / nloc;
        if (old + 1u == (gen + 1u) * nloc) {
            __builtin_amdgcn_fence(__ATOMIC_RELEASE, "agent");
            asm volatile("s_waitcnt vmcnt(0)" ::: "memory");
            const unsigned og = xb_add(&bar[XB_TOP], 1u);
            const unsigned tg = og / nx;
            if (og + 1u == (tg + 1u) * nx) xb_add(&bar[XB_TOPGEN], 1u);
            else XB_SPIN(xb_ld(&bar[XB_TOPGEN]) == tg, bar);
            __builtin_amdgcn_fence(__ATOMIC_ACQUIRE, "agent");
            xb_add(&bar[XB_XGEN(b.x)], 1u);
            asm volatile("s_waitcnt vmcnt(0)" ::: "memory");
        } else {
            XB_SPIN(xb_ld(&bar[XB_XGEN(b.x)]) == gen, bar);
            __builtin_amdgcn_fence(__ATOMIC_ACQUIRE, "agent");
            asm volatile("s_waitcnt vmcnt(0)" ::: "memory");
        }
    }
    __syncthreads();
}


__global__ void __launch_bounds__(512, 2) mk_forward(Params P) {
    extern __shared__ __attribute__((aligned(16))) unsigned char lds_raw[];
    LAS unsigned char* lds = (LAS unsigned char*)lds_raw;
    cg::grid_group grid = cg::this_grid();
    volatile LAS unsigned* xb_st = (volatile LAS unsigned*)(lds + 131072);
    if (threadIdx.x < 4) xb_st[threadIdx.x] = 0u;
    __syncthreads();
    const XcdBarrier xb = xcd_barrier_post((unsigned*)(P.ws + O_BAR), xb_st);
    unsigned char* ws = P.ws;
    float* MODv = (float*)(ws + O_MOD);
    float* Y = P.out + OUT_Y;
    constexpr int NPROG = NSTEPS + (PROBE_DUP >= 0 ? 1 : 0);
    for (int si = P.ph_lo; si < NPROG; ++si) {
        const int step = (PROBE_DUP >= 0 && si > PROBE_DUP) ? si - 1 : si;
        const bool rerun = (PROBE_DUP >= 0 && si == PROBE_DUP + 1);
        bool is_gemm = false, sync_after = true;
        pg8::Gemm g; g.A = nullptr; g.Bt = nullptr; g.M = 0; g.N = 0; g.K = 0; g.lda = 0;
        Epi E; E.mode = EM_PLAIN; E.sub = 0; E.gidx = 0; E.row_off = 0; E.coef = 1.0f; E.ws = ws; E.Y = Y; E.xp = P.in[I_XP]; E.xs = P.in[I_XS]; E.bgate = P.in[I_BGATE];
        switch (step) {
        case 0: prep_phase(P, lds); break;
        case 1: modulate_phase(P.in[I_XP], P.in[I_XS], P.in[I_GFFN1], MODv, 0, 1, (bf16_t*)(ws + O_H)); break;
        case 2: is_gemm = true; g.A = (const bf16_t*)(ws + O_H); g.lda = 1024; g.Bt = (const bf16_t*)(ws + O_W1U); g.M = MT; g.N = 2 * DFF; g.K = 1024; E.mode = EM_SWIGLU; break;
        case 3: is_gemm = true; g.A = (const bf16_t*)(ws + O_ACT); g.lda = DFF; g.Bt = (const bf16_t*)(ws + O_W1D); g.M = MP; g.N = 1024; g.K = DFF; E.mode = EM_RESID; E.gidx = 2; E.coef = 0.5f; break;
        case 4:
            if (blockIdx.x < 8) { is_gemm = true; g.A = (const bf16_t*)(ws + O_ACT) + (size_t)MP * DFF; g.lda = DFF; g.Bt = (const bf16_t*)(ws + O_W1D); g.M = MS; g.N = 1024; g.K = DFF; E.mode = EM_RESID; E.gidx = 2; E.coef = 0.5f; E.row_off = MP; }
            else modulate16_phase((const bf16_t*)Y, P.in[I_GMIX], MODv, 3, 4, (bf16_t*)(ws + O_H), 0, MP, 8);
            break;
        case 5: modulate16_phase((const bf16_t*)Y, P.in[I_GMIX], MODv, 3, 4, (bf16_t*)(ws + O_H), MP, MT, 0); xcd_barrier(xb);
            is_gemm = true; g.A = (const bf16_t*)(ws + O_H); g.lda = 1024; g.Bt = (const bf16_t*)(ws + O_WIN); g.M = MT; g.N = NINP; g.K = 1024; E.mode = EM_WIN; break;
        case 6: rowpost_phase(P); break;
        case 7: gmlp_phase(P, lds); break;
        case 8: is_gemm = true; sync_after = false; g.A = (const bf16_t*)(ws + O_ZS); g.lda = 768; g.Bt = (const bf16_t*)(ws + O_WUQ); g.M = MT; g.N = 768; g.K = 384; E.mode = EM_PLAIN; E.sub = 0; break;
        case 9: is_gemm = true; sync_after = false; g.A = (const bf16_t*)(ws + O_CKV); g.lda = 256; g.Bt = (const bf16_t*)(ws + O_WUK); g.M = MKV; g.N = 512; g.K = 256; E.mode = EM_KNOPE; E.bgate = P.in[I_GKN]; break;
        case 10: is_gemm = true; g.A = (const bf16_t*)(ws + O_WUV); g.lda = 256; g.Bt = (const bf16_t*)(ws + O_CKV); g.M = 512; g.N = MKV; g.K = 256; E.mode = EM_PLAIN; E.sub = 1; break;
        case 11: sync_after = false; break;
        case 12: if (blockIdx.x < 8 && !rerun) { is_gemm = true; g.A = (const bf16_t*)(ws + O_OA) + (size_t)MP * 1024; g.lda = 1024; g.Bt = (const bf16_t*)(ws + O_WBA); g.M = MS; g.N = 1024; g.K = 1024; E.mode = EM_BRA; E.row_off = MP; } break;
        case 13: is_gemm = true; g.A = (const bf16_t*)(ws + O_OA); g.lda = 1024; g.Bt = (const bf16_t*)(ws + O_WBA); g.M = MP; g.N = 1024; g.K = 1024; E.mode = EM_BRA; break;
        case 14: is_gemm = true; g.A = (const bf16_t*)(ws + O_OB); g.lda = 512; g.Bt = (const bf16_t*)(ws + O_WBB); g.M = MT; g.N = 1024; g.K = 512; E.mode = EM_BRB; break;
        case 15: is_gemm = true; g.A = (const bf16_t*)(ws + O_MG); g.lda = 1024; g.Bt = (const bf16_t*)(ws + O_WO); g.M = MP; g.N = 1024; g.K = 1024; E.mode = EM_RESID_B2B; E.gidx = 5; E.coef = 1.0f; break;
        case 16:
            if (blockIdx.x < 8) { is_gemm = true; g.A = (const bf16_t*)(ws + O_MG) + (size_t)MP * 1024; g.lda = 1024; g.Bt = (const bf16_t*)(ws + O_WO); g.M = MS; g.N = 1024; g.K = 1024; E.mode = EM_RESID_B2B; E.gidx = 5; E.coef = 1.0f; E.row_off = MP; }
            else modulate16_phase((const bf16_t*)(ws + O_X2), P.in[I_GFFN2], MODv, 6, 7, (bf16_t*)(ws + O_H), 0, MP, 8);
            break;
        case 17: modulate16_phase((const bf16_t*)(ws + O_X2), P.in[I_GFFN2], MODv, 6, 7, (bf16_t*)(ws + O_H), MP, MT, 0); xcd_barrier(xb);
            is_gemm = true; g.A = (const bf16_t*)(ws + O_H); g.lda = 1024; g.Bt = (const bf16_t*)(ws + O_W2U); g.M = MT; g.N = 2 * DFF; g.K = 1024; E.mode = EM_SWIGLU; break;
        case 18: is_gemm = true; g.A = (const bf16_t*)(ws + O_ACT); g.lda = DFF; g.Bt = (const bf16_t*)(ws + O_W2D); g.M = MT; g.N = 1024; g.K = DFF; E.mode = EM_RESID_B2F; E.gidx = 8; E.coef = 0.5f; break;
        default: break;
        }
        if (is_gemm) {
            pg8::StaticOrder S; S.init(g.M, g.N, (int)gridDim.x, (int)blockIdx.x);
#if STAGGER_MODE
            {
                const unsigned lvl = STAGGER_MODE == 1 ? ((blockIdx.x >> 3) & 31u) : (blockIdx.x & 7u) * 4u;
                const unsigned long long ticks = (unsigned long long)lvl * (unsigned)(g.K / 64) * 120ull / 32ull;
                const unsigned long long t0 = wall_clock64();
                while (wall_clock64() - t0 < ticks) __builtin_amdgcn_s_sleep(8);
            }
#endif
            pg8::gemm_phase<Epi, pg8::StaticOrder>(lds, g, S, E);
        }
        if (step == 12) attn_phase(P, lds, rerun ? 1 : 0);
        if ((sync_after || (PROBE_DUP >= 0 && si == PROBE_DUP)) && si + 1 < NPROG) { if (si == 0) grid.sync(); else xcd_barrier(xb); }
    }
}

extern "C" void kernel_launch(void* const* d_in, const int* in_sizes, int n_in, void* d_out, int out_size, void* d_ws, size_t ws_size, hipStream_t stream) {
    static int grid = 0;
    if (grid == 0) {
        if (n_in != 30 || ws_size < WS_END) { fprintf(stderr, "kernel_launch: unexpected n_in %d or ws_size %zu (< %zu)\n", n_in, ws_size, (size_t)WS_END); grid = -1; return; }
        int dev = 0, cus = 0, per_cu = 0;
        hipGetDevice(&dev);
        hipDeviceGetAttribute(&cus, hipDeviceAttributeMultiprocessorCount, dev);
        if (hipFuncSetAttribute((const void*)mk_forward, hipFuncAttributeMaxDynamicSharedMemorySize, LDS_BYTES) != hipSuccess) fprintf(stderr, "kernel_launch: hipFuncSetAttribute failed\n");
        if (hipOccupancyMaxActiveBlocksPerMultiprocessor(&per_cu, (const void*)mk_forward, 512, LDS_BYTES) != hipSuccess || per_cu < 1) fprintf(stderr, "kernel_launch: occupancy query says %d blocks per CU\n", per_cu);
        (void)hipGetLastError();
        grid = cus > 0 ? cus : 256;
    }
    if (grid < 0) return;
    if (hipMemsetAsync((unsigned char*)d_ws + O_BAR, 0, XCD_BAR_WORDS * sizeof(unsigned), stream) != hipSuccess) { fprintf(stderr, "kernel_launch: memset of the barrier words failed\n"); return; }
    Params p{};
    for (int i = 0; i < 30; ++i) p.in[i] = (const float*)d_in[i];
    p.out = (float*)d_out; p.ws = (unsigned char*)d_ws; p.ph_lo = 0; p.ph_hi = NSTEPS;
    void* args[] = {&p};
    hipError_t e = hipLaunchCooperativeKernel((const void*)mk_forward, dim3(grid), dim3(512), args, LDS_BYTES, stream);
    if (e != hipSuccess) fprintf(stderr, "kernel_launch: cooperative launch failed: %s (grid %d)\n", hipGetErrorString(e), grid);
}
```

```cpp
#include <hip/hip_runtime.h>
#include <hip/hip_cooperative_groups.h>
#include <cstdio>
#include <cstdint>
namespace cg = cooperative_groups;

namespace pg8 {
#define PG8_LAS __attribute__((address_space(3)))
typedef unsigned short bf16_t;
typedef short bf16x8 __attribute__((ext_vector_type(8)));
typedef float f32x4 __attribute__((ext_vector_type(4)));
typedef unsigned u32x4 __attribute__((ext_vector_type(4)));
constexpr int BM = 256, BK = 64, HALF = 128, HTB = HALF * BK * 2  , STAGE_BYTES = 8 * HTB, NXCD = 8, WGM = 8;

__host__ __device__ __forceinline__ int lds_byte(int r, int c) { const int st = (r >> 4) * 2 + (c >> 5), rr = r & 15, cc = c & 31, ob = rr * 64 + cc * 2; return st * 1024 + (ob ^ (((ob >> 9) & 1) << 5)); }
__host__ __device__ __forceinline__ void stage_rc(int b, int& R, int& C) { const int st = b / 1024, sb = b % 1024, swz = sb ^ (((sb >> 9) & 1) << 5); R = (st >> 1) * 16 + swz / 64; C = (st & 1) * 32 + (swz % 64) / 2; }
__host__ __device__ __forceinline__ int perm32(int rho) { const int n = rho >> 4, i = rho & 15; return 8 * (i >> 2) + 4 * n + (i & 3); }

struct Unit { int pm, pn; };
struct Gemm { const bf16_t* A; const bf16_t* Bt; int M, N, K, lda; };

struct StaticOrder {
    int nM, nN, nwg, G, c;
    __host__ __device__ void init(int M, int N, int G_, int c_) { nM = M / BM; nN = N / BM; nwg = nM * nN; G = G_; c = c_; }
    __host__ __device__ bool next(int i, Unit& u) const {
        const long L = (long)i * G + c; if (L >= nwg) return false;
        int wgid = (int)L; { const int q = nwg / NXCD, r = nwg % NXCD, xcd = wgid % NXCD, off = wgid / NXCD; wgid = (xcd < r ? xcd * (q + 1) : r * (q + 1) + (xcd - r) * q) + off; }
        const int nig = WGM * nN, gid = wgid / nig, fm = gid * WGM, gsz = (nM - fm) < WGM ? (nM - fm) : WGM;
        u.pm = fm + ((wgid % nig) % gsz); u.pn = (wgid % nig) / gsz; return true;
    }
    __device__ __forceinline__ void a_ready(const Unit&) const {}
    __device__ __forceinline__ void done(const Unit&) const {}
};
__device__ __forceinline__ unsigned cvt_pk_bf16(float lo, float hi) { unsigned r; asm volatile("v_cvt_pk_bf16_f32 %0, %1, %2" : "=v"(r) : "v"(lo), "v"(hi)); return r; }

template <class Epi, class Sched, bool ALIGN_EPI = false, bool SP2 = false>
__device__ __forceinline__ void gemm_phase(PG8_LAS unsigned char* lds, const Gemm g, const Sched& S, const Epi& E) {
    int tid_ = threadIdx.x; asm volatile("" : "+v"(tid_));
    const int tid = tid_, wid = __builtin_amdgcn_readfirstlane(tid >> 6), lane = tid & 63, wr = wid >> 2, wc = wid & 3, fr = lane & 15, fq = lane >> 4;
    const int K = g.K, nt = K / BK;
    unsigned voffA[2], voffB[2];
#pragma unroll
    for (int i = 0; i < 2; ++i) { int R, C; stage_rc(tid * 16 + i * 8192, R, C); const int Rb = Epi::PERM ? ((R & ~31) + perm32(R & 31)) : R;
        voffA[i] = (unsigned)(R * g.lda + C) * 2u; voffB[i] = (unsigned)(Rb * K + C) * 2u; }
    const size_t kstep = (size_t)(BK * 2);
    const size_t hstep = (size_t)HALF * K * 2, hstepA = (size_t)HALF * g.lda * 2;
    const size_t tstep = 2 * hstep, tstepA = 2 * hstepA;
    const unsigned ldsw = (unsigned)wid * 1024u;
    const int aoff = lds_byte(wr * 64 + fr, fq * 8), boff = lds_byte(wc * 32 + fr, fq * 8);
#define PG8_SA(b, h) (((b) * 2 + (h)) * HTB)
#define PG8_SB(b, h) ((4 + (b) * 2 + (h)) * HTB)
#define PG8_STAGE(bufoff, gbase, voff) do { _Pragma("unroll") for (int _i = 0; _i < 2; ++_i) \
        __builtin_amdgcn_global_load_lds((const unsigned*)((const char*)(gbase) + (voff)[_i]), (PG8_LAS unsigned*)(lds + (bufoff) + ldsw + _i * 8192), 16, 0, 0); } while (0)
#define PG8_LDA(dst, b, h) do { _Pragma("unroll") for (int m = 0; m < 4; ++m) _Pragma("unroll") for (int k = 0; k < 2; ++k) dst[m][k] = *(const PG8_LAS bf16x8*)(lds + PG8_SA(b, h) + aoff + m * 2048 + k * 1024); } while (0)
#define PG8_LDB(dst, b, h) do { _Pragma("unroll") for (int n = 0; n < 2; ++n) _Pragma("unroll") for (int k = 0; k < 2; ++k) dst[n][k] = *(const PG8_LAS bf16x8*)(lds + PG8_SB(b, h) + boff + n * 2048 + k * 1024); } while (0)
#define PG8_MMA(ai, bj, At, Bt) do { __builtin_amdgcn_s_setprio(1); _Pragma("unroll") for (int m = 0; m < 4; ++m) _Pragma("unroll") for (int n = 0; n < 2; ++n) _Pragma("unroll") for (int k = 0; k < 2; ++k) \
        acc[ai][bj][m][n] = __builtin_amdgcn_mfma_f32_16x16x32_bf16(Bt[n][k], At[m][k], acc[ai][bj][m][n], 0, 0, 0); __builtin_amdgcn_s_setprio(0); } while (0)
#define PG8_WAIT_V(n) asm volatile("s_waitcnt vmcnt(" #n ")" ::: "memory")
#define PG8_WAIT_L(n) asm volatile("s_waitcnt lgkmcnt(" #n ")" ::: "memory")
#define PG8_BAR __builtin_amdgcn_s_barrier()
#define PG8_SCHED __builtin_amdgcn_sched_barrier(0)
    Unit cur, nxt; int ui = 0;
    if (!S.next(0, cur)) return;
    f32x4 acc[2][2][4][2];
#pragma unroll
    for (int a = 0; a < 2; ++a)
#pragma unroll
        for (int b = 0; b < 2; ++b)
#pragma unroll
            for (int m = 0; m < 4; ++m)
#pragma unroll
                for (int n = 0; n < 2; ++n) acc[a][b][m][n] = (f32x4){0.f, 0.f, 0.f, 0.f};
    bf16x8 At[4][2], B0[2][2], B1[2][2];
    const char* cA = (const char*)g.A + (size_t)cur.pm * tstepA; const char* cB = (const char*)g.Bt + (size_t)cur.pn * tstep;
    S.a_ready(cur);
    if constexpr (SP2) {
        PG8_STAGE(PG8_SB(0, 0), cB, voffB); PG8_STAGE(PG8_SB(0, 1), cB + hstep, voffB); PG8_STAGE(PG8_SA(0, 0), cA, voffA); PG8_STAGE(PG8_SA(0, 1), cA + hstepA, voffA);
        if (wr == 1) PG8_BAR;
        PG8_WAIT_V(2); PG8_BAR;
        PG8_STAGE(PG8_SB(1, 0), cB + kstep, voffB); PG8_STAGE(PG8_SA(1, 0), cA + kstep, voffA); PG8_STAGE(PG8_SB(1, 1), cB + hstep + kstep, voffB);
        PG8_WAIT_V(6); PG8_BAR;
    } else {
        PG8_STAGE(PG8_SB(0, 0), cB, voffB); PG8_STAGE(PG8_SA(0, 0), cA, voffA); PG8_STAGE(PG8_SB(0, 1), cB + hstep, voffB); PG8_STAGE(PG8_SA(0, 1), cA + hstepA, voffA);
        if (wr == 1) PG8_BAR;
        PG8_WAIT_V(4); PG8_BAR;
        PG8_STAGE(PG8_SB(1, 0), cB + kstep, voffB); PG8_STAGE(PG8_SA(1, 0), cA + kstep, voffA); PG8_STAGE(PG8_SB(1, 1), cB + hstep + kstep, voffB);
        PG8_WAIT_V(6); PG8_BAR;
    }
    for (;;) {
        const bool has_next = S.next(ui + 1, nxt);
        const char* nA = has_next ? (const char*)g.A + (size_t)nxt.pm * tstepA : cA; const char* nB = has_next ? (const char*)g.Bt + (size_t)nxt.pn * tstep : cB;
        for (int t = 0; t < nt; t += 2) {
            const bool last = (t == nt - 2);
            const char* a1 = cA + (size_t)(t + 1) * kstep;
            const char* a2 = last ? nA : cA + (size_t)(t + 2) * kstep; const char* b2 = last ? nB : cB + (size_t)(t + 2) * kstep;
            const char* a3 = a2 + kstep; const char* b3 = b2 + kstep;
            if (last && has_next) S.a_ready(nxt);
            if constexpr (SP2) {
            PG8_LDB(B0, 0, 0); PG8_LDB(B1, 0, 1); PG8_SCHED; PG8_LDA(At, 0, 0); PG8_STAGE(PG8_SA(1, 1), a1 + hstepA, voffA);
            PG8_WAIT_V(8); PG8_WAIT_L(0); PG8_BAR; PG8_MMA(0, 0, At, B0); PG8_MMA(0, 1, At, B1); PG8_BAR; PG8_SCHED;
            PG8_LDA(At, 0, 1); PG8_STAGE(PG8_SB(0, 0), b2, voffB); PG8_STAGE(PG8_SB(0, 1), b2 + hstep, voffB); PG8_STAGE(PG8_SA(0, 0), a2, voffA);
            PG8_WAIT_V(8); PG8_WAIT_L(0); PG8_BAR; PG8_MMA(1, 0, At, B0); PG8_MMA(1, 1, At, B1); PG8_BAR; PG8_SCHED;
            PG8_LDB(B0, 1, 0); PG8_LDB(B1, 1, 1); PG8_SCHED; PG8_LDA(At, 1, 0); PG8_STAGE(PG8_SA(0, 1), a2 + hstepA, voffA);
            PG8_WAIT_V(8); PG8_WAIT_L(0); PG8_BAR; PG8_MMA(0, 0, At, B0); PG8_MMA(0, 1, At, B1); PG8_BAR; PG8_SCHED;
            PG8_LDA(At, 1, 1); PG8_STAGE(PG8_SB(1, 0), b3, voffB); PG8_STAGE(PG8_SB(1, 1), b3 + hstep, voffB); PG8_STAGE(PG8_SA(1, 0), a3, voffA);
            PG8_WAIT_V(8); PG8_WAIT_L(0); PG8_BAR; PG8_MMA(1, 0, At, B0); PG8_MMA(1, 1, At, B1); PG8_BAR; PG8_SCHED;
            } else {
            PG8_LDB(B0, 0, 0); PG8_SCHED; PG8_LDA(At, 0, 0); PG8_STAGE(PG8_SA(1, 1), a1 + hstepA, voffA);
            PG8_WAIT_L(8); PG8_BAR; PG8_WAIT_L(0); PG8_MMA(0, 0, At, B0); PG8_BAR; PG8_SCHED;
            PG8_LDB(B1, 0, 1); PG8_STAGE(PG8_SB(0, 0), b2, voffB);
            PG8_BAR; PG8_WAIT_L(0); PG8_MMA(0, 1, At, B1); PG8_BAR;
            PG8_LDA(At, 0, 1); PG8_STAGE(PG8_SA(0, 0), a2, voffA);
            PG8_BAR; PG8_WAIT_L(0); PG8_MMA(1, 0, At, B0); PG8_BAR; PG8_SCHED;
            PG8_STAGE(PG8_SB(0, 1), b2 + hstep, voffB);
            PG8_WAIT_V(6); PG8_BAR; PG8_MMA(1, 1, At, B1); PG8_BAR;
            PG8_LDB(B0, 1, 0); PG8_SCHED; PG8_LDA(At, 1, 0); PG8_STAGE(PG8_SA(0, 1), a2 + hstepA, voffA);
            PG8_WAIT_L(8); PG8_BAR; PG8_WAIT_L(0); PG8_MMA(0, 0, At, B0); PG8_BAR; PG8_SCHED;
            PG8_LDB(B1, 1, 1); PG8_STAGE(PG8_SB(1, 0), b3, voffB);
            PG8_BAR; PG8_WAIT_L(0); PG8_MMA(0, 1, At, B1); PG8_BAR;
            PG8_LDA(At, 1, 1); PG8_STAGE(PG8_SA(1, 0), a3, voffA);
            PG8_BAR; PG8_WAIT_L(0); PG8_MMA(1, 0, At, B0); PG8_BAR; PG8_SCHED;
            PG8_STAGE(PG8_SB(1, 1), b3 + hstep, voffB);
            PG8_WAIT_V(6); PG8_BAR; PG8_MMA(1, 1, At, B1); PG8_BAR;
            }
        }
        if constexpr (ALIGN_EPI) { if (wr == 0) PG8_BAR; }
        if constexpr (!Epi::AFTER_DRAIN) { E(acc, cur, wr, wc, fr, fq); S.done(cur); }
        if (!has_next) break;
#pragma unroll
        for (int a = 0; a < 2; ++a)
#pragma unroll
            for (int b = 0; b < 2; ++b)
#pragma unroll
                for (int m = 0; m < 4; ++m)
#pragma unroll
                    for (int n = 0; n < 2; ++n) acc[a][b][m][n] = (f32x4){0.f, 0.f, 0.f, 0.f};
        cur = nxt; cA = nA; cB = nB; ++ui;
        if constexpr (ALIGN_EPI) { if (wr == 1) PG8_BAR; }
    }
    PG8_WAIT_V(0);
    if constexpr (!ALIGN_EPI) { if (wr == 0) PG8_BAR; }
    PG8_BAR;
    if constexpr (Epi::AFTER_DRAIN) { E.fused(acc, cur, wr, wc, fr, fq, lds, wid, lane); S.done(cur); }
#undef PG8_SA
#undef PG8_SB
#undef PG8_STAGE
#undef PG8_LDA
#undef PG8_LDB
#undef PG8_MMA
#undef PG8_WAIT_V
#undef PG8_WAIT_L
#undef PG8_BAR
#undef PG8_SCHED
}
}

#define LAS __attribute__((address_space(3)))
using pg8::bf16_t; using pg8::bf16x8; using pg8::f32x4; using pg8::u32x4;
typedef float f32x16 __attribute__((ext_vector_type(16)));
typedef float f32x2 __attribute__((ext_vector_type(2)));
typedef unsigned u32x2 __attribute__((ext_vector_type(2)));
typedef __bf16 bf16x2v __attribute__((ext_vector_type(2)));

constexpr int DM = 1024, MP = 65536, MS = 512, MT = MP + MS  , MC = 32768, MKV = MT + MC  ;
constexpr int DFF = 2816, NINP = 4864, NMODC = 9216;
constexpr float EPSF = 1e-6f;
constexpr int LDS_BYTES = 131072 + 256;
constexpr int NSTEPS = 19;
#define STAGGER_MODE 0
#define GEMM_ALIGN_EPI true
#define GEMM_SP2 true
#define PROBE_DUP -1

constexpr size_t al256(size_t x) { return (x + 255) & ~(size_t)255; }
constexpr size_t O_CTL = 0;
constexpr size_t O_MOD = 256;
constexpr size_t O_RV  = al256(O_MOD + (size_t)40 * NMODC * 4);
constexpr size_t O_W1U = al256(O_RV + (size_t)MT * 4);
constexpr size_t O_W1D = O_W1U + (size_t)2 * DFF * DM * 2;
constexpr size_t O_W2U = O_W1D + (size_t)DM * DFF * 2;
constexpr size_t O_W2D = O_W2U + (size_t)2 * DFF * DM * 2;
constexpr size_t O_WIN = O_W2D + (size_t)DM * DFF * 2;
constexpr size_t O_WUQ = O_WIN + (size_t)NINP * DM * 2;
constexpr size_t O_WUK = O_WUQ + (size_t)768 * 384 * 2;
constexpr size_t O_WUV = O_WUK + (size_t)512 * 256 * 2;
constexpr size_t O_WBA = O_WUV + (size_t)512 * 256 * 2;
constexpr size_t O_WBB = O_WBA + (size_t)1024 * 1024 * 2;
constexpr size_t O_WO  = O_WBB + (size_t)1024 * 512 * 2;
constexpr size_t O_WS  = O_WO + (size_t)1024 * 1024 * 2;
constexpr size_t O_H   = al256(O_WS + (size_t)8 * 128 * 128 * 2);
constexpr size_t O_ZA  = O_H + (size_t)MT * 1024 * 2;
constexpr size_t O_G   = O_ZA + (size_t)MT * 2048 * 2;
constexpr size_t O_ZS  = O_G + (size_t)MT * 2048 * 2;
constexpr size_t O_KF  = O_ZS + (size_t)MT * 768 * 2;
constexpr size_t O_CKV = O_KF + (size_t)MKV * 768 * 2;
constexpr size_t O_KR  = O_CKV + (size_t)MKV * 256 * 2;
constexpr size_t O_KRSS = O_KR + (size_t)MKV * 32 * 4;
constexpr size_t O_BAR = al256(O_KRSS + (size_t)MKV * 4);
constexpr size_t O_T2 = O_BAR + 16384;
constexpr size_t WS_END = O_T2 + (size_t)MS * 1024 * 2;
constexpr size_t O_ACT = O_ZA;
constexpr size_t O_QR  = O_ZA;
constexpr size_t O_VT  = O_ZA + (size_t)MT * 768 * 2;
constexpr size_t O_T   = O_ZA;
constexpr size_t O_MG  = O_ZA + (size_t)MT * 1024 * 2;
constexpr size_t O_OB  = O_ZS;
constexpr size_t O_X2  = O_ZS;
constexpr size_t O_OA  = O_H;
static_assert((size_t)MT * 768 * 2 + (size_t)512 * MKV * 2 <= (size_t)MT * 2048 * 2, "QR+VT must fit in ZA");
static_assert((size_t)MT * DFF * 2 <= (size_t)MT * 4096 * 2, "ACT must fit in ZA+G");

constexpr size_t OUT_Y = 0;
constexpr size_t OUT_CKVP = (size_t)MT * 1024;
constexpr size_t OUT_KRP = OUT_CKVP + (size_t)MP * 256;
constexpr size_t OUT_CKVS = OUT_KRP + (size_t)MP * 32;
constexpr size_t OUT_KRS = OUT_CKVS + (size_t)MS * 256;
constexpr size_t OUT_GV = OUT_KRS + (size_t)MS * 32;

enum { I_XP = 0, I_XS, I_CP, I_CS, I_CCKV, I_CKR, I_WMOD, I_BMOD, I_GFFN1, I_W1U, I_W1D, I_GMIX, I_WIN, I_GGV, I_GWS, I_GB, I_GQL, I_WUQ, I_GKVL, I_WUK, I_WUV,
       I_GQN, I_GKN, I_BGATE, I_WBA, I_WBB, I_WO, I_GFFN2, I_W2U, I_W2D };

struct Params {
    const float* in[30];
    float* out;
    unsigned char* ws;
    int ph_lo, ph_hi;
};

__device__ __forceinline__ unsigned pk2(float lo, float hi) { f32x2 v = {lo, hi}; bf16x2v b = __builtin_convertvector(v, bf16x2v); return __builtin_bit_cast(unsigned, b); }
__device__ __forceinline__ float bflo(unsigned w) { return __uint_as_float(w << 16); }
__device__ __forceinline__ float bfhi(unsigned w) { return __uint_as_float(w & 0xffff0000u); }
__device__ __forceinline__ float bf2f(bf16_t b) { return __uint_as_float((unsigned)b << 16); }
__device__ __forceinline__ bf16_t f2bf(float x) { return (bf16_t)(pk2(x, 0.f) & 0xffffu); }
__device__ __forceinline__ float wave_sum(float v) {
#pragma unroll
    for (int o = 1; o < 64; o <<= 1) v += __shfl_xor(v, o);
    return v;
}
__device__ __forceinline__ float fast_exp2(float x) { return __builtin_amdgcn_exp2f(x); }
__device__ __forceinline__ float sigmoidf_(float x) { return __builtin_amdgcn_rcpf(1.0f + fast_exp2(-1.4426950408889634f * x)); }
__device__ __forceinline__ float siluf_(float x) { return x * sigmoidf_(x); }
__device__ __forceinline__ float gelu_tanh(float x) { const float y = 1.5957691216057308f * (x + 0.044715f * x * x * x); return x * sigmoidf_(y); }
__device__ __forceinline__ int batch_of(int row) { return row < MP ? (row >> 11) : 32 + ((row - MP) >> 6); }
__device__ __forceinline__ float pos_of(int row) { return row < MP ? (float)(row & 2047) : (float)(4096 + ((row - MP) & 63)); }
__device__ __forceinline__ void rope_sc(float pos, int i, float& sn, float& cs) {
    const float freq = exp2f(-(float)i * (13.287712379549449f / 16.0f));
    const float ang = pos * freq;
    float rev = ang * 0.15915494309189535f; rev = rev - floorf(rev);
    sn = __builtin_amdgcn_sinf(rev); cs = __builtin_amdgcn_cosf(rev);
}

enum { EM_SWIGLU = 0, EM_RESID, EM_WIN, EM_PLAIN, EM_KNOPE, EM_BRA, EM_BRB, EM_RESID_B2B, EM_RESID_B2F };
struct Epi {
    static constexpr bool PERM = true, AFTER_DRAIN = false;
    int mode, sub, gidx, row_off; float coef;
    unsigned char* ws; float* Y; const float* xp; const float* xs; const float* bgate;
    __device__ __forceinline__ void operator()(const f32x4 (&acc)[2][2][4][2], const pg8::Unit& u, int wr, int wc, int fr, int fq) const {
        const int row0 = row_off + u.pm * 256 + wr * 64 + fr, cl = wc * 32 + 8 * fq;
        const float* MODv = (const float*)(ws + O_MOD);
        bf16_t* O = (bf16_t*)(ws + (mode == EM_SWIGLU ? O_ACT : mode == EM_KNOPE ? O_KF : mode == EM_BRA ? O_T : mode == EM_BRB ? O_MG : (sub == 0 ? O_QR : O_VT)));
        if (mode == EM_BRA && (row_off + u.pm * 256) >= MP) O = (bf16_t*)(ws + O_T2) - (size_t)MP * 1024;
        const int ldc = sub == 0 ? 768 : MKV;
        const bool srows = (row_off + u.pm * 256) >= MP;
        const bf16_t* G = (const bf16_t*)(ws + O_G); const bf16_t* T = srows ? (const bf16_t*)(ws + O_T2) - (size_t)MP * 1024 : (const bf16_t*)(ws + O_T);
        bf16_t* ZA = (bf16_t*)(ws + O_ZA); bf16_t* Gw = (bf16_t*)(ws + O_G); bf16_t* ZS = (bf16_t*)(ws + O_ZS);
        const bf16_t* xb = (mode == EM_RESID_B2B) ? (const bf16_t*)Y : (const bf16_t*)(ws + O_X2);
        bf16_t* yb = (mode == EM_RESID) ? (bf16_t*)Y : (bf16_t*)(ws + O_X2);
        if (mode == EM_SWIGLU) {
#pragma unroll
            for (int ai = 0; ai < 2; ++ai)
#pragma unroll
                for (int m = 0; m < 4; ++m) {
                    const int r = row0 + ai * 128 + m * 16;
                    float o[8];
#pragma unroll
                    for (int n = 0; n < 2; ++n)
#pragma unroll
                        for (int j = 0; j < 4; ++j) { const float g = acc[ai][0][m][n][j], uu = acc[ai][1][m][n][j]; o[4 * n + j] = siluf_(g) * uu; }
                    u32x4 w; w.x = pk2(o[0], o[1]); w.y = pk2(o[2], o[3]); w.z = pk2(o[4], o[5]); w.w = pk2(o[6], o[7]);
                    *(u32x4*)(O + (size_t)r * DFF + u.pn * 128 + cl) = w;
                }
        } else if (mode == EM_RESID) {
            const int c0 = u.pn * 256 + cl;
#pragma unroll
            for (int ai = 0; ai < 2; ++ai) {
                f32x4 gg[2][2];
                const float* gt = MODv + (size_t)batch_of(row0 + ai * 128) * NMODC + gidx * DM;
#pragma unroll
                for (int bj = 0; bj < 2; ++bj)
#pragma unroll
                    for (int n = 0; n < 2; ++n) gg[bj][n] = *(const f32x4*)(gt + c0 + bj * 128 + 4 * n) * coef;
#pragma unroll
                for (int mh = 0; mh < 2; ++mh) {
                    f32x4 bs[2][2][2];
#pragma unroll
                    for (int mm = 0; mm < 2; ++mm) { const int r = row0 + ai * 128 + (2 * mh + mm) * 16; const float* base = (r < MP) ? xp + (size_t)r * DM : xs + (size_t)(r - MP) * DM;
#pragma unroll
                        for (int bj = 0; bj < 2; ++bj)
#pragma unroll
                            for (int n = 0; n < 2; ++n) bs[mm][bj][n] = *(const f32x4*)(base + c0 + bj * 128 + 4 * n); }
                    asm volatile("" ::: "memory");
#pragma unroll
                    for (int mm = 0; mm < 2; ++mm) { const int m = 2 * mh + mm; const int r = row0 + ai * 128 + m * 16;
#pragma unroll
                        for (int bj = 0; bj < 2; ++bj) {
                            const f32x4 o0 = bs[mm][bj][0] + gg[bj][0] * acc[ai][bj][m][0], o1 = bs[mm][bj][1] + gg[bj][1] * acc[ai][bj][m][1];
                            u32x4 w; w.x = pk2(o0[0], o0[1]); w.y = pk2(o0[2], o0[3]); w.z = pk2(o1[0], o1[1]); w.w = pk2(o1[2], o1[3]);
                            *(u32x4*)(yb + (size_t)r * DM + c0 + bj * 128) = w;
                        } }
                    asm volatile("" ::: "memory");
                }
            }
        } else if (mode == EM_RESID_B2B || mode == EM_RESID_B2F) {
            const int c0 = u.pn * 256 + cl;
            const bool tof32 = (mode == EM_RESID_B2F);
#pragma unroll
            for (int ai = 0; ai < 2; ++ai) {
                u32x4 bs[4][2]; f32x4 gg[2][2];
                const bf16_t* xrow = xb + (size_t)(row0 + ai * 128) * DM + c0;
#pragma unroll
                for (int m = 0; m < 4; ++m)
#pragma unroll
                    for (int bj = 0; bj < 2; ++bj) bs[m][bj] = *(const u32x4*)(xrow + (size_t)m * 16 * DM + bj * 128);
                const float* gt = MODv + (size_t)batch_of(row0 + ai * 128) * NMODC + gidx * DM;
#pragma unroll
                for (int bj = 0; bj < 2; ++bj)
#pragma unroll
                    for (int n = 0; n < 2; ++n) gg[bj][n] = *(const f32x4*)(gt + c0 + bj * 128 + 4 * n) * coef;
                asm volatile("" ::: "memory");
#pragma unroll
                for (int m = 0; m < 4; ++m) {
                    const int r = row0 + ai * 128 + m * 16;
#pragma unroll
                    for (int bj = 0; bj < 2; ++bj) {
                        const u32x4 bw = bs[m][bj];
                        const f32x4 b0 = {bflo(bw.x), bfhi(bw.x), bflo(bw.y), bfhi(bw.y)}, b1 = {bflo(bw.z), bfhi(bw.z), bflo(bw.w), bfhi(bw.w)};
                        const f32x4 o0 = b0 + gg[bj][0] * acc[ai][bj][m][0], o1 = b1 + gg[bj][1] * acc[ai][bj][m][1];
                        if (tof32) { float* yo = Y + (size_t)r * DM + c0 + bj * 128; *(f32x4*)yo = o0; *(f32x4*)(yo + 4) = o1; }
                        else { u32x4 w; w.x = pk2(o0[0], o0[1]); w.y = pk2(o0[2], o0[3]); w.z = pk2(o1[0], o1[1]); w.w = pk2(o1[2], o1[3]);
                               *(u32x4*)(yb + (size_t)r * DM + c0 + bj * 128) = w; }
                    }
                }
                asm volatile("" ::: "memory");
            }
        } else if (mode == EM_WIN) {
            const int sel = u.pn < 8 ? 0 : (u.pn < 16 ? 1 : 2);
#pragma unroll
            for (int ai = 0; ai < 2; ++ai)
#pragma unroll
                for (int m = 0; m < 4; ++m) {
                    const int r = row0 + ai * 128 + m * 16;
#pragma unroll
                    for (int bj = 0; bj < 2; ++bj) {
                        float o[8];
#pragma unroll
                        for (int n = 0; n < 2; ++n)
#pragma unroll
                            for (int j = 0; j < 4; ++j) o[4 * n + j] = acc[ai][bj][m][n][j];
                        bf16_t* dst;
                        if (sel == 0) {
                            const int c = u.pn * 256 + bj * 128 + cl;
                            dst = ZA + (size_t)r * 2048 + c;
                        } else if (sel == 1) {
                            const int c = (u.pn - 8) * 256 + bj * 128 + cl;
                            const f32x4 b0 = *(const f32x4*)(bgate + c), b1 = *(const f32x4*)(bgate + c + 4);
#pragma unroll
                            for (int j = 0; j < 4; ++j) { o[j] = sigmoidf_(o[j] + b0[j]); o[4 + j] = sigmoidf_(o[4 + j] + b1[j]); }
                            dst = Gw + (size_t)r * 2048 + c;
                        } else {
                            const int c = (u.pn - 16) * 256 + bj * 128 + cl;
                            dst = ZS + (size_t)r * 768 + c;
                        }
                        u32x4 w; w.x = pk2(o[0], o[1]); w.y = pk2(o[2], o[3]); w.z = pk2(o[4], o[5]); w.w = pk2(o[6], o[7]);
                        *(u32x4*)dst = w;
                    }
                }
        } else if (mode == EM_KNOPE) {
            const int head = u.pn * 4 + wc;
            const float* gkn = bgate;
            const float* KRp = (const float*)(ws + O_KR); const float* KSS = (const float*)(ws + O_KRSS);
            f32x4 gn[2][2], gr[2];
#pragma unroll
            for (int bj = 0; bj < 2; ++bj) { gn[bj][0] = *(const f32x4*)(gkn + bj * 32 + 8 * fq); gn[bj][1] = *(const f32x4*)(gkn + bj * 32 + 8 * fq + 4); }
            gr[0] = *(const f32x4*)(gkn + 64 + 8 * fq); gr[1] = *(const f32x4*)(gkn + 64 + 8 * fq + 4);
#pragma unroll
            for (int ai = 0; ai < 2; ++ai)
#pragma unroll
                for (int m = 0; m < 4; ++m) {
                    const int r = row0 + ai * 128 + m * 16;
                    const f32x4 k0 = *(const f32x4*)(KRp + (size_t)r * 32 + 8 * fq), k1 = *(const f32x4*)(KRp + (size_t)r * 32 + 8 * fq + 4);
                    const float krss = KSS[r];
                    float ss = 0.f;
#pragma unroll
                    for (int bj = 0; bj < 2; ++bj)
#pragma unroll
                        for (int n = 0; n < 2; ++n) { const f32x4 v = acc[ai][bj][m][n]; ss += (v[0] * v[0] + v[1] * v[1]) + (v[2] * v[2] + v[3] * v[3]); }
                    ss += __shfl_xor(ss, 16); ss += __shfl_xor(ss, 32);
                    const float rinv = rsqrtf((ss + krss) * (1.0f / 96.0f) + EPSF);
                    bf16_t* dst = O + (size_t)r * 768 + head * 96;
#pragma unroll
                    for (int bj = 0; bj < 2; ++bj) {
                        const f32x4 v0 = acc[ai][bj][m][0] * gn[bj][0] * rinv, v1 = acc[ai][bj][m][1] * gn[bj][1] * rinv;
                        u32x4 w; w.x = pk2(v0[0], v0[1]); w.y = pk2(v0[2], v0[3]); w.z = pk2(v1[0], v1[1]); w.w = pk2(v1[2], v1[3]);
                        *(u32x4*)(dst + bj * 32 + 8 * fq) = w;
                    }
                    { const f32x4 v0 = k0 * gr[0] * rinv, v1 = k1 * gr[1] * rinv;
                      u32x4 w; w.x = pk2(v0[0], v0[1]); w.y = pk2(v0[2], v0[3]); w.z = pk2(v1[0], v1[1]); w.w = pk2(v1[2], v1[3]);
                      *(u32x4*)(dst + 64 + 8 * fq) = w; }
                }
        } else if (mode == EM_PLAIN) {
#pragma unroll
            for (int ai = 0; ai < 2; ++ai)
#pragma unroll
                for (int m = 0; m < 4; ++m) {
                    const int r = row0 + ai * 128 + m * 16;
#pragma unroll
                    for (int bj = 0; bj < 2; ++bj) {
                        const int c = u.pn * 256 + bj * 128 + cl;
                        const f32x4 v0 = acc[ai][bj][m][0], v1 = acc[ai][bj][m][1];
                        u32x4 w; w.x = pk2(v0[0], v0[1]); w.y = pk2(v0[2], v0[3]); w.z = pk2(v1[0], v1[1]); w.w = pk2(v1[2], v1[3]);
                        *(u32x4*)(O + (size_t)r * ldc + c) = w;
                    }
                }
        } else {
            const int c0 = u.pn * 256 + cl;
            const bool isb = (mode == EM_BRB);
#pragma unroll
            for (int ai = 0; ai < 2; ++ai) {
                u32x4 gs[4][2], ts[4][2];
                const bf16_t* grow = G + (size_t)(row0 + ai * 128) * 2048 + (isb ? 1024 : 0) + c0;
                const bf16_t* trow = T + (size_t)(row0 + ai * 128) * 1024 + c0;
#pragma unroll
                for (int m = 0; m < 4; ++m)
#pragma unroll
                    for (int bj = 0; bj < 2; ++bj) { gs[m][bj] = *(const u32x4*)(grow + (size_t)m * 16 * 2048 + bj * 128);
                        ts[m][bj] = isb ? *(const u32x4*)(trow + (size_t)m * 16 * 1024 + bj * 128) : (u32x4){0u, 0u, 0u, 0u}; }
                asm volatile("" ::: "memory");
#pragma unroll
                for (int m = 0; m < 4; ++m) { const int r = row0 + ai * 128 + m * 16;
#pragma unroll
                    for (int bj = 0; bj < 2; ++bj) {
                        const u32x4 gw = gs[m][bj], tw = ts[m][bj];
                        const f32x4 v0 = acc[ai][bj][m][0], v1 = acc[ai][bj][m][1];
                        float o[8];
                        o[0] = bflo(gw.x) * v0[0]; o[1] = bfhi(gw.x) * v0[1]; o[2] = bflo(gw.y) * v0[2]; o[3] = bfhi(gw.y) * v0[3];
                        o[4] = bflo(gw.z) * v1[0]; o[5] = bfhi(gw.z) * v1[1]; o[6] = bflo(gw.w) * v1[2]; o[7] = bfhi(gw.w) * v1[3];
                        if (isb) { o[0] += bflo(tw.x); o[1] += bfhi(tw.x); o[2] += bflo(tw.y); o[3] += bfhi(tw.y);
                                   o[4] += bflo(tw.z); o[5] += bfhi(tw.z); o[6] += bflo(tw.w); o[7] += bfhi(tw.w); }
                        u32x4 w; w.x = pk2(o[0], o[1]); w.y = pk2(o[2], o[3]); w.z = pk2(o[4], o[5]); w.w = pk2(o[6], o[7]);
                        *(u32x4*)(O + (size_t)r * 1024 + c0 + bj * 128) = w;
                    } }
                asm volatile("" ::: "memory");
            }
        }
    }
};

template <class MapF>
__device__ __forceinline__ void conv_wT(const float* __restrict__ W, int K, int Nsrc, bf16_t* __restrict__ Bt, int Ndst, MapF map, size_t gtid, size_t gsz) {
    const size_t total = (size_t)Ndst * (size_t)(K / 8);
    for (size_t i = gtid; i < total; i += gsz) {
        const int n = (int)(i % (size_t)Ndst), kb = (int)(i / (size_t)Ndst);
        const int src = map(n);
        u32x4 o = {0u, 0u, 0u, 0u};
        if (src >= 0) {
            const float* p = W + (size_t)(kb * 8) * Nsrc + src;
            const float v0 = p[0], v1 = p[(size_t)Nsrc], v2 = p[(size_t)2 * Nsrc], v3 = p[(size_t)3 * Nsrc], v4 = p[(size_t)4 * Nsrc], v5 = p[(size_t)5 * Nsrc], v6 = p[(size_t)6 * Nsrc], v7 = p[(size_t)7 * Nsrc];
            o.x = pk2(v0, v1); o.y = pk2(v2, v3); o.z = pk2(v4, v5); o.w = pk2(v6, v7);
        }
        *(u32x4*)(Bt + (size_t)n * K + kb * 8) = o;
    }
}
struct MapId { __device__ __forceinline__ int operator()(int n) const { return n; } };
struct MapUp { __device__ __forceinline__ int operator()(int n) const { const int t = n >> 8, l = n & 255; return l < 128 ? t * 128 + l : DFF + t * 128 + (l - 128); } };
struct MapUk { __device__ __forceinline__ int operator()(int n) const { const int pn = n >> 8, bj = (n >> 7) & 1, wc = (n >> 5) & 3, x = n & 31; return (pn * 4 + wc) * 64 + bj * 32 + x; } };
struct MapIn { __device__ __forceinline__ int operator()(int n) const { return n < 2048 ? n : (n < 4096 ? 2720 + (n - 2048) : (n < 4768 ? 2048 + (n - 4096) : -1)); } };

__device__ __forceinline__ void prep_phase(const Params& P, LAS unsigned char* lds) {
    int tid_ = threadIdx.x; asm volatile("" : "+v"(tid_));
    const int tid = tid_, lane = tid & 63, wid = __builtin_amdgcn_readfirstlane(tid >> 6);
    const size_t gtid = (size_t)blockIdx.x * 512 + tid, gsz = (size_t)gridDim.x * 512;
    unsigned char* ws = P.ws;
    if (gtid < 64) ((unsigned*)(ws + O_CTL))[gtid] = 0u;
    if (blockIdx.x < NMODC / 64) {
        const int n0 = blockIdx.x * 64;
        const float* cp = P.in[I_CP]; const float* cs = P.in[I_CS]; const float* wm = P.in[I_WMOD];
        LAS float* sc = (LAS float*)lds;
        float acc[40];
#pragma unroll
        for (int b = 0; b < 40; ++b) acc[b] = 0.f;
        for (int half = 0; half < 2; ++half) {
            __syncthreads();
            for (int i = tid; i < 40 * 512; i += 512) { const int b = i >> 9, k = i & 511; const float c = b < 32 ? cp[b * 1024 + half * 512 + k] : cs[(b - 32) * 1024 + half * 512 + k]; sc[i] = siluf_(c); }
            __syncthreads();
            for (int kk = 0; kk < 64; kk += 4) {
                const int kl = wid * 64 + kk; const size_t kg = (size_t)(half * 512 + kl);
                const float w0 = wm[kg * NMODC + n0 + lane], w1 = wm[(kg + 1) * NMODC + n0 + lane], w2 = wm[(kg + 2) * NMODC + n0 + lane], w3 = wm[(kg + 3) * NMODC + n0 + lane];
#pragma unroll
                for (int b = 0; b < 40; ++b) { const f32x4 s = *(const LAS f32x4*)(sc + b * 512 + kl); acc[b] += s.x * w0 + s.y * w1 + s.z * w2 + s.w * w3; }
            }
        }
        __syncthreads();
        LAS float* red = (LAS float*)lds;
#pragma unroll
        for (int b = 0; b < 40; ++b) red[(wid * 40 + b) * 64 + lane] = acc[b];
        __syncthreads();
        float* MODv = (float*)(ws + O_MOD); const float* bm = P.in[I_BMOD];
        for (int i = tid; i < 40 * 64; i += 512) { const int b = i >> 6, l = i & 63; float s = bm[n0 + l];
#pragma unroll
            for (int w = 0; w < 8; ++w) s += red[(w * 40 + b) * 64 + l];
            MODv[(size_t)b * NMODC + n0 + l] = s; }
        __syncthreads();
    }
    conv_wT(P.in[I_W1U], 1024, 2 * DFF, (bf16_t*)(ws + O_W1U), 2 * DFF, MapUp(), gtid, gsz);
    conv_wT(P.in[I_W2U], 1024, 2 * DFF, (bf16_t*)(ws + O_W2U), 2 * DFF, MapUp(), gtid, gsz);
    conv_wT(P.in[I_W1D], DFF, 1024, (bf16_t*)(ws + O_W1D), 1024, MapId(), gtid, gsz);
    conv_wT(P.in[I_W2D], DFF, 1024, (bf16_t*)(ws + O_W2D), 1024, MapId(), gtid, gsz);
    conv_wT(P.in[I_WIN], 1024, 4768, (bf16_t*)(ws + O_WIN), NINP, MapIn(), gtid, gsz);
    conv_wT(P.in[I_WUQ], 384, 768, (bf16_t*)(ws + O_WUQ), 768, MapId(), gtid, gsz);
    conv_wT(P.in[I_WUK], 256, 512, (bf16_t*)(ws + O_WUK), 512, MapUk(), gtid, gsz);
    conv_wT(P.in[I_WUV], 256, 512, (bf16_t*)(ws + O_WUV), 512, MapId(), gtid, gsz);
    conv_wT(P.in[I_WBA], 1024, 1024, (bf16_t*)(ws + O_WBA), 1024, MapId(), gtid, gsz);
    conv_wT(P.in[I_WBB], 512, 1024, (bf16_t*)(ws + O_WBB), 1024, MapId(), gtid, gsz);
    conv_wT(P.in[I_WO], 1024, 1024, (bf16_t*)(ws + O_WO), 1024, MapId(), gtid, gsz);
    { const float* w = P.in[I_GWS]; bf16_t* o = (bf16_t*)(ws + O_WS);
      for (size_t i = gtid; i < (size_t)8 * 128 * 128; i += gsz) { const int s = (int)(i & 127), t = (int)((i >> 7) & 127); o[i] = f2bf(s <= t ? w[i] : 0.f); } }
    { const float* c = P.in[I_CCKV]; bf16_t* o = (bf16_t*)(ws + O_CKV) + (size_t)MT * 256;
      for (size_t i = gtid; i < (size_t)MC * 256 / 4; i += gsz) { const f32x4 v = *(const f32x4*)(c + 4 * i); u32x2 w; w.x = pk2(v.x, v.y); w.y = pk2(v.z, v.w); *(u32x2*)(o + 4 * i) = w; }
      const float* kr = P.in[I_CKR]; float* ko = (float*)(ws + O_KR) + (size_t)MT * 32; float* kss = (float*)(ws + O_KRSS) + MT;
      for (size_t i = gtid; i < (size_t)MC; i += gsz) { float ss = 0.f;
#pragma unroll
          for (int j = 0; j < 8; ++j) { const f32x4 v = *(const f32x4*)(kr + 32 * i + 4 * j); *(f32x4*)(ko + 32 * i + 4 * j) = v; ss += (v.x * v.x + v.y * v.y) + (v.z * v.z + v.w * v.w); }
          kss[i] = ss; } }
}

__device__ __forceinline__ void modulate_phase(const float* xp, const float* xs, const float* g, const float* MODv, int ish, int isc, bf16_t* H) {
    int tid_ = threadIdx.x; asm volatile("" : "+v"(tid_));
    const int tid = tid_, lane = tid & 63, wid = tid >> 6;
    const int gw = blockIdx.x * 8 + wid, ngw = gridDim.x * 8;
    f32x4 v[4][4], vn[4][4];
#define MOD_LOAD(dst, rb) do { _Pragma("unroll") for (int q = 0; q < 4; ++q) { const int row_ = (rb) + q * ngw; \
            if (row_ < MT) { const float* x_ = row_ < MP ? xp + (size_t)row_ * DM : xs + (size_t)(row_ - MP) * DM; \
                _Pragma("unroll") for (int j = 0; j < 4; ++j) dst[q][j] = *(const f32x4*)(x_ + 4 * lane + 256 * j); } \
            else { _Pragma("unroll") for (int j = 0; j < 4; ++j) dst[q][j] = (f32x4){0.f, 0.f, 0.f, 0.f}; } } } while (0)
    MOD_LOAD(v, gw);
    for (int rowb = gw; rowb < MT; rowb += 4 * ngw) {
        if (rowb + 4 * ngw < MT) MOD_LOAD(vn, rowb + 4 * ngw);
        float ss[4];
#pragma unroll
        for (int q = 0; q < 4; ++q) { float t = 0.f;
#pragma unroll
            for (int j = 0; j < 4; ++j) t += (v[q][j].x * v[q][j].x + v[q][j].y * v[q][j].y) + (v[q][j].z * v[q][j].z + v[q][j].w * v[q][j].w);
            ss[q] = wave_sum(t); }
#pragma unroll
        for (int q = 0; q < 4; ++q) {
            const int row = rowb + q * ngw;
            if (row < MT) {
                const float* mb = MODv + (size_t)batch_of(row) * NMODC;
                const float r = rsqrtf(ss[q] * (1.0f / 1024.0f) + EPSF);
#pragma unroll
                for (int j = 0; j < 4; ++j) {
                    const int c = 4 * lane + 256 * j;
                    const f32x4 gg = *(const f32x4*)(g + c), sc = *(const f32x4*)(mb + isc * DM + c), sh = *(const f32x4*)(mb + ish * DM + c);
                    const f32x4 o = (v[q][j] * r) * gg * (sc + 1.0f) + sh;
                    u32x2 w; w.x = pk2(o.x, o.y); w.y = pk2(o.z, o.w);
                    *(u32x2*)(H + (size_t)row * DM + c) = w;
                }
            }
        }
#pragma unroll
        for (int q = 0; q < 4; ++q)
#pragma unroll
            for (int j = 0; j < 4; ++j) v[q][j] = vn[q][j];
    }
#undef MOD_LOAD
}

__device__ __forceinline__ void modulate16_phase(const bf16_t* X, const float* g, const float* MODv, int ish, int isc, bf16_t* H, int row_begin, int row_end, int blk_first) {
    int tid_ = threadIdx.x; asm volatile("" : "+v"(tid_));
    const int tid = tid_, lane = tid & 63, wid = tid >> 6;
    if ((int)blockIdx.x < blk_first) return;
    const int gw = ((int)blockIdx.x - blk_first) * 8 + wid, ngw = ((int)gridDim.x - blk_first) * 8;
    for (int rowb = row_begin + gw; rowb < row_end; rowb += 4 * ngw) {
        u32x4 v[4][2]; float ss[4];
#pragma unroll
        for (int q = 0; q < 4; ++q) {
            const int row = min(rowb + q * ngw, row_end - 1);
#pragma unroll
            for (int j = 0; j < 2; ++j) v[q][j] = *(const u32x4*)(X + (size_t)row * DM + 8 * lane + 512 * j);
        }
#pragma unroll
        for (int q = 0; q < 4; ++q) { float t = 0.f;
#pragma unroll
            for (int j = 0; j < 2; ++j) { const unsigned w[4] = {v[q][j].x, v[q][j].y, v[q][j].z, v[q][j].w};
#pragma unroll
                for (int e = 0; e < 4; ++e) { const float lo = bflo(w[e]), hi = bfhi(w[e]); t += lo * lo + hi * hi; } }
            ss[q] = wave_sum(t); }
#pragma unroll
        for (int q = 0; q < 4; ++q) {
            const int row = rowb + q * ngw;
            if (row < row_end) {
                const float* mb = MODv + (size_t)batch_of(row) * NMODC;
                const float r = rsqrtf(ss[q] * (1.0f / 1024.0f) + EPSF);
#pragma unroll
                for (int j = 0; j < 2; ++j) {
                    const int c = 8 * lane + 512 * j;
                    const unsigned w[4] = {v[q][j].x, v[q][j].y, v[q][j].z, v[q][j].w};
                    unsigned ow[4];
#pragma unroll
                    for (int e = 0; e < 2; ++e) {
                        const f32x4 gg = *(const f32x4*)(g + c + 4 * e), sc = *(const f32x4*)(mb + isc * DM + c + 4 * e), sh = *(const f32x4*)(mb + ish * DM + c + 4 * e);
                        const f32x4 x = {bflo(w[2 * e]), bfhi(w[2 * e]), bflo(w[2 * e + 1]), bfhi(w[2 * e + 1])};
                        const f32x4 o = (x * r) * gg * (sc + 1.0f) + sh;
                        ow[2 * e] = pk2(o.x, o.y); ow[2 * e + 1] = pk2(o.z, o.w);
                    }
                    *(u32x4*)(H + (size_t)row * DM + c) = (u32x4){ow[0], ow[1], ow[2], ow[3]};
                }
            }
        }
    }
}

__device__ __forceinline__ void rowpost_phase(const Params& P) {
    int tid_ = threadIdx.x; asm volatile("" : "+v"(tid_));
    const int tid = tid_, lane = tid & 63, wid = tid >> 6;
    const int gw = blockIdx.x * 8 + wid, ngw = gridDim.x * 8;
    unsigned char* ws = P.ws;
    const bf16_t* ZA = (const bf16_t*)(ws + O_ZA); bf16_t* ZS = (bf16_t*)(ws + O_ZS); float* RV = (float*)(ws + O_RV);
    bf16_t* CKV = (bf16_t*)(ws + O_CKV); float* KR = (float*)(ws + O_KR);
    const float* gql = P.in[I_GQL]; const float* gkv = P.in[I_GKVL];
    for (int rowb = gw; rowb < MT; rowb += 2 * ngw) {
        u32x4 va[2], vb[2], qa[2]; u32x2 ka[2]; float kr[2];
#pragma unroll
        for (int q = 0; q < 2; ++q) {
            const int row = min(rowb + q * ngw, MT - 1);
            const u32x4* p = (const u32x4*)(ZA + (size_t)row * 2048 + 1024 + 16 * lane); va[q] = p[0]; vb[q] = p[1];
            const bf16_t* zs = ZS + (size_t)row * 768;
            qa[q] = (u32x4){0u, 0u, 0u, 0u}; if (lane < 48) qa[q] = *(const u32x4*)(zs + 8 * lane);
            ka[q] = *(const u32x2*)(zs + 384 + 4 * lane);
            kr[q] = lane < 32 ? bf2f(zs[640 + lane]) : 0.f;
        }
#pragma unroll
        for (int q = 0; q < 2; ++q) {
            const int row = rowb + q * ngw;
            if (row < MT) {
                bf16_t* zs = ZS + (size_t)row * 768;
                { const unsigned w[8] = {va[q].x, va[q].y, va[q].z, va[q].w, vb[q].x, vb[q].y, vb[q].z, vb[q].w}; float ss = 0.f;
#pragma unroll
                  for (int j = 0; j < 8; ++j) { const float lo = gelu_tanh(bflo(w[j])), hi = gelu_tanh(bfhi(w[j])); ss += lo * lo + hi * hi; }
                  ss = wave_sum(ss); if (lane == 0) RV[row] = rsqrtf(ss * (1.0f / 1024.0f) + EPSF); }
                { const u32x4 a = qa[q];
                  float qv[8] = {bflo(a.x), bfhi(a.x), bflo(a.y), bfhi(a.y), bflo(a.z), bfhi(a.z), bflo(a.w), bfhi(a.w)}; float ss = 0.f;
#pragma unroll
                  for (int j = 0; j < 8; ++j) ss += qv[j] * qv[j];
                  ss = wave_sum(ss); const float r = rsqrtf(ss * (1.0f / 384.0f) + EPSF);
                  if (lane < 48) { const f32x4 g0 = *(const f32x4*)(gql + 8 * lane), g1 = *(const f32x4*)(gql + 8 * lane + 4);
                    u32x4 w; w.x = pk2(qv[0] * r * g0.x, qv[1] * r * g0.y); w.y = pk2(qv[2] * r * g0.z, qv[3] * r * g0.w); w.z = pk2(qv[4] * r * g1.x, qv[5] * r * g1.y); w.w = pk2(qv[6] * r * g1.z, qv[7] * r * g1.w);
                    *(u32x4*)(zs + 8 * lane) = w; } }
                { const u32x2 a = ka[q]; float v[4] = {bflo(a.x), bfhi(a.x), bflo(a.y), bfhi(a.y)};
                  float ss = (v[0] * v[0] + v[1] * v[1]) + (v[2] * v[2] + v[3] * v[3]); ss = wave_sum(ss); const float r = rsqrtf(ss * (1.0f / 256.0f) + EPSF);
                  const f32x4 g4 = *(const f32x4*)(gkv + 4 * lane); f32x4 o = {v[0] * r * g4.x, v[1] * r * g4.y, v[2] * r * g4.z, v[3] * r * g4.w};
                  float* dst = row < MP ? P.out + OUT_CKVP + (size_t)row * 256 : P.out + OUT_CKVS + (size_t)(row - MP) * 256;
                  *(f32x4*)(dst + 4 * lane) = o; u32x2 w; w.x = pk2(o.x, o.y); w.y = pk2(o.z, o.w); *(u32x2*)(CKV + (size_t)row * 256 + 4 * lane) = w; }
                { const float val = kr[q]; const float partner = __shfl_xor(val, 16); float sn, cs; rope_sc(pos_of(row), lane & 15, sn, cs);
                  const float o = (lane < 16) ? val * cs - partner * sn : partner * sn + val * cs;
                  if (lane < 32) { KR[(size_t)row * 32 + lane] = o; float* dst = row < MP ? P.out + OUT_KRP + (size_t)row * 32 : P.out + OUT_KRS + (size_t)(row - MP) * 32; dst[lane] = o; }
                  const float oss = wave_sum(lane < 32 ? o * o : 0.f); if (lane == 0) ((float*)(ws + O_KRSS))[row] = oss; }
            }
        }
    }
}

__device__ __forceinline__ void gmlp_phase(const Params& P, LAS unsigned char* lds) {
    int tid_ = threadIdx.x; asm volatile("" : "+v"(tid_));
    const int tid = tid_, lane = tid & 63, wid = __builtin_amdgcn_readfirstlane(tid >> 6), l32 = lane & 31, hh = lane >> 5;
    unsigned char* ws = P.ws;
    const bf16_t* ZA = (const bf16_t*)(ws + O_ZA); const float* RV = (const float*)(ws + O_RV); const bf16_t* WS = (const bf16_t*)(ws + O_WS);
    bf16_t* OA = (bf16_t*)(ws + O_OA);
    const float* ggv = P.in[I_GGV]; const float* gb = P.in[I_GB];
    LAS bf16_t* vt = (LAS bf16_t*)lds;
    LAS float* mx = (LAS float*)(lds + 34816);
    const int sr = tid >> 4, cp = tid & 15;
    for (int item = blockIdx.x; item < 520 * 8; item += gridDim.x) {
        const int ci = item >> 3, g = item & 7; const bool sample = ci >= 512;
        const int row0 = sample ? MP + (ci - 512) * 64 : ci * 128, L = sample ? 64 : 128;
        u32x4 gvr[4], ur[4]; float rvr[4];
#pragma unroll
        for (int p = 0; p < 4; ++p) {
            const int s = p * 32 + sr; const int row = row0 + (s < L ? s : 0);
            gvr[p] = *(const u32x4*)(ZA + (size_t)row * 2048 + 1024 + g * 128 + 8 * cp);
            ur[p] = *(const u32x4*)(ZA + (size_t)row * 2048 + g * 128 + 8 * cp);
            rvr[p] = RV[row];
        }
        const f32x4 g0 = *(const f32x4*)(ggv + g * 128 + 8 * cp), g1 = *(const f32x4*)(ggv + g * 128 + 8 * cp + 4);
        __syncthreads();
#pragma unroll
        for (int p = 0; p < 4; ++p) {
            const int s = p * 32 + sr;
            if (s < L) {
                const int row = row0 + s; const u32x4 a = gvr[p]; const float rv = rvr[p];
                float v[8] = {gelu_tanh(bflo(a.x)) * rv * g0.x, gelu_tanh(bfhi(a.x)) * rv * g0.y, gelu_tanh(bflo(a.y)) * rv * g0.z, gelu_tanh(bfhi(a.y)) * rv * g0.w, gelu_tanh(bflo(a.z)) * rv * g1.x, gelu_tanh(bfhi(a.z)) * rv * g1.y, gelu_tanh(bflo(a.w)) * rv * g1.z, gelu_tanh(bfhi(a.w)) * rv * g1.w};
                if (sample) { float* dst = P.out + OUT_GV + (size_t)(row - MP) * 1024 + g * 128 + 8 * cp; *(f32x4*)dst = (f32x4){v[0], v[1], v[2], v[3]}; *(f32x4*)(dst + 4) = (f32x4){v[4], v[5], v[6], v[7]}; }
#pragma unroll
                for (int j = 0; j < 8; ++j) vt[(8 * cp + j) * 136 + s] = f2bf(v[j]);
            }
        }
        __syncthreads();
        const int tb = wid & 3, ch = wid >> 2;
        if (32 * tb < L) {
            f32x16 acc0, acc1;
#pragma unroll
            for (int i = 0; i < 16; ++i) { acc0[i] = 0.f; acc1[i] = 0.f; }
            const bf16_t* wp = WS + ((size_t)g * 128 + 32 * tb + l32) * 128 + 8 * hh;
            const LAS bf16_t* b0p = vt + (64 * ch + l32) * 136 + 8 * hh; const LAS bf16_t* b1p = b0p + 32 * 136;
            const int nks = 2 * (tb + 1);
            for (int ks = 0; ks < nks; ++ks) {
                const bf16x8 a = *(const bf16x8*)(wp + 16 * ks);
                const bf16x8 b0 = *(const LAS bf16x8*)(b0p + 16 * ks), b1 = *(const LAS bf16x8*)(b1p + 16 * ks);
                acc0 = __builtin_amdgcn_mfma_f32_32x32x16_bf16(a, b0, acc0, 0, 0, 0);
                acc1 = __builtin_amdgcn_mfma_f32_32x32x16_bf16(a, b1, acc1, 0, 0, 0);
            }
#pragma unroll
            for (int i = 0; i < 16; ++i) {
                const int t = 32 * tb + (i & 3) + 8 * (i >> 2) + 4 * hh;
                mx[t * 132 + 64 * ch + l32] = acc0[i]; mx[t * 132 + 64 * ch + 32 + l32] = acc1[i];
            }
        }
        __syncthreads();
#pragma unroll
        for (int p = 0; p < 4; ++p) {
            const int t = p * 32 + sr;
            if (t < L) {
                const int row = row0 + t; const float bias = gb[g * 128 + t];
                const f32x4 m0 = *(const LAS f32x4*)(mx + t * 132 + 8 * cp), m1 = *(const LAS f32x4*)(mx + t * 132 + 8 * cp + 4);
                const u32x4 a = ur[p];
                u32x4 w;
                w.x = pk2(gelu_tanh(bflo(a.x)) * (m0.x + bias), gelu_tanh(bfhi(a.x)) * (m0.y + bias)); w.y = pk2(gelu_tanh(bflo(a.y)) * (m0.z + bias), gelu_tanh(bfhi(a.y)) * (m0.w + bias));
                w.z = pk2(gelu_tanh(bflo(a.z)) * (m1.x + bias), gelu_tanh(bfhi(a.z)) * (m1.y + bias)); w.w = pk2(gelu_tanh(bflo(a.w)) * (m1.z + bias), gelu_tanh(bfhi(a.w)) * (m1.w + bias));
                *(u32x4*)(OA + (size_t)row * 1024 + g * 128 + 8 * cp) = w;
            }
        }
    }
}

__device__ __forceinline__ void qkfinal_phase(const Params& P) {
    int tid_ = threadIdx.x; asm volatile("" : "+v"(tid_));
    const int tid = tid_, lane = tid & 63, wid = tid >> 6;
    const int gw = blockIdx.x * 8 + wid, ngw = gridDim.x * 8;
    unsigned char* ws = P.ws;
    bf16_t* QR = (bf16_t*)(ws + O_QR); bf16_t* KF = (bf16_t*)(ws + O_KF); const float* KR = (const float*)(ws + O_KR);
    const float* gqn = P.in[I_GQN]; const float* gkn = P.in[I_GKN];
    const int h = lane >> 3, sub = lane & 7;
    constexpr float QSCALE = 0.10206207261596575f * 1.4426950408889634f;
    for (int itemb = gw; itemb < MT + MKV; itemb += 4 * ngw) {
        u32x4 na[4]; u32x2 qb[4]; f32x4 kb[4];
#pragma unroll
        for (int q = 0; q < 4; ++q) {
            const int item = min(itemb + q * ngw, MT + MKV - 1);
            const bool isq = item < MT; const int row = isq ? item : item - MT;
            const bf16_t* p = (isq ? QR : KF) + (size_t)row * 768 + h * 96;
            na[q] = *(const u32x4*)(p + 8 * sub);
            qb[q] = (u32x2){0u, 0u}; kb[q] = (f32x4){0.f, 0.f, 0.f, 0.f};
            if (isq) qb[q] = *(const u32x2*)(p + 64 + 4 * sub); else kb[q] = *(const f32x4*)(KR + (size_t)row * 32 + 4 * sub);
        }
#pragma unroll
        for (int q = 0; q < 4; ++q) {
            const int item = itemb + q * ngw;
            if (item < MT + MKV) {
                const bool isq = item < MT; const int row = isq ? item : item - MT;
                bf16_t* p = (isq ? QR : KF) + (size_t)row * 768 + h * 96;
                const u32x4 a = na[q];
                float nope[8] = {bflo(a.x), bfhi(a.x), bflo(a.y), bfhi(a.y), bflo(a.z), bfhi(a.z), bflo(a.w), bfhi(a.w)};
                float rp[4];
                if (isq) {
                    const u32x2 b = qb[q];
                    const float raw[4] = {bflo(b.x), bfhi(b.x), bflo(b.y), bfhi(b.y)};
                    const float pos = pos_of(row);
#pragma unroll
                    for (int j = 0; j < 4; ++j) { const float partner = __shfl_xor(raw[j], 4); float sn, cs; rope_sc(pos, (4 * sub + j) & 15, sn, cs);
                        rp[j] = (sub < 4) ? raw[j] * cs - partner * sn : partner * sn + raw[j] * cs; }
                } else { rp[0] = kb[q].x; rp[1] = kb[q].y; rp[2] = kb[q].z; rp[3] = kb[q].w; }
                float ss = 0.f;
#pragma unroll
                for (int j = 0; j < 8; ++j) ss += nope[j] * nope[j];
#pragma unroll
                for (int j = 0; j < 4; ++j) ss += rp[j] * rp[j];
                ss += __shfl_xor(ss, 1); ss += __shfl_xor(ss, 2); ss += __shfl_xor(ss, 4);
                const float r = rsqrtf(ss * (1.0f / 96.0f) + EPSF) * (isq ? QSCALE : 1.0f);
                const float* gn = isq ? gqn : gkn;
                const f32x4 g0 = *(const f32x4*)(gn + 8 * sub), g1 = *(const f32x4*)(gn + 8 * sub + 4), g2 = *(const f32x4*)(gn + 64 + 4 * sub);
                u32x4 w; w.x = pk2(nope[0] * r * g0.x, nope[1] * r * g0.y); w.y = pk2(nope[2] * r * g0.z, nope[3] * r * g0.w); w.z = pk2(nope[4] * r * g1.x, nope[5] * r * g1.y); w.w = pk2(nope[6] * r * g1.z, nope[7] * r * g1.w);
                u32x2 w2; w2.x = pk2(rp[0] * r * g2.x, rp[1] * r * g2.y); w2.y = pk2(rp[2] * r * g2.z, rp[3] * r * g2.w);
                *(u32x4*)(p + 8 * sub) = w; *(u32x2*)(p + 64 + 4 * sub) = w2;
            }
        }
    }
}

constexpr int N_ATT_ITEMS = 64 + 2048;
__device__ __forceinline__ void attn_phase(const Params& P, LAS unsigned char* lds, int cidx) {
    int tid_ = threadIdx.x; asm volatile("" : "+v"(tid_));
    const int tid = tid_, lane = tid & 63, wid = __builtin_amdgcn_readfirstlane(tid >> 6), l32 = lane & 31, hh = lane >> 5;
    unsigned char* ws = P.ws;
    const bf16_t* QR = (const bf16_t*)(ws + O_QR); const bf16_t* KF = (const bf16_t*)(ws + O_KF); const bf16_t* VT = (const bf16_t*)(ws + O_VT);
    bf16_t* OB = (bf16_t*)(ws + O_OB);
    unsigned* counter = (unsigned*)(ws + O_CTL) + cidx;
    LAS unsigned* slot = (LAS unsigned*)(lds + 45056);
    const int k0key = tid / 12, k0part = tid % 12, k1key = (tid + 512) / 12, k1part = (tid + 512) % 12; const bool has1 = tid < 256;
    const int vdv = tid >> 3, vpart = tid & 7;
    for (;;) {
        __syncthreads();
        if (tid == 0) *slot = atomicAdd(counter, 1u);
        __syncthreads();
        const int item = (int)*slot;
        if (item >= N_ATT_ITEMS) break;
        const bool sample = item < 64;
        int b, h, nt, qrow0, wlim;
        if (sample) { b = item >> 3; h = item & 7; nt = 65; qrow0 = MP + b * 64; wlim = 64; }
        else { const int j = item - 64, qb = 7 - (j >> 8), bh = j & 255; b = bh >> 3; h = bh & 7; nt = 4 * qb + 4; qrow0 = b * 2048 + qb * 256; wlim = 4 * qb + (wid >> 1); }
        const bool wvalid = sample ? (wid < 2) : true;
        bf16x8 qf[6];
        if (wvalid) { const int qrow = qrow0 + 32 * wid + l32; const bf16_t* qp = QR + (size_t)qrow * 768 + h * 96 + 8 * hh;
            u32x4 qraw[6];
#pragma unroll
            for (int ks = 0; ks < 6; ++ks) qraw[ks] = *(const u32x4*)(qp + 16 * ks);
            float qv[6][8];
#pragma unroll
            for (int ks = 0; ks < 6; ++ks) { qv[ks][0] = bflo(qraw[ks].x); qv[ks][1] = bfhi(qraw[ks].x); qv[ks][2] = bflo(qraw[ks].y); qv[ks][3] = bfhi(qraw[ks].y);
                qv[ks][4] = bflo(qraw[ks].z); qv[ks][5] = bfhi(qraw[ks].z); qv[ks][6] = bflo(qraw[ks].w); qv[ks][7] = bfhi(qraw[ks].w); }
            const float pos = pos_of(qrow);
#pragma unroll
            for (int j = 0; j < 8; ++j) { float sn, cs; rope_sc(pos, 8 * hh + j, sn, cs); const float x1 = qv[4][j], x2 = qv[5][j]; qv[4][j] = x1 * cs - x2 * sn; qv[5][j] = x1 * sn + x2 * cs; }
            float ss = 0.f;
#pragma unroll
            for (int ks = 0; ks < 6; ++ks)
#pragma unroll
                for (int j = 0; j < 8; ++j) ss += qv[ks][j] * qv[ks][j];
            ss += __shfl_xor(ss, 32);
            const float rq = rsqrtf(ss * (1.0f / 96.0f) + EPSF) * (0.10206207261596575f * 1.4426950408889634f);
            const float* gqn = P.in[I_GQN];
#pragma unroll
            for (int ks = 0; ks < 6; ++ks) { const f32x4 g0 = *(const f32x4*)(gqn + 16 * ks + 8 * hh), g1 = *(const f32x4*)(gqn + 16 * ks + 8 * hh + 4);
                u32x4 w; w.x = pk2(qv[ks][0] * rq * g0.x, qv[ks][1] * rq * g0.y); w.y = pk2(qv[ks][2] * rq * g0.z, qv[ks][3] * rq * g0.w);
                w.z = pk2(qv[ks][4] * rq * g1.x, qv[ks][5] * rq * g1.y); w.w = pk2(qv[ks][6] * rq * g1.z, qv[ks][7] * rq * g1.w);
                qf[ks] = __builtin_bit_cast(bf16x8, w); } }
        else {
#pragma unroll
            for (int ks = 0; ks < 6; ++ks) qf[ks] = (bf16x8){0, 0, 0, 0, 0, 0, 0, 0}; }
        f32x16 O0, O1;
#pragma unroll
        for (int i = 0; i < 16; ++i) { O0[i] = 0.f; O1[i] = 0.f; }
        float mrun = -1e30f, lrun = 0.f;
        u32x4 kr0, kr1 = {0u, 0u, 0u, 0u}, vr;
#define ATT_TROW(kt) (sample ? ((kt) < 64 ? MT + b * 4096 + (kt) * 64 : MP + b * 64) : b * 2048 + (kt) * 64)
#define ATT_ISSUE(kt) do { const size_t krow = (size_t)ATT_TROW(kt); \
            kr0 = *(const u32x4*)(KF + (krow + k0key) * 768 + h * 96 + k0part * 8); \
            if (has1) kr1 = *(const u32x4*)(KF + (krow + k1key) * 768 + h * 96 + k1part * 8); \
            vr = *(const u32x4*)(VT + (size_t)(h * 64 + vdv) * MKV + krow + vpart * 8); } while (0)
#define ATT_COMMIT(bufi) do { *(LAS u32x4*)(lds + (bufi) * 13312 + k0key * 208 + k0part * 16) = kr0; \
            if (has1) *(LAS u32x4*)(lds + (bufi) * 13312 + k1key * 208 + k1part * 16) = kr1; \
            *(LAS u32x4*)(lds + 26624 + (bufi) * 9216 + vdv * 144 + vpart * 16) = vr; } while (0)
        ATT_ISSUE(0); ATT_COMMIT(0);
        __syncthreads();
        for (int kt = 0; kt < nt; ++kt) {
            const int buf = kt & 1;
            if (kt + 1 < nt) ATT_ISSUE(kt + 1);
            if (wvalid && kt <= wlim) {
                const LAS unsigned char* kb = lds + buf * 13312 + l32 * 208 + hh * 16;
                const LAS unsigned char* vb = lds + 26624 + buf * 9216 + l32 * 144 + hh * 8;
                f32x16 S0, S1;
#pragma unroll
                for (int i = 0; i < 16; ++i) { S0[i] = 0.f; S1[i] = 0.f; }
#pragma unroll
                for (int ks = 0; ks < 6; ++ks) {
                    const bf16x8 a0 = *(const LAS bf16x8*)(kb + ks * 32), a1 = *(const LAS bf16x8*)(kb + 32 * 208 + ks * 32);
                    S0 = __builtin_amdgcn_mfma_f32_32x32x16_bf16(a0, qf[ks], S0, 0, 0, 0);
                    S1 = __builtin_amdgcn_mfma_f32_32x32x16_bf16(a1, qf[ks], S1, 0, 0, 0);
                }
                float mx = S0[0];
#pragma unroll
                for (int i = 1; i < 16; ++i) mx = fmaxf(mx, S0[i]);
#pragma unroll
                for (int i = 0; i < 16; ++i) mx = fmaxf(mx, S1[i]);
                mx = fmaxf(mx, __shfl_xor(mx, 32));
                const float mnew = fmaxf(mrun, mx), alpha = fast_exp2(mrun - mnew); mrun = mnew;
                float ps = 0.f;
#pragma unroll
                for (int i = 0; i < 16; ++i) { S0[i] = fast_exp2(S0[i] - mnew); ps += S0[i]; }
#pragma unroll
                for (int i = 0; i < 16; ++i) { S1[i] = fast_exp2(S1[i] - mnew); ps += S1[i]; }
                lrun = lrun * alpha + ps;
#pragma unroll
                for (int i = 0; i < 16; ++i) { O0[i] *= alpha; O1[i] *= alpha; }
#pragma unroll
                for (int kk = 0; kk < 4; ++kk) {
                    u32x4 pw;
                    if (kk == 0) { pw.x = pk2(S0[0], S0[1]); pw.y = pk2(S0[2], S0[3]); pw.z = pk2(S0[4], S0[5]); pw.w = pk2(S0[6], S0[7]); }
                    else if (kk == 1) { pw.x = pk2(S0[8], S0[9]); pw.y = pk2(S0[10], S0[11]); pw.z = pk2(S0[12], S0[13]); pw.w = pk2(S0[14], S0[15]); }
                    else if (kk == 2) { pw.x = pk2(S1[0], S1[1]); pw.y = pk2(S1[2], S1[3]); pw.z = pk2(S1[4], S1[5]); pw.w = pk2(S1[6], S1[7]); }
                    else { pw.x = pk2(S1[8], S1[9]); pw.y = pk2(S1[10], S1[11]); pw.z = pk2(S1[12], S1[13]); pw.w = pk2(S1[14], S1[15]); }
                    const bf16x8 pb = __builtin_bit_cast(bf16x8, pw);
                    const u32x2 lo0 = *(const LAS u32x2*)(vb + kk * 32), hi0 = *(const LAS u32x2*)(vb + kk * 32 + 16);
                    const u32x2 lo1 = *(const LAS u32x2*)(vb + 32 * 144 + kk * 32), hi1 = *(const LAS u32x2*)(vb + 32 * 144 + kk * 32 + 16);
                    const u32x4 va0 = {lo0.x, lo0.y, hi0.x, hi0.y}, va1 = {lo1.x, lo1.y, hi1.x, hi1.y};
                    O0 = __builtin_amdgcn_mfma_f32_32x32x16_bf16(__builtin_bit_cast(bf16x8, va0), pb, O0, 0, 0, 0);
                    O1 = __builtin_amdgcn_mfma_f32_32x32x16_bf16(__builtin_bit_cast(bf16x8, va1), pb, O1, 0, 0, 0);
                }
            }
            if (kt + 1 < nt) ATT_COMMIT(buf ^ 1);
            __syncthreads();
        }
#undef ATT_TROW
#undef ATT_ISSUE
#undef ATT_COMMIT
        if (wvalid) {
            const float ltot = lrun + __shfl_xor(lrun, 32); const float inv = 1.0f / ltot;
            bf16_t* op = OB + (size_t)(qrow0 + 32 * wid + l32) * 512 + h * 64 + 4 * hh;
#pragma unroll
            for (int g4 = 0; g4 < 4; ++g4) {
                u32x2 w0; w0.x = pk2(O0[4 * g4] * inv, O0[4 * g4 + 1] * inv); w0.y = pk2(O0[4 * g4 + 2] * inv, O0[4 * g4 + 3] * inv);
                u32x2 w1; w1.x = pk2(O1[4 * g4] * inv, O1[4 * g4 + 1] * inv); w1.y = pk2(O1[4 * g4 + 2] * inv, O1[4 * g4 + 3] * inv);
                *(u32x2*)(op + 8 * g4) = w0; *(u32x2*)(op + 32 + 8 * g4) = w1;
            }
        }
    }
}

#define XB_TMO      128
#define XB_XCNT(j)  (256  + 64 * (j))
#define XB_XSUB(j)  (1280 + 64 * (j))
#define XB_XGEN(j)  (2304 + 64 * (j))
#define XB_TOP      3328
#define XB_TOPGEN   3392
#define XCD_BAR_WORDS 3456
#define XB_SPIN_CAP (1u << 18)

__device__ __forceinline__ unsigned xb_ld(unsigned* p)              { return __hip_atomic_load(p, __ATOMIC_RELAXED, __HIP_MEMORY_SCOPE_AGENT); }
__device__ __forceinline__ unsigned xb_add(unsigned* p, unsigned v) { return __hip_atomic_fetch_add(p, v, __ATOMIC_RELAXED, __HIP_MEMORY_SCOPE_AGENT); }
__device__ __forceinline__ unsigned xb_xcc_id() { return (unsigned)__builtin_amdgcn_s_getreg((3 << 11) | 20) & 0xFu; }
#define XB_SPIN(cond, bar) do { unsigned _sp = 0; while (cond) { __builtin_amdgcn_s_sleep(1); \
    if ((++_sp & 255u) == 0u) { if (xb_ld(&(bar)[XB_TMO])) break; if (_sp > XB_SPIN_CAP) { atomicAdd(&(bar)[XB_TMO], 1u); break; } } } } while (0)

struct XcdBarrier {
    unsigned* bar; unsigned x;
    volatile LAS unsigned* st;
};

__device__ __forceinline__ XcdBarrier xcd_barrier_post(unsigned* bar, volatile LAS unsigned* st) {
    XcdBarrier b; b.bar = bar; b.x = xb_xcc_id(); b.st = st;
    if (threadIdx.x == 0) (void)xb_add(&bar[XB_XCNT(b.x)], 1u);
    return b;
}
__device__ __forceinline__ void xcd_barrier_complete(unsigned* bar, unsigned x, unsigned& nloc, unsigned& nx) {
    const unsigned G = gridDim.x * gridDim.y * gridDim.z;
    unsigned sum, cnt, mine, sp = 0u;
    for (;;) {
        sum = 0u; cnt = 0u; mine = 0u;
#pragma unroll
        for (unsigned j = 0; j < 16; ++j) { const unsigned c = xb_ld(&bar[XB_XCNT(j)]); sum += c; cnt += (c > 0u) ? 1u : 0u; mine = (j == x) ? c : mine; }
        if (sum == G) break;
        __builtin_amdgcn_s_sleep(1);
        if ((++sp & 255u) == 0u) { if (xb_ld(&bar[XB_TMO])) break; if (sp > XB_SPIN_CAP) { atomicAdd(&bar[XB_TMO], 1u); break; } }
    }
    nloc = mine > 0u ? mine : 1u; nx = cnt > 0u ? cnt : 1u;
}

__device__ __forceinline__ void xcd_barrier(const XcdBarrier& b) {
    asm volatile("s_waitcnt vmcnt(0)" ::: "memory");
    __syncthreads();
    if (threadIdx.x == 0) {
        unsigned* bar = b.bar;
        __builtin_amdgcn_s_waitcnt(0);
        unsigned nloc = b.st[0], nx = b.st[1];
        if (nloc == 0u) { xcd_barrier_complete(bar, b.x, nloc, nx); b.st[0] = nloc; b.st[1] = nx; }
        const unsigned old = xb_add(&bar[XB_XSUB(b.x)], 1u);
        const unsigned gen = old / nloc;
        if (old + 1u == (gen + 1u) * nloc) {
            __builtin_amdgcn_fence(__ATOMIC_RELEASE, "agent");
            asm volatile("s_waitcnt vmcnt(0)" ::: "memory");
            const unsigned og = xb_add(&bar[XB_TOP], 1u);
            const unsigned tg = og / nx;
            if (og + 1u == (tg + 1u) * nx) xb_add(&bar[XB_TOPGEN], 1u);
            else XB_SPIN(xb_ld(&bar[XB_TOPGEN]) == tg, bar);
            __builtin_amdgcn_fence(__ATOMIC_ACQUIRE, "agent");
            xb_add(&bar[XB_XGEN(b.x)], 1u);
            asm volatile("s_waitcnt vmcnt(0)" ::: "memory");
        } else {
            XB_SPIN(xb_ld(&bar[XB_XGEN(b.x)]) == gen, bar);
            __builtin_amdgcn_fence(__ATOMIC_ACQUIRE, "agent");
            asm volatile("s_waitcnt vmcnt(0)" ::: "memory");
        }
    }
    __syncthreads();
}


__global__ void __launch_bounds__(512, 2) mk_forward(Params P) {
    extern __shared__ __attribute__((aligned(16))) unsigned char lds_raw[];
    LAS unsigned char* lds = (LAS unsigned char*)lds_raw;
    cg::grid_group grid = cg::this_grid();
    volatile LAS unsigned* xb_st = (volatile LAS unsigned*)(lds + 131072);
    if (threadIdx.x < 4) xb_st[threadIdx.x] = 0u;
    __syncthreads();
    const XcdBarrier xb = xcd_barrier_post((unsigned*)(P.ws + O_BAR), xb_st);
    unsigned char* ws = P.ws;
    float* MODv = (float*)(ws + O_MOD);
    float* Y = P.out + OUT_Y;
    constexpr int NPROG = NSTEPS + (PROBE_DUP >= 0 ? 1 : 0);
    for (int si = P.ph_lo; si < NPROG; ++si) {
        const int step = (PROBE_DUP >= 0 && si > PROBE_DUP) ? si - 1 : si;
        const bool rerun = (PROBE_DUP >= 0 && si == PROBE_DUP + 1);
        bool is_gemm = false, sync_after = true;
        pg8::Gemm g; g.A = nullptr; g.Bt = nullptr; g.M = 0; g.N = 0; g.K = 0; g.lda = 0;
        Epi E; E.mode = EM_PLAIN; E.sub = 0; E.gidx = 0; E.row_off = 0; E.coef = 1.0f; E.ws = ws; E.Y = Y; E.xp = P.in[I_XP]; E.xs = P.in[I_XS]; E.bgate = P.in[I_BGATE];
        switch (step) {
        case 0: prep_phase(P, lds); break;
        case 1: modulate_phase(P.in[I_XP], P.in[I_XS], P.in[I_GFFN1], MODv, 0, 1, (bf16_t*)(ws + O_H)); break;
        case 2: is_gemm = true; g.A = (const bf16_t*)(ws + O_H); g.lda = 1024; g.Bt = (const bf16_t*)(ws + O_W1U); g.M = MT; g.N = 2 * DFF; g.K = 1024; E.mode = EM_SWIGLU; break;
        case 3: is_gemm = true; g.A = (const bf16_t*)(ws + O_ACT); g.lda = DFF; g.Bt = (const bf16_t*)(ws + O_W1D); g.M = MP; g.N = 1024; g.K = DFF; E.mode = EM_RESID; E.gidx = 2; E.coef = 0.5f; break;
        case 4:
            if (blockIdx.x < 8) { is_gemm = true; g.A = (const bf16_t*)(ws + O_ACT) + (size_t)MP * DFF; g.lda = DFF; g.Bt = (const bf16_t*)(ws + O_W1D); g.M = MS; g.N = 1024; g.K = DFF; E.mode = EM_RESID; E.gidx = 2; E.coef = 0.5f; E.row_off = MP; }
            else modulate16_phase((const bf16_t*)Y, P.in[I_GMIX], MODv, 3, 4, (bf16_t*)(ws + O_H), 0, MP, 8);
            break;
        case 5: modulate16_phase((const bf16_t*)Y, P.in[I_GMIX], MODv, 3, 4, (bf16_t*)(ws + O_H), MP, MT, 0); xcd_barrier(xb);
            is_gemm = true; g.A = (const bf16_t*)(ws + O_H); g.lda = 1024; g.Bt = (const bf16_t*)(ws + O_WIN); g.M = MT; g.N = NINP; g.K = 1024; E.mode = EM_WIN; break;
        case 6: rowpost_phase(P); break;
        case 7: gmlp_phase(P, lds); break;
        case 8: is_gemm = true; sync_after = false; g.A = (const bf16_t*)(ws + O_ZS); g.lda = 768; g.Bt = (const bf16_t*)(ws + O_WUQ); g.M = MT; g.N = 768; g.K = 384; E.mode = EM_PLAIN; E.sub = 0; break;
        case 9: is_gemm = true; sync_after = false; g.A = (const bf16_t*)(ws + O_CKV); g.lda = 256; g.Bt = (const bf16_t*)(ws + O_WUK); g.M = MKV; g.N = 512; g.K = 256; E.mode = EM_KNOPE; E.bgate = P.in[I_GKN]; break;
        case 10: is_gemm = true; g.A = (const bf16_t*)(ws + O_WUV); g.lda = 256; g.Bt = (const bf16_t*)(ws + O_CKV); g.M = 512; g.N = MKV; g.K = 256; E.mode = EM_PLAIN; E.sub = 1; break;
        case 11: sync_after = false; break;
        case 12: if (blockIdx.x < 8 && !rerun) { is_gemm = true; g.A = (const bf16_t*)(ws + O_OA) + (size_t)MP * 1024; g.lda = 1024; g.Bt = (const bf16_t*)(ws + O_WBA); g.M = MS; g.N = 1024; g.K = 1024; E.mode = EM_BRA; E.row_off = MP; } break;
        case 13: is_gemm = true; g.A = (const bf16_t*)(ws + O_OA); g.lda = 1024; g.Bt = (const bf16_t*)(ws + O_WBA); g.M = MP; g.N = 1024; g.K = 1024; E.mode = EM_BRA; break;
        case 14: is_gemm = true; g.A = (const bf16_t*)(ws + O_OB); g.lda = 512; g.Bt = (const bf16_t*)(ws + O_WBB); g.M = MT; g.N = 1024; g.K = 512; E.mode = EM_BRB; break;
        case 15: is_gemm = true; g.A = (const bf16_t*)(ws + O_MG); g.lda = 1024; g.Bt = (const bf16_t*)(ws + O_WO); g.M = MP; g.N = 1024; g.K = 1024; E.mode = EM_RESID_B2B; E.gidx = 5; E.coef = 1.0f; break;
        case 16:
            if (blockIdx.x < 8) { is_gemm = true; g.A = (const bf16_t*)(ws + O_MG) + (size_t)MP * 1024; g.lda = 1024; g.Bt = (const bf16_t*)(ws + O_WO); g.M = MS; g.N = 1024; g.K = 1024; E.mode = EM_RESID_B2B; E.gidx = 5; E.coef = 1.0f; E.row_off = MP; }
            else modulate16_phase((const bf16_t*)(ws + O_X2), P.in[I_GFFN2], MODv, 6, 7, (bf16_t*)(ws + O_H), 0, MP, 8);
            break;
        case 17: modulate16_phase((const bf16_t*)(ws + O_X2), P.in[I_GFFN2], MODv, 6, 7, (bf16_t*)(ws + O_H), MP, MT, 0); xcd_barrier(xb);
            is_gemm = true; g.A = (const bf16_t*)(ws + O_H); g.lda = 1024; g.Bt = (const bf16_t*)(ws + O_W2U); g.M = MT; g.N = 2 * DFF; g.K = 1024; E.mode = EM_SWIGLU; break;
        case 18: is_gemm = true; g.A = (const bf16_t*)(ws + O_ACT); g.lda = DFF; g.Bt = (const bf16_t*)(ws + O_W2D); g.M = MT; g.N = 1024; g.K = DFF; E.mode = EM_RESID_B2F; E.gidx = 8; E.coef = 0.5f; break;
        default: break;
        }
        if (is_gemm) {
            pg8::StaticOrder S; S.init(g.M, g.N, (int)gridDim.x, (int)blockIdx.x);
#if STAGGER_MODE
            {
                const unsigned lvl = STAGGER_MODE == 1 ? ((blockIdx.x >> 3) & 31u) : (blockIdx.x & 7u) * 4u;
                const unsigned long long ticks = (unsigned long long)lvl * (unsigned)(g.K / 64) * 120ull / 32ull;
                const unsigned long long t0 = wall_clock64();
                while (wall_clock64() - t0 < ticks) __builtin_amdgcn_s_sleep(8);
            }
#endif
            pg8::gemm_phase<Epi, pg8::StaticOrder, GEMM_ALIGN_EPI, GEMM_SP2>(lds, g, S, E);
        }
        if (step == 12) attn_phase(P, lds, rerun ? 1 : 0);
        if ((sync_after || (PROBE_DUP >= 0 && si == PROBE_DUP)) && si + 1 < NPROG) { if (si == 0) grid.sync(); else xcd_barrier(xb); }
    }
}

extern "C" void kernel_launch(void* const* d_in, const int* in_sizes, int n_in, void* d_out, int out_size, void* d_ws, size_t ws_size, hipStream_t stream) {
    static int grid = 0;
    if (grid == 0) {
        if (n_in != 30 || ws_size < WS_END) { fprintf(stderr, "kernel_launch: unexpected n_in %d or ws_size %zu (< %zu)\n", n_in, ws_size, (size_t)WS_END); grid = -1; return; }
        int dev = 0, cus = 0, per_cu = 0;
        hipGetDevice(&dev);
        hipDeviceGetAttribute(&cus, hipDeviceAttributeMultiprocessorCount, dev);
        if (hipFuncSetAttribute((const void*)mk_forward, hipFuncAttributeMaxDynamicSharedMemorySize, LDS_BYTES) != hipSuccess) fprintf(stderr, "kernel_launch: hipFuncSetAttribute failed\n");
        if (hipOccupancyMaxActiveBlocksPerMultiprocessor(&per_cu, (const void*)mk_forward, 512, LDS_BYTES) != hipSuccess || per_cu < 1) fprintf(stderr, "kernel_launch: occupancy query says %d blocks per CU\n", per_cu);
        (void)hipGetLastError();
        grid = cus > 0 ? cus : 256;
    }
    if (grid < 0) return;
    if (hipMemsetAsync((unsigned char*)d_ws + O_BAR, 0, XCD_BAR_WORDS * sizeof(unsigned), stream) != hipSuccess) { fprintf(stderr, "kernel_launch: memset of the barrier words failed\n"); return; }
    Params p{};
    for (int i = 0; i < 30; ++i) p.in[i] = (const float*)d_in[i];
    p.out = (float*)d_out; p.ws = (unsigned char*)d_ws; p.ph_lo = 0; p.ph_hi = NSTEPS;
    void* args[] = {&p};
    hipError_t e = hipLaunchCooperativeKernel((const void*)mk_forward, dim3(grid), dim3(512), args, LDS_BYTES, stream);
    if (e != hipSuccess) fprintf(stderr, "kernel_launch: cooperative launch failed: %s (grid %d)\n", hipGetErrorString(e), grid);
}
```

```cpp
#include <hip/hip_runtime.h>
#include <hip/hip_cooperative_groups.h>
#include <cstdio>
#include <cstdint>
namespace cg = cooperative_groups;

namespace pg8 {
#define PG8_LAS __attribute__((address_space(3)))
typedef unsigned short bf16_t;
typedef short bf16x8 __attribute__((ext_vector_type(8)));
typedef float f32x4 __attribute__((ext_vector_type(4)));
typedef unsigned u32x4 __attribute__((ext_vector_type(4)));
constexpr int BM = 256, BK = 64, HALF = 128, HTB = HALF * BK * 2  , STAGE_BYTES = 8 * HTB, NXCD = 8, WGM = 8;

__host__ __device__ __forceinline__ int lds_byte(int r, int c) { const int st = (r >> 4) * 2 + (c >> 5), rr = r & 15, cc = c & 31, ob = rr * 64 + cc * 2; return st * 1024 + (ob ^ (((ob >> 9) & 1) << 5)); }
__host__ __device__ __forceinline__ void stage_rc(int b, int& R, int& C) { const int st = b / 1024, sb = b % 1024, swz = sb ^ (((sb >> 9) & 1) << 5); R = (st >> 1) * 16 + swz / 64; C = (st & 1) * 32 + (swz % 64) / 2; }
__host__ __device__ __forceinline__ int perm32(int rho) { const int n = rho >> 4, i = rho & 15; return 8 * (i >> 2) + 4 * n + (i & 3); }

struct Unit { int pm, pn; };
struct Gemm { const bf16_t* A; const bf16_t* Bt; int M, N, K, lda, ldb; };

struct StaticOrder {
    int nM, nN, nwg, G, c;
    __host__ __device__ void init(int M, int N, int G_, int c_) { nM = M / BM; nN = N / BM; nwg = nM * nN; G = G_; c = c_; }
    __host__ __device__ bool next(int i, Unit& u) const {
        const long L = (long)i * G + c; if (L >= nwg) return false;
        int wgid = (int)L; { const int q = nwg / NXCD, r = nwg % NXCD, xcd = wgid % NXCD, off = wgid / NXCD; wgid = (xcd < r ? xcd * (q + 1) : r * (q + 1) + (xcd - r) * q) + off; }
        const int nig = WGM * nN, gid = wgid / nig, fm = gid * WGM, gsz = (nM - fm) < WGM ? (nM - fm) : WGM;
        u.pm = fm + ((wgid % nig) % gsz); u.pn = (wgid % nig) / gsz; return true;
    }
    __device__ __forceinline__ void a_ready(const Unit&) const {}
    __device__ __forceinline__ void done(const Unit&) const {}
};
__device__ __forceinline__ unsigned cvt_pk_bf16(float lo, float hi) { unsigned r; asm volatile("v_cvt_pk_bf16_f32 %0, %1, %2" : "=v"(r) : "v"(lo), "v"(hi)); return r; }

template <class Epi, class Sched, bool ALIGN_EPI = false, bool SP2 = false>
__device__ __forceinline__ void gemm_phase(PG8_LAS unsigned char* lds, const Gemm g, const Sched& S, const Epi& E, const int wv_) {
    int tid_; asm volatile("v_mbcnt_lo_u32_b32 %0, -1, 0\n\tv_mbcnt_hi_u32_b32 %0, -1, %0" : "=v"(tid_)); tid_ += 64 * wv_;
    const int tid = tid_, wid = __builtin_amdgcn_readfirstlane(tid >> 6), lane = tid & 63, wr = wid >> 2, wc = wid & 3, fr = lane & 15, fq = lane >> 4;
    const int K = g.K, nt = K / BK;
    unsigned voffA[2], voffB[2];
#pragma unroll
    for (int i = 0; i < 2; ++i) { int R, C; stage_rc(tid * 16 + i * 8192, R, C); const int Rb = Epi::PERM ? ((R & ~31) + perm32(R & 31)) : R;
        voffA[i] = (unsigned)(R * g.lda + C) * 2u; voffB[i] = (unsigned)(Rb * g.ldb + C) * 2u; }
    const size_t kstep = (size_t)(BK * 2);
    const size_t hstep = (size_t)HALF * g.ldb * 2, hstepA = (size_t)HALF * g.lda * 2;
    const size_t tstep = 2 * hstep, tstepA = 2 * hstepA;
    const unsigned ldsw = (unsigned)wid * 1024u;
    const int aoff = lds_byte(wr * 64 + fr, fq * 8), boff = lds_byte(wc * 32 + fr, fq * 8);
#define PG8_SA(b, h) (((b) * 2 + (h)) * HTB)
#define PG8_SB(b, h) ((4 + (b) * 2 + (h)) * HTB)
#define PG8_STAGE(bufoff, gbase, voff) do { _Pragma("unroll") for (int _i = 0; _i < 2; ++_i) \
        __builtin_amdgcn_global_load_lds((const unsigned*)((const char*)(gbase) + (voff)[_i]), (PG8_LAS unsigned*)(lds + (bufoff) + ldsw + _i * 8192), 16, 0, 0); } while (0)
#define PG8_LDA(dst, b, h) do { _Pragma("unroll") for (int m = 0; m < 4; ++m) _Pragma("unroll") for (int k = 0; k < 2; ++k) dst[m][k] = *(const PG8_LAS bf16x8*)(lds + PG8_SA(b, h) + aoff + m * 2048 + k * 1024); } while (0)
#define PG8_LDB(dst, b, h) do { _Pragma("unroll") for (int n = 0; n < 2; ++n) _Pragma("unroll") for (int k = 0; k < 2; ++k) dst[n][k] = *(const PG8_LAS bf16x8*)(lds + PG8_SB(b, h) + boff + n * 2048 + k * 1024); } while (0)
#define PG8_MMA(ai, bj, At, Bt) do { __builtin_amdgcn_s_setprio(1); _Pragma("unroll") for (int m = 0; m < 4; ++m) _Pragma("unroll") for (int n = 0; n < 2; ++n) _Pragma("unroll") for (int k = 0; k < 2; ++k) \
        acc[ai][bj][m][n] = __builtin_amdgcn_mfma_f32_16x16x32_bf16(Bt[n][k], At[m][k], acc[ai][bj][m][n], 0, 0, 0); __builtin_amdgcn_s_setprio(0); } while (0)
#define PG8_WAIT_V(n) asm volatile("s_waitcnt vmcnt(" #n ")" ::: "memory")
#define PG8_WAIT_L(n) asm volatile("s_waitcnt lgkmcnt(" #n ")" ::: "memory")
#define PG8_BAR __builtin_amdgcn_s_barrier()
#define PG8_SCHED __builtin_amdgcn_sched_barrier(0)
    Unit cur, nxt; int ui = 0;
    if (!S.next(0, cur)) return;
    f32x4 acc[2][2][4][2];
#pragma unroll
    for (int a = 0; a < 2; ++a)
#pragma unroll
        for (int b = 0; b < 2; ++b)
#pragma unroll
            for (int m = 0; m < 4; ++m)
#pragma unroll
                for (int n = 0; n < 2; ++n) acc[a][b][m][n] = (f32x4){0.f, 0.f, 0.f, 0.f};
    bf16x8 At[4][2], B0[2][2], B1[2][2];
    const char* cA = (const char*)g.A + (size_t)cur.pm * tstepA; const char* cB = (const char*)g.Bt + (size_t)cur.pn * tstep;
    S.a_ready(cur);
    if constexpr (SP2) {
        PG8_STAGE(PG8_SB(0, 0), cB, voffB); PG8_STAGE(PG8_SB(0, 1), cB + hstep, voffB); PG8_STAGE(PG8_SA(0, 0), cA, voffA); PG8_STAGE(PG8_SA(0, 1), cA + hstepA, voffA);
        if (wr == 1) PG8_BAR;
        PG8_WAIT_V(2); PG8_BAR;
        PG8_STAGE(PG8_SB(1, 0), cB + kstep, voffB); PG8_STAGE(PG8_SA(1, 0), cA + kstep, voffA); PG8_STAGE(PG8_SB(1, 1), cB + hstep + kstep, voffB);
        PG8_WAIT_V(6); PG8_BAR;
    } else {
        PG8_STAGE(PG8_SB(0, 0), cB, voffB); PG8_STAGE(PG8_SA(0, 0), cA, voffA); PG8_STAGE(PG8_SB(0, 1), cB + hstep, voffB); PG8_STAGE(PG8_SA(0, 1), cA + hstepA, voffA);
        if (wr == 1) PG8_BAR;
        PG8_WAIT_V(4); PG8_BAR;
        PG8_STAGE(PG8_SB(1, 0), cB + kstep, voffB); PG8_STAGE(PG8_SA(1, 0), cA + kstep, voffA); PG8_STAGE(PG8_SB(1, 1), cB + hstep + kstep, voffB);
        PG8_WAIT_V(6); PG8_BAR;
    }
    for (;;) {
        const bool has_next = S.next(ui + 1, nxt);
        const char* nA = has_next ? (const char*)g.A + (size_t)nxt.pm * tstepA : cA; const char* nB = has_next ? (const char*)g.Bt + (size_t)nxt.pn * tstep : cB;
        for (int t = 0; t < nt; t += 2) {
            const bool last = (t == nt - 2);
            const char* a1 = cA + (size_t)(t + 1) * kstep;
            const char* a2 = last ? nA : cA + (size_t)(t + 2) * kstep; const char* b2 = last ? nB : cB + (size_t)(t + 2) * kstep;
            const char* a3 = a2 + kstep; const char* b3 = b2 + kstep;
            if (last && has_next) S.a_ready(nxt);
            if constexpr (SP2) {
            PG8_LDB(B0, 0, 0); PG8_LDB(B1, 0, 1); PG8_SCHED; PG8_LDA(At, 0, 0); PG8_STAGE(PG8_SA(1, 1), a1 + hstepA, voffA);
            PG8_WAIT_V(8); PG8_WAIT_L(0); PG8_BAR; PG8_MMA(0, 0, At, B0); PG8_MMA(0, 1, At, B1); PG8_BAR; PG8_SCHED;
            PG8_LDA(At, 0, 1); PG8_STAGE(PG8_SB(0, 0), b2, voffB); PG8_STAGE(PG8_SB(0, 1), b2 + hstep, voffB); PG8_STAGE(PG8_SA(0, 0), a2, voffA);
            PG8_WAIT_V(8); PG8_WAIT_L(0); PG8_BAR; PG8_MMA(1, 0, At, B0); PG8_MMA(1, 1, At, B1); PG8_BAR; PG8_SCHED;
            PG8_LDB(B0, 1, 0); PG8_LDB(B1, 1, 1); PG8_SCHED; PG8_LDA(At, 1, 0); PG8_STAGE(PG8_SA(0, 1), a2 + hstepA, voffA);
            PG8_WAIT_V(8); PG8_WAIT_L(0); PG8_BAR; PG8_MMA(0, 0, At, B0); PG8_MMA(0, 1, At, B1); PG8_BAR; PG8_SCHED;
            PG8_LDA(At, 1, 1); PG8_STAGE(PG8_SB(1, 0), b3, voffB); PG8_STAGE(PG8_SB(1, 1), b3 + hstep, voffB); PG8_STAGE(PG8_SA(1, 0), a3, voffA);
            PG8_WAIT_V(8); PG8_WAIT_L(0); PG8_BAR; PG8_MMA(1, 0, At, B0); PG8_MMA(1, 1, At, B1); PG8_BAR; PG8_SCHED;
            } else {
            PG8_LDB(B0, 0, 0); PG8_SCHED; PG8_LDA(At, 0, 0); PG8_STAGE(PG8_SA(1, 1), a1 + hstepA, voffA);
            PG8_WAIT_L(8); PG8_BAR; PG8_WAIT_L(0); PG8_MMA(0, 0, At, B0); PG8_BAR; PG8_SCHED;
            PG8_LDB(B1, 0, 1); PG8_STAGE(PG8_SB(0, 0), b2, voffB);
            PG8_BAR; PG8_WAIT_L(0); PG8_MMA(0, 1, At, B1); PG8_BAR;
            PG8_LDA(At, 0, 1); PG8_STAGE(PG8_SA(0, 0), a2, voffA);
            PG8_BAR; PG8_WAIT_L(0); PG8_MMA(1, 0, At, B0); PG8_BAR; PG8_SCHED;
            PG8_STAGE(PG8_SB(0, 1), b2 + hstep, voffB);
            PG8_WAIT_V(6); PG8_BAR; PG8_MMA(1, 1, At, B1); PG8_BAR;
            PG8_LDB(B0, 1, 0); PG8_SCHED; PG8_LDA(At, 1, 0); PG8_STAGE(PG8_SA(0, 1), a2 + hstepA, voffA);
            PG8_WAIT_L(8); PG8_BAR; PG8_WAIT_L(0); PG8_MMA(0, 0, At, B0); PG8_BAR; PG8_SCHED;
            PG8_LDB(B1, 1, 1); PG8_STAGE(PG8_SB(1, 0), b3, voffB);
            PG8_BAR; PG8_WAIT_L(0); PG8_MMA(0, 1, At, B1); PG8_BAR;
            PG8_LDA(At, 1, 1); PG8_STAGE(PG8_SA(1, 0), a3, voffA);
            PG8_BAR; PG8_WAIT_L(0); PG8_MMA(1, 0, At, B0); PG8_BAR; PG8_SCHED;
            PG8_STAGE(PG8_SB(1, 1), b3 + hstep, voffB);
            PG8_WAIT_V(6); PG8_BAR; PG8_MMA(1, 1, At, B1); PG8_BAR;
            }
        }
        if constexpr (ALIGN_EPI) { if (wr == 0) PG8_BAR; }
        if constexpr (!Epi::AFTER_DRAIN) { E(acc, cur, wr, wc, fr, fq); S.done(cur); }
        if (!has_next) break;
#pragma unroll
        for (int a = 0; a < 2; ++a)
#pragma unroll
            for (int b = 0; b < 2; ++b)
#pragma unroll
                for (int m = 0; m < 4; ++m)
#pragma unroll
                    for (int n = 0; n < 2; ++n) acc[a][b][m][n] = (f32x4){0.f, 0.f, 0.f, 0.f};
        cur = nxt; cA = nA; cB = nB; ++ui;
        if constexpr (ALIGN_EPI) { if (wr == 1) PG8_BAR; }
    }
    PG8_WAIT_V(0);
    if constexpr (!ALIGN_EPI) { if (wr == 0) PG8_BAR; }
    PG8_BAR;
    if constexpr (Epi::AFTER_DRAIN) { E.fused(acc, cur, wr, wc, fr, fq, lds, wid, lane); S.done(cur); }
#undef PG8_SA
#undef PG8_SB
#undef PG8_STAGE
#undef PG8_LDA
#undef PG8_LDB
#undef PG8_MMA
#undef PG8_WAIT_V
#undef PG8_WAIT_L
#undef PG8_BAR
#undef PG8_SCHED
}
}

#define LAS __attribute__((address_space(3)))
using pg8::bf16_t; using pg8::bf16x8; using pg8::f32x4; using pg8::u32x4;
typedef float f32x16 __attribute__((ext_vector_type(16)));
typedef float f32x2 __attribute__((ext_vector_type(2)));
typedef unsigned u32x2 __attribute__((ext_vector_type(2)));
typedef __bf16 bf16x2v __attribute__((ext_vector_type(2)));

constexpr int DM = 1024, MP = 65536, MS = 512, MT = MP + MS  , MC = 32768, MKV = MT + MC  ;
constexpr int DFF = 2816, NINP = 4864, NMODC = 9216;
constexpr float EPSF = 1e-6f;
constexpr int LDS_BYTES = 131072 + 256;
constexpr int NSTEPS = 19;
#define STAGGER_MODE 0
#define GEMM_ALIGN_EPI true
#define GEMM_SP2 true
#define PROBE_DUP -1

constexpr size_t al256(size_t x) { return (x + 255) & ~(size_t)255; }
constexpr size_t O_CTL = 0;
constexpr size_t O_MOD = 256;
constexpr size_t O_RV  = al256(O_MOD + (size_t)40 * NMODC * 4);
constexpr size_t O_W1U = al256(O_RV + (size_t)MT * 4);
constexpr size_t O_W1D = O_W1U + (size_t)2 * DFF * DM * 2;
constexpr size_t O_W2U = O_W1D + (size_t)DM * DFF * 2;
constexpr size_t O_W2D = O_W2U + (size_t)2 * DFF * DM * 2;
constexpr size_t O_WIN = O_W2D + (size_t)DM * DFF * 2;
constexpr size_t O_WUQ = O_WIN + (size_t)NINP * DM * 2;
constexpr size_t O_WUK = O_WUQ + (size_t)768 * 384 * 2;
constexpr size_t O_WUV = O_WUK + (size_t)512 * 256 * 2;
constexpr size_t O_WBA = O_WUV + (size_t)512 * 256 * 2;
constexpr size_t O_WBB = O_WBA + (size_t)1024 * 1024 * 2;
constexpr size_t O_WO  = O_WBB + (size_t)1024 * 512 * 2;
constexpr size_t O_WS  = O_WO + (size_t)1024 * 1024 * 2;
constexpr size_t O_H   = al256(O_WS + (size_t)8 * 128 * 128 * 2);
constexpr size_t O_ZA  = O_H + (size_t)MT * 1024 * 2;
constexpr size_t O_G   = O_ZA + (size_t)MT * 2048 * 2;
constexpr size_t O_ZS  = O_G + (size_t)MT * 2048 * 2;
constexpr size_t O_KF  = O_ZS + (size_t)MT * 768 * 2;
constexpr size_t O_CKV = O_KF + (size_t)MKV * 768 * 2;
constexpr size_t O_KR  = O_CKV + (size_t)MKV * 256 * 2;
constexpr size_t O_KRSS = O_KR + (size_t)MKV * 32 * 4;
constexpr size_t O_BAR = al256(O_KRSS + (size_t)MKV * 4);
constexpr size_t O_T2 = O_BAR + 16384;
constexpr size_t WS_END = O_T2 + (size_t)MS * 1024 * 2;
constexpr size_t O_ACT = O_ZA;
constexpr size_t O_QR  = O_ZA;
constexpr size_t O_VT  = O_ZA + (size_t)MT * 768 * 2;
constexpr size_t O_T   = O_ZA;
constexpr size_t O_MG  = O_ZA + (size_t)MT * 1024 * 2;
constexpr size_t O_OB  = O_ZS;
constexpr size_t O_X2  = O_ZS;
constexpr size_t O_OA  = O_H;
static_assert((size_t)MT * 768 * 2 + (size_t)512 * MKV * 2 <= (size_t)MT * 2048 * 2, "QR+VT must fit in ZA");
static_assert((size_t)MT * DFF * 2 <= (size_t)MT * 4096 * 2, "ACT must fit in ZA+G");

constexpr size_t OUT_Y = 0;
constexpr size_t OUT_CKVP = (size_t)MT * 1024;
constexpr size_t OUT_KRP = OUT_CKVP + (size_t)MP * 256;
constexpr size_t OUT_CKVS = OUT_KRP + (size_t)MP * 32;
constexpr size_t OUT_KRS = OUT_CKVS + (size_t)MS * 256;
constexpr size_t OUT_GV = OUT_KRS + (size_t)MS * 32;

enum { I_XP = 0, I_XS, I_CP, I_CS, I_CCKV, I_CKR, I_WMOD, I_BMOD, I_GFFN1, I_W1U, I_W1D, I_GMIX, I_WIN, I_GGV, I_GWS, I_GB, I_GQL, I_WUQ, I_GKVL, I_WUK, I_WUV,
       I_GQN, I_GKN, I_BGATE, I_WBA, I_WBB, I_WO, I_GFFN2, I_W2U, I_W2D };

struct Params {
    const float* in[30];
    float* out;
    unsigned char* ws;
    int ph_lo, ph_hi;
};

__device__ __forceinline__ unsigned pk2(float lo, float hi) { f32x2 v = {lo, hi}; bf16x2v b = __builtin_convertvector(v, bf16x2v); return __builtin_bit_cast(unsigned, b); }
__device__ __forceinline__ float bflo(unsigned w) { return __uint_as_float(w << 16); }
__device__ __forceinline__ float bfhi(unsigned w) { return __uint_as_float(w & 0xffff0000u); }
__device__ __forceinline__ float bf2f(bf16_t b) { return __uint_as_float((unsigned)b << 16); }
__device__ __forceinline__ bf16_t f2bf(float x) { return (bf16_t)(pk2(x, 0.f) & 0xffffu); }
__device__ __forceinline__ float wave_sum(float v) {
#pragma unroll
    for (int o = 1; o < 64; o <<= 1) v += __shfl_xor(v, o);
    return v;
}
__device__ __forceinline__ float fast_exp2(float x) { return __builtin_amdgcn_exp2f(x); }
__device__ __forceinline__ float sigmoidf_(float x) { return __builtin_amdgcn_rcpf(1.0f + fast_exp2(-1.4426950408889634f * x)); }
__device__ __forceinline__ float siluf_(float x) { return x * sigmoidf_(x); }
__device__ __forceinline__ float gelu_tanh(float x) { const float y = 1.5957691216057308f * (x + 0.044715f * x * x * x); return x * sigmoidf_(y); }
__device__ __forceinline__ int batch_of(int row) { return row < MP ? (row >> 11) : 32 + ((row - MP) >> 6); }
__device__ __forceinline__ float pos_of(int row) { return row < MP ? (float)(row & 2047) : (float)(4096 + ((row - MP) & 63)); }
__device__ __forceinline__ void rope_sc(float pos, int i, float& sn, float& cs) {
    const float freq = exp2f(-(float)i * (13.287712379549449f / 16.0f));
    const float ang = pos * freq;
    float rev = ang * 0.15915494309189535f; rev = rev - floorf(rev);
    sn = __builtin_amdgcn_sinf(rev); cs = __builtin_amdgcn_cosf(rev);
}

enum { EM_SWIGLU = 0, EM_RESID, EM_WIN, EM_PLAIN, EM_KNOPE, EM_BRA, EM_BRB, EM_RESID_B2B, EM_RESID_B2F, EM_ATOMIC };
struct Epi {
    static constexpr bool PERM = true, AFTER_DRAIN = false;
    int mode, sub, gidx, row_off; float coef;
    unsigned char* ws; float* Y; const float* xp; const float* xs; const float* bgate;
    __device__ __forceinline__ void operator()(const f32x4 (&acc)[2][2][4][2], const pg8::Unit& u, int wr, int wc, int fr, int fq) const {
        const int row0 = row_off + u.pm * 256 + wr * 64 + fr, cl = wc * 32 + 8 * fq;
        const float* MODv = (const float*)(ws + O_MOD);
        bf16_t* O = (bf16_t*)(ws + (mode == EM_SWIGLU ? O_ACT : mode == EM_KNOPE ? O_KF : mode == EM_BRA ? O_T : mode == EM_BRB ? O_MG : (sub == 0 ? O_QR : O_VT)));
        if (mode == EM_BRA && (row_off + u.pm * 256) >= MP) O = (bf16_t*)(ws + O_T2) - (size_t)MP * 1024;
        const int ldc = sub == 0 ? 768 : MKV;
        const bool srows = (row_off + u.pm * 256) >= MP;
        const bf16_t* G = (const bf16_t*)(ws + O_G); const bf16_t* T = srows ? (const bf16_t*)(ws + O_T2) - (size_t)MP * 1024 : (const bf16_t*)(ws + O_T);
        bf16_t* ZA = (bf16_t*)(ws + O_ZA); bf16_t* Gw = (bf16_t*)(ws + O_G); bf16_t* ZS = (bf16_t*)(ws + O_ZS);
        const bf16_t* xb = (mode == EM_RESID_B2B) ? (const bf16_t*)Y : (const bf16_t*)(ws + O_X2);
        bf16_t* yb = (mode == EM_RESID) ? (bf16_t*)Y : (bf16_t*)(ws + O_X2);
        if (mode == EM_SWIGLU) {
#pragma unroll
            for (int ai = 0; ai < 2; ++ai)
#pragma unroll
                for (int m = 0; m < 4; ++m) {
                    const int r = row0 + ai * 128 + m * 16;
                    float o[8];
#pragma unroll
                    for (int n = 0; n < 2; ++n)
#pragma unroll
                        for (int j = 0; j < 4; ++j) { const float g = acc[ai][0][m][n][j], uu = acc[ai][1][m][n][j]; o[4 * n + j] = siluf_(g) * uu; }
                    u32x4 w; w.x = pk2(o[0], o[1]); w.y = pk2(o[2], o[3]); w.z = pk2(o[4], o[5]); w.w = pk2(o[6], o[7]);
                    *(u32x4*)(O + (size_t)r * DFF + u.pn * 128 + cl) = w;
                }
        } else if (mode == EM_RESID) {
            const int c0 = u.pn * 256 + cl;
#pragma unroll
            for (int ai = 0; ai < 2; ++ai) {
                f32x4 gg[2][2];
                const float* gt = MODv + (size_t)batch_of(row0 + ai * 128) * NMODC + gidx * DM;
#pragma unroll
                for (int bj = 0; bj < 2; ++bj)
#pragma unroll
                    for (int n = 0; n < 2; ++n) gg[bj][n] = *(const f32x4*)(gt + c0 + bj * 128 + 4 * n) * coef;
#pragma unroll
                for (int mh = 0; mh < 2; ++mh) {
                    f32x4 bs[2][2][2];
#pragma unroll
                    for (int mm = 0; mm < 2; ++mm) { const int r = row0 + ai * 128 + (2 * mh + mm) * 16; const float* base = (r < MP) ? xp + (size_t)r * DM : xs + (size_t)(r - MP) * DM;
#pragma unroll
                        for (int bj = 0; bj < 2; ++bj)
#pragma unroll
                            for (int n = 0; n < 2; ++n) bs[mm][bj][n] = *(const f32x4*)(base + c0 + bj * 128 + 4 * n); }
                    asm volatile("" ::: "memory");
#pragma unroll
                    for (int mm = 0; mm < 2; ++mm) { const int m = 2 * mh + mm; const int r = row0 + ai * 128 + m * 16;
#pragma unroll
                        for (int bj = 0; bj < 2; ++bj) {
                            const f32x4 o0 = bs[mm][bj][0] + gg[bj][0] * acc[ai][bj][m][0], o1 = bs[mm][bj][1] + gg[bj][1] * acc[ai][bj][m][1];
                            u32x4 w; w.x = pk2(o0[0], o0[1]); w.y = pk2(o0[2], o0[3]); w.z = pk2(o1[0], o1[1]); w.w = pk2(o1[2], o1[3]);
                            *(u32x4*)(yb + (size_t)r * DM + c0 + bj * 128) = w;
                        } }
                    asm volatile("" ::: "memory");
                }
            }
        } else if (mode == EM_RESID_B2B || mode == EM_RESID_B2F) {
            const int c0 = u.pn * 256 + cl;
            const bool tof32 = (mode == EM_RESID_B2F);
#pragma unroll
            for (int ai = 0; ai < 2; ++ai) {
                u32x4 bs[4][2]; f32x4 gg[2][2];
                const bf16_t* xrow = xb + (size_t)(row0 + ai * 128) * DM + c0;
#pragma unroll
                for (int m = 0; m < 4; ++m)
#pragma unroll
                    for (int bj = 0; bj < 2; ++bj) bs[m][bj] = *(const u32x4*)(xrow + (size_t)m * 16 * DM + bj * 128);
                const float* gt = MODv + (size_t)batch_of(row0 + ai * 128) * NMODC + gidx * DM;
#pragma unroll
                for (int bj = 0; bj < 2; ++bj)
#pragma unroll
                    for (int n = 0; n < 2; ++n) gg[bj][n] = *(const f32x4*)(gt + c0 + bj * 128 + 4 * n) * coef;
                asm volatile("" ::: "memory");
#pragma unroll
                for (int m = 0; m < 4; ++m) {
                    const int r = row0 + ai * 128 + m * 16;
#pragma unroll
                    for (int bj = 0; bj < 2; ++bj) {
                        const u32x4 bw = bs[m][bj];
                        const f32x4 b0 = {bflo(bw.x), bfhi(bw.x), bflo(bw.y), bfhi(bw.y)}, b1 = {bflo(bw.z), bfhi(bw.z), bflo(bw.w), bfhi(bw.w)};
                        const f32x4 o0 = b0 + gg[bj][0] * acc[ai][bj][m][0], o1 = b1 + gg[bj][1] * acc[ai][bj][m][1];
                        if (tof32) { float* yo = Y + (size_t)r * DM + c0 + bj * 128; *(f32x4*)yo = o0; *(f32x4*)(yo + 4) = o1; }
                        else { u32x4 w; w.x = pk2(o0[0], o0[1]); w.y = pk2(o0[2], o0[3]); w.z = pk2(o1[0], o1[1]); w.w = pk2(o1[2], o1[3]);
                               *(u32x4*)(yb + (size_t)r * DM + c0 + bj * 128) = w; }
                    }
                }
                asm volatile("" ::: "memory");
            }
        } else if (mode == EM_ATOMIC) {
            const int c0 = u.pn * 256 + cl;
#pragma unroll
            for (int ai = 0; ai < 2; ++ai) {
                f32x4 gg[2][2];
                const float* gt = MODv + (size_t)batch_of(row0 + ai * 128) * NMODC + gidx * DM;
#pragma unroll
                for (int bj = 0; bj < 2; ++bj)
#pragma unroll
                    for (int n = 0; n < 2; ++n) gg[bj][n] = *(const f32x4*)(gt + c0 + bj * 128 + 4 * n) * coef;
#pragma unroll
                for (int m = 0; m < 4; ++m) { float* yo = Y + (size_t)(row0 + ai * 128 + m * 16) * DM + c0;
#pragma unroll
                    for (int bj = 0; bj < 2; ++bj)
#pragma unroll
                        for (int n = 0; n < 2; ++n) { const f32x4 v = gg[bj][n] * acc[ai][bj][m][n];
#pragma unroll
                            for (int j = 0; j < 4; ++j) __hip_atomic_fetch_add(yo + bj * 128 + 4 * n + j, v[j], __ATOMIC_RELAXED, __HIP_MEMORY_SCOPE_AGENT); } }
            }
        } else if (mode == EM_WIN) {
            const int sel = u.pn < 8 ? 0 : (u.pn < 16 ? 1 : 2);
#pragma unroll
            for (int ai = 0; ai < 2; ++ai)
#pragma unroll
                for (int m = 0; m < 4; ++m) {
                    const int r = row0 + ai * 128 + m * 16;
#pragma unroll
                    for (int bj = 0; bj < 2; ++bj) {
                        float o[8];
#pragma unroll
                        for (int n = 0; n < 2; ++n)
#pragma unroll
                            for (int j = 0; j < 4; ++j) o[4 * n + j] = acc[ai][bj][m][n][j];
                        bf16_t* dst;
                        if (sel == 0) {
                            const int c = u.pn * 256 + bj * 128 + cl;
                            dst = ZA + (size_t)r * 2048 + c;
                        } else if (sel == 1) {
                            const int c = (u.pn - 8) * 256 + bj * 128 + cl;
                            const f32x4 b0 = *(const f32x4*)(bgate + c), b1 = *(const f32x4*)(bgate + c + 4);
#pragma unroll
                            for (int j = 0; j < 4; ++j) { o[j] = sigmoidf_(o[j] + b0[j]); o[4 + j] = sigmoidf_(o[4 + j] + b1[j]); }
                            dst = Gw + (size_t)r * 2048 + c;
                        } else {
                            const int c = (u.pn - 16) * 256 + bj * 128 + cl;
                            dst = ZS + (size_t)r * 768 + c;
                        }
                        u32x4 w; w.x = pk2(o[0], o[1]); w.y = pk2(o[2], o[3]); w.z = pk2(o[4], o[5]); w.w = pk2(o[6], o[7]);
                        *(u32x4*)dst = w;
                    }
                }
        } else if (mode == EM_KNOPE) {
            const int head = u.pn * 4 + wc;
            const float* gkn = bgate;
            const float* KRp = (const float*)(ws + O_KR); const float* KSS = (const float*)(ws + O_KRSS);
            f32x4 gn[2][2], gr[2];
#pragma unroll
            for (int bj = 0; bj < 2; ++bj) { gn[bj][0] = *(const f32x4*)(gkn + bj * 32 + 8 * fq); gn[bj][1] = *(const f32x4*)(gkn + bj * 32 + 8 * fq + 4); }
            gr[0] = *(const f32x4*)(gkn + 64 + 8 * fq); gr[1] = *(const f32x4*)(gkn + 64 + 8 * fq + 4);
#pragma unroll
            for (int ai = 0; ai < 2; ++ai)
#pragma unroll
                for (int m = 0; m < 4; ++m) {
                    const int r = row0 + ai * 128 + m * 16;
                    const f32x4 k0 = *(const f32x4*)(KRp + (size_t)r * 32 + 8 * fq), k1 = *(const f32x4*)(KRp + (size_t)r * 32 + 8 * fq + 4);
                    const float krss = KSS[r];
                    float ss = 0.f;
#pragma unroll
                    for (int bj = 0; bj < 2; ++bj)
#pragma unroll
                        for (int n = 0; n < 2; ++n) { const f32x4 v = acc[ai][bj][m][n]; ss += (v[0] * v[0] + v[1] * v[1]) + (v[2] * v[2] + v[3] * v[3]); }
                    ss += __shfl_xor(ss, 16); ss += __shfl_xor(ss, 32);
                    const float rinv = rsqrtf((ss + krss) * (1.0f / 96.0f) + EPSF);
                    bf16_t* dst = O + (size_t)r * 768 + head * 96;
#pragma unroll
                    for (int bj = 0; bj < 2; ++bj) {
                        const f32x4 v0 = acc[ai][bj][m][0] * gn[bj][0] * rinv, v1 = acc[ai][bj][m][1] * gn[bj][1] * rinv;
                        u32x4 w; w.x = pk2(v0[0], v0[1]); w.y = pk2(v0[2], v0[3]); w.z = pk2(v1[0], v1[1]); w.w = pk2(v1[2], v1[3]);
                        *(u32x4*)(dst + bj * 32 + 8 * fq) = w;
                    }
                    { const f32x4 v0 = k0 * gr[0] * rinv, v1 = k1 * gr[1] * rinv;
                      u32x4 w; w.x = pk2(v0[0], v0[1]); w.y = pk2(v0[2], v0[3]); w.z = pk2(v1[0], v1[1]); w.w = pk2(v1[2], v1[3]);
                      *(u32x4*)(dst + 64 + 8 * fq) = w; }
                }
        } else if (mode == EM_PLAIN) {
#pragma unroll
            for (int ai = 0; ai < 2; ++ai)
#pragma unroll
                for (int m = 0; m < 4; ++m) {
                    const int r = row0 + ai * 128 + m * 16;
#pragma unroll
                    for (int bj = 0; bj < 2; ++bj) {
                        const int c = u.pn * 256 + bj * 128 + cl;
                        const f32x4 v0 = acc[ai][bj][m][0], v1 = acc[ai][bj][m][1];
                        u32x4 w; w.x = pk2(v0[0], v0[1]); w.y = pk2(v0[2], v0[3]); w.z = pk2(v1[0], v1[1]); w.w = pk2(v1[2], v1[3]);
                        *(u32x4*)(O + (size_t)r * ldc + c) = w;
                    }
                }
        } else {
            const int c0 = u.pn * 256 + cl;
            const bool isb = (mode == EM_BRB);
#pragma unroll
            for (int ai = 0; ai < 2; ++ai) {
                u32x4 gs[4][2], ts[4][2];
                const bf16_t* grow = G + (size_t)(row0 + ai * 128) * 2048 + (isb ? 1024 : 0) + c0;
                const bf16_t* trow = T + (size_t)(row0 + ai * 128) * 1024 + c0;
#pragma unroll
                for (int m = 0; m < 4; ++m)
#pragma unroll
                    for (int bj = 0; bj < 2; ++bj) { gs[m][bj] = *(const u32x4*)(grow + (size_t)m * 16 * 2048 + bj * 128);
                        ts[m][bj] = isb ? *(const u32x4*)(trow + (size_t)m * 16 * 1024 + bj * 128) : (u32x4){0u, 0u, 0u, 0u}; }
                asm volatile("" ::: "memory");
#pragma unroll
                for (int m = 0; m < 4; ++m) { const int r = row0 + ai * 128 + m * 16;
#pragma unroll
                    for (int bj = 0; bj < 2; ++bj) {
                        const u32x4 gw = gs[m][bj], tw = ts[m][bj];
                        const f32x4 v0 = acc[ai][bj][m][0], v1 = acc[ai][bj][m][1];
                        float o[8];
                        o[0] = bflo(gw.x) * v0[0]; o[1] = bfhi(gw.x) * v0[1]; o[2] = bflo(gw.y) * v0[2]; o[3] = bfhi(gw.y) * v0[3];
                        o[4] = bflo(gw.z) * v1[0]; o[5] = bfhi(gw.z) * v1[1]; o[6] = bflo(gw.w) * v1[2]; o[7] = bfhi(gw.w) * v1[3];
                        if (isb) { o[0] += bflo(tw.x); o[1] += bfhi(tw.x); o[2] += bflo(tw.y); o[3] += bfhi(tw.y);
                                   o[4] += bflo(tw.z); o[5] += bfhi(tw.z); o[6] += bflo(tw.w); o[7] += bfhi(tw.w); }
                        u32x4 w; w.x = pk2(o[0], o[1]); w.y = pk2(o[2], o[3]); w.z = pk2(o[4], o[5]); w.w = pk2(o[6], o[7]);
                        *(u32x4*)(O + (size_t)r * 1024 + c0 + bj * 128) = w;
                    } }
                asm volatile("" ::: "memory");
            }
        }
    }
};

template <class MapF>
__device__ __forceinline__ void conv_wT(const float* __restrict__ W, int K, int Nsrc, bf16_t* __restrict__ Bt, int Ndst, MapF map, size_t gtid, size_t gsz) {
    const size_t total = (size_t)Ndst * (size_t)(K / 8);
    for (size_t i = gtid; i < total; i += gsz) {
        const int n = (int)(i % (size_t)Ndst), kb = (int)(i / (size_t)Ndst);
        const int src = map(n);
        u32x4 o = {0u, 0u, 0u, 0u};
        if (src >= 0) {
            const float* p = W + (size_t)(kb * 8) * Nsrc + src;
            const float v0 = p[0], v1 = p[(size_t)Nsrc], v2 = p[(size_t)2 * Nsrc], v3 = p[(size_t)3 * Nsrc], v4 = p[(size_t)4 * Nsrc], v5 = p[(size_t)5 * Nsrc], v6 = p[(size_t)6 * Nsrc], v7 = p[(size_t)7 * Nsrc];
            o.x = pk2(v0, v1); o.y = pk2(v2, v3); o.z = pk2(v4, v5); o.w = pk2(v6, v7);
        }
        *(u32x4*)(Bt + (size_t)n * K + kb * 8) = o;
    }
}
struct MapId { __device__ __forceinline__ int operator()(int n) const { return n; } };
struct MapUp { __device__ __forceinline__ int operator()(int n) const { const int t = n >> 8, l = n & 255; return l < 128 ? t * 128 + l : DFF + t * 128 + (l - 128); } };
struct MapUk { __device__ __forceinline__ int operator()(int n) const { const int pn = n >> 8, bj = (n >> 7) & 1, wc = (n >> 5) & 3, x = n & 31; return (pn * 4 + wc) * 64 + bj * 32 + x; } };
struct MapIn { __device__ __forceinline__ int operator()(int n) const { return n < 2048 ? n : (n < 4096 ? 2720 + (n - 2048) : (n < 4768 ? 2048 + (n - 4096) : -1)); } };

__device__ __forceinline__ void prep_phase(const Params& P, LAS unsigned char* lds, const int wv_) {
    int tid_; asm volatile("v_mbcnt_lo_u32_b32 %0, -1, 0\n\tv_mbcnt_hi_u32_b32 %0, -1, %0" : "=v"(tid_)); tid_ += 64 * wv_;
    const int tid = tid_, lane = tid & 63, wid = __builtin_amdgcn_readfirstlane(tid >> 6);
    const size_t gtid = (size_t)blockIdx.x * 512 + tid, gsz = (size_t)gridDim.x * 512;
    unsigned char* ws = P.ws;
    if (gtid < 64) ((unsigned*)(ws + O_CTL))[gtid] = 0u;
    if (blockIdx.x < NMODC / 64) {
        const int n0 = blockIdx.x * 64;
        const float* cp = P.in[I_CP]; const float* cs = P.in[I_CS]; const float* wm = P.in[I_WMOD];
        LAS float* sc = (LAS float*)lds;
        float acc[40];
#pragma unroll
        for (int b = 0; b < 40; ++b) acc[b] = 0.f;
        for (int half = 0; half < 2; ++half) {
            __syncthreads();
            for (int i = tid; i < 40 * 512; i += 512) { const int b = i >> 9, k = i & 511; const float c = b < 32 ? cp[b * 1024 + half * 512 + k] : cs[(b - 32) * 1024 + half * 512 + k]; sc[i] = siluf_(c); }
            __syncthreads();
            for (int kk = 0; kk < 64; kk += 4) {
                const int kl = wid * 64 + kk; const size_t kg = (size_t)(half * 512 + kl);
                const float w0 = wm[kg * NMODC + n0 + lane], w1 = wm[(kg + 1) * NMODC + n0 + lane], w2 = wm[(kg + 2) * NMODC + n0 + lane], w3 = wm[(kg + 3) * NMODC + n0 + lane];
#pragma unroll
                for (int b = 0; b < 40; ++b) { const f32x4 s = *(const LAS f32x4*)(sc + b * 512 + kl); acc[b] += s.x * w0 + s.y * w1 + s.z * w2 + s.w * w3; }
            }
        }
        __syncthreads();
        LAS float* red = (LAS float*)lds;
#pragma unroll
        for (int b = 0; b < 40; ++b) red[(wid * 40 + b) * 64 + lane] = acc[b];
        __syncthreads();
        float* MODv = (float*)(ws + O_MOD); const float* bm = P.in[I_BMOD];
        for (int i = tid; i < 40 * 64; i += 512) { const int b = i >> 6, l = i & 63; float s = bm[n0 + l];
#pragma unroll
            for (int w = 0; w < 8; ++w) s += red[(w * 40 + b) * 64 + l];
            MODv[(size_t)b * NMODC + n0 + l] = s; }
        __syncthreads();
    }
    conv_wT(P.in[I_W1U], 1024, 2 * DFF, (bf16_t*)(ws + O_W1U), 2 * DFF, MapUp(), gtid, gsz);
    conv_wT(P.in[I_W2U], 1024, 2 * DFF, (bf16_t*)(ws + O_W2U), 2 * DFF, MapUp(), gtid, gsz);
    conv_wT(P.in[I_W1D], DFF, 1024, (bf16_t*)(ws + O_W1D), 1024, MapId(), gtid, gsz);
    conv_wT(P.in[I_W2D], DFF, 1024, (bf16_t*)(ws + O_W2D), 1024, MapId(), gtid, gsz);
    conv_wT(P.in[I_WIN], 1024, 4768, (bf16_t*)(ws + O_WIN), NINP, MapIn(), gtid, gsz);
    conv_wT(P.in[I_WUQ], 384, 768, (bf16_t*)(ws + O_WUQ), 768, MapId(), gtid, gsz);
    conv_wT(P.in[I_WUK], 256, 512, (bf16_t*)(ws + O_WUK), 512, MapUk(), gtid, gsz);
    conv_wT(P.in[I_WUV], 256, 512, (bf16_t*)(ws + O_WUV), 512, MapId(), gtid, gsz);
    conv_wT(P.in[I_WBA], 1024, 1024, (bf16_t*)(ws + O_WBA), 1024, MapId(), gtid, gsz);
    conv_wT(P.in[I_WBB], 512, 1024, (bf16_t*)(ws + O_WBB), 1024, MapId(), gtid, gsz);
    conv_wT(P.in[I_WO], 1024, 1024, (bf16_t*)(ws + O_WO), 1024, MapId(), gtid, gsz);
    { const float* w = P.in[I_GWS]; bf16_t* o = (bf16_t*)(ws + O_WS);
      for (size_t i = gtid; i < (size_t)8 * 128 * 128; i += gsz) { const int s = (int)(i & 127), t = (int)((i >> 7) & 127); o[i] = f2bf(s <= t ? w[i] : 0.f); } }
    { const float* c = P.in[I_CCKV]; bf16_t* o = (bf16_t*)(ws + O_CKV) + (size_t)MT * 256;
      for (size_t i = gtid; i < (size_t)MC * 256 / 4; i += gsz) { const f32x4 v = *(const f32x4*)(c + 4 * i); u32x2 w; w.x = pk2(v.x, v.y); w.y = pk2(v.z, v.w); *(u32x2*)(o + 4 * i) = w; }
      const float* kr = P.in[I_CKR]; float* ko = (float*)(ws + O_KR) + (size_t)MT * 32; float* kss = (float*)(ws + O_KRSS) + MT;
      for (size_t i = gtid; i < (size_t)MC; i += gsz) { float ss = 0.f;
#pragma unroll
          for (int j = 0; j < 8; ++j) { const f32x4 v = *(const f32x4*)(kr + 32 * i + 4 * j); *(f32x4*)(ko + 32 * i + 4 * j) = v; ss += (v.x * v.x + v.y * v.y) + (v.z * v.z + v.w * v.w); }
          kss[i] = ss; } }
}

__device__ __forceinline__ void modulate_phase(const float* xp, const float* xs, const float* g, const float* MODv, int ish, int isc, bf16_t* H, const int wv_) {
    int tid_; asm volatile("v_mbcnt_lo_u32_b32 %0, -1, 0\n\tv_mbcnt_hi_u32_b32 %0, -1, %0" : "=v"(tid_)); tid_ += 64 * wv_;
    const int tid = tid_, lane = tid & 63, wid = tid >> 6;
    const int gw = blockIdx.x * 8 + wid, ngw = gridDim.x * 8;
    f32x4 v[4][4], vn[4][4];
#define MOD_LOAD(dst, rb) do { _Pragma("unroll") for (int q = 0; q < 4; ++q) { const int row_ = (rb) + q * ngw; \
            if (row_ < MT) { const float* x_ = row_ < MP ? xp + (size_t)row_ * DM : xs + (size_t)(row_ - MP) * DM; \
                _Pragma("unroll") for (int j = 0; j < 4; ++j) dst[q][j] = *(const f32x4*)(x_ + 4 * lane + 256 * j); } \
            else { _Pragma("unroll") for (int j = 0; j < 4; ++j) dst[q][j] = (f32x4){0.f, 0.f, 0.f, 0.f}; } } } while (0)
    MOD_LOAD(v, gw);
    for (int rowb = gw; rowb < MT; rowb += 4 * ngw) {
        if (rowb + 4 * ngw < MT) MOD_LOAD(vn, rowb + 4 * ngw);
        float ss[4];
#pragma unroll
        for (int q = 0; q < 4; ++q) { float t = 0.f;
#pragma unroll
            for (int j = 0; j < 4; ++j) t += (v[q][j].x * v[q][j].x + v[q][j].y * v[q][j].y) + (v[q][j].z * v[q][j].z + v[q][j].w * v[q][j].w);
            ss[q] = wave_sum(t); }
#pragma unroll
        for (int q = 0; q < 4; ++q) {
            const int row = rowb + q * ngw;
            if (row < MT) {
                const float* mb = MODv + (size_t)batch_of(row) * NMODC;
                const float r = rsqrtf(ss[q] * (1.0f / 1024.0f) + EPSF);
#pragma unroll
                for (int j = 0; j < 4; ++j) {
                    const int c = 4 * lane + 256 * j;
                    const f32x4 gg = *(const f32x4*)(g + c), sc = *(const f32x4*)(mb + isc * DM + c), sh = *(const f32x4*)(mb + ish * DM + c);
                    const f32x4 o = (v[q][j] * r) * gg * (sc + 1.0f) + sh;
                    u32x2 w; w.x = pk2(o.x, o.y); w.y = pk2(o.z, o.w);
                    *(u32x2*)(H + (size_t)row * DM + c) = w;
                }
            }
        }
#pragma unroll
        for (int q = 0; q < 4; ++q)
#pragma unroll
            for (int j = 0; j < 4; ++j) v[q][j] = vn[q][j];
    }
#undef MOD_LOAD
}

__device__ __forceinline__ void modulate16_phase(const bf16_t* X, const float* g, const float* MODv, int ish, int isc, bf16_t* H, int row_begin, int row_end, int blk_first, const int wv_) {
    int tid_; asm volatile("v_mbcnt_lo_u32_b32 %0, -1, 0\n\tv_mbcnt_hi_u32_b32 %0, -1, %0" : "=v"(tid_)); tid_ += 64 * wv_;
    const int tid = tid_, lane = tid & 63, wid = tid >> 6;
    if ((int)blockIdx.x < blk_first) return;
    const int gw = ((int)blockIdx.x - blk_first) * 8 + wid, ngw = ((int)gridDim.x - blk_first) * 8;
    for (int rowb = row_begin + gw; rowb < row_end; rowb += 4 * ngw) {
        u32x4 v[4][2]; float ss[4];
#pragma unroll
        for (int q = 0; q < 4; ++q) {
            const int row = min(rowb + q * ngw, row_end - 1);
#pragma unroll
            for (int j = 0; j < 2; ++j) v[q][j] = *(const u32x4*)(X + (size_t)row * DM + 8 * lane + 512 * j);
        }
#pragma unroll
        for (int q = 0; q < 4; ++q) { float t = 0.f;
#pragma unroll
            for (int j = 0; j < 2; ++j) { const unsigned w[4] = {v[q][j].x, v[q][j].y, v[q][j].z, v[q][j].w};
#pragma unroll
                for (int e = 0; e < 4; ++e) { const float lo = bflo(w[e]), hi = bfhi(w[e]); t += lo * lo + hi * hi; } }
            ss[q] = wave_sum(t); }
#pragma unroll
        for (int q = 0; q < 4; ++q) {
            const int row = rowb + q * ngw;
            if (row < row_end) {
                const float* mb = MODv + (size_t)batch_of(row) * NMODC;
                const float r = rsqrtf(ss[q] * (1.0f / 1024.0f) + EPSF);
#pragma unroll
                for (int j = 0; j < 2; ++j) {
                    const int c = 8 * lane + 512 * j;
                    const unsigned w[4] = {v[q][j].x, v[q][j].y, v[q][j].z, v[q][j].w};
                    unsigned ow[4];
#pragma unroll
                    for (int e = 0; e < 2; ++e) {
                        const f32x4 gg = *(const f32x4*)(g + c + 4 * e), sc = *(const f32x4*)(mb + isc * DM + c + 4 * e), sh = *(const f32x4*)(mb + ish * DM + c + 4 * e);
                        const f32x4 x = {bflo(w[2 * e]), bfhi(w[2 * e]), bflo(w[2 * e + 1]), bfhi(w[2 * e + 1])};
                        const f32x4 o = (x * r) * gg * (sc + 1.0f) + sh;
                        ow[2 * e] = pk2(o.x, o.y); ow[2 * e + 1] = pk2(o.z, o.w);
                    }
                    *(u32x4*)(H + (size_t)row * DM + c) = (u32x4){ow[0], ow[1], ow[2], ow[3]};
                }
            }
        }
    }
}

__device__ __forceinline__ void rowpost_phase(const Params& P, const int wv_) {
    int tid_; asm volatile("v_mbcnt_lo_u32_b32 %0, -1, 0\n\tv_mbcnt_hi_u32_b32 %0, -1, %0" : "=v"(tid_)); tid_ += 64 * wv_;
    const int tid = tid_, lane = tid & 63, wid = tid >> 6;
    const int gw = blockIdx.x * 8 + wid, ngw = gridDim.x * 8;
    unsigned char* ws = P.ws;
    const bf16_t* ZA = (const bf16_t*)(ws + O_ZA); bf16_t* ZS = (bf16_t*)(ws + O_ZS); float* RV = (float*)(ws + O_RV);
    bf16_t* CKV = (bf16_t*)(ws + O_CKV); float* KR = (float*)(ws + O_KR);
    const float* gql = P.in[I_GQL]; const float* gkv = P.in[I_GKVL];
    for (int rowb = gw; rowb < MT; rowb += 2 * ngw) {
        u32x4 va[2], vb[2], qa[2]; u32x2 ka[2]; float kr[2];
#pragma unroll
        for (int q = 0; q < 2; ++q) {
            const int row = min(rowb + q * ngw, MT - 1);
            const u32x4* p = (const u32x4*)(ZA + (size_t)row * 2048 + 1024 + 16 * lane); va[q] = p[0]; vb[q] = p[1];
            const bf16_t* zs = ZS + (size_t)row * 768;
            qa[q] = (u32x4){0u, 0u, 0u, 0u}; if (lane < 48) qa[q] = *(const u32x4*)(zs + 8 * lane);
            ka[q] = *(const u32x2*)(zs + 384 + 4 * lane);
            kr[q] = lane < 32 ? bf2f(zs[640 + lane]) : 0.f;
        }
#pragma unroll
        for (int q = 0; q < 2; ++q) {
            const int row = rowb + q * ngw;
            if (row < MT) {
                bf16_t* zs = ZS + (size_t)row * 768;
                { const unsigned w[8] = {va[q].x, va[q].y, va[q].z, va[q].w, vb[q].x, vb[q].y, vb[q].z, vb[q].w}; float ss = 0.f;
#pragma unroll
                  for (int j = 0; j < 8; ++j) { const float lo = gelu_tanh(bflo(w[j])), hi = gelu_tanh(bfhi(w[j])); ss += lo * lo + hi * hi; }
                  ss = wave_sum(ss); if (lane == 0) RV[row] = rsqrtf(ss * (1.0f / 1024.0f) + EPSF); }
                { const u32x4 a = qa[q];
                  float qv[8] = {bflo(a.x), bfhi(a.x), bflo(a.y), bfhi(a.y), bflo(a.z), bfhi(a.z), bflo(a.w), bfhi(a.w)}; float ss = 0.f;
#pragma unroll
                  for (int j = 0; j < 8; ++j) ss += qv[j] * qv[j];
                  ss = wave_sum(ss); const float r = rsqrtf(ss * (1.0f / 384.0f) + EPSF);
                  if (lane < 48) { const f32x4 g0 = *(const f32x4*)(gql + 8 * lane), g1 = *(const f32x4*)(gql + 8 * lane + 4);
                    u32x4 w; w.x = pk2(qv[0] * r * g0.x, qv[1] * r * g0.y); w.y = pk2(qv[2] * r * g0.z, qv[3] * r * g0.w); w.z = pk2(qv[4] * r * g1.x, qv[5] * r * g1.y); w.w = pk2(qv[6] * r * g1.z, qv[7] * r * g1.w);
                    *(u32x4*)(zs + 8 * lane) = w; } }
                { const u32x2 a = ka[q]; float v[4] = {bflo(a.x), bfhi(a.x), bflo(a.y), bfhi(a.y)};
                  float ss = (v[0] * v[0] + v[1] * v[1]) + (v[2] * v[2] + v[3] * v[3]); ss = wave_sum(ss); const float r = rsqrtf(ss * (1.0f / 256.0f) + EPSF);
                  const f32x4 g4 = *(const f32x4*)(gkv + 4 * lane); f32x4 o = {v[0] * r * g4.x, v[1] * r * g4.y, v[2] * r * g4.z, v[3] * r * g4.w};
                  float* dst = row < MP ? P.out + OUT_CKVP + (size_t)row * 256 : P.out + OUT_CKVS + (size_t)(row - MP) * 256;
                  *(f32x4*)(dst + 4 * lane) = o; u32x2 w; w.x = pk2(o.x, o.y); w.y = pk2(o.z, o.w); *(u32x2*)(CKV + (size_t)row * 256 + 4 * lane) = w; }
                { const float val = kr[q]; const float partner = __shfl_xor(val, 16); float sn, cs; rope_sc(pos_of(row), lane & 15, sn, cs);
                  const float o = (lane < 16) ? val * cs - partner * sn : partner * sn + val * cs;
                  if (lane < 32) { KR[(size_t)row * 32 + lane] = o; float* dst = row < MP ? P.out + OUT_KRP + (size_t)row * 32 : P.out + OUT_KRS + (size_t)(row - MP) * 32; dst[lane] = o; }
                  const float oss = wave_sum(lane < 32 ? o * o : 0.f); if (lane == 0) ((float*)(ws + O_KRSS))[row] = oss; }
            }
        }
    }
}

__device__ __forceinline__ void gmlp_phase(const Params& P, LAS unsigned char* lds, const int wv_) {
    int tid_; asm volatile("v_mbcnt_lo_u32_b32 %0, -1, 0\n\tv_mbcnt_hi_u32_b32 %0, -1, %0" : "=v"(tid_)); tid_ += 64 * wv_;
    const int tid = tid_, lane = tid & 63, wid = __builtin_amdgcn_readfirstlane(tid >> 6), l32 = lane & 31, hh = lane >> 5;
    unsigned char* ws = P.ws;
    const bf16_t* ZA = (const bf16_t*)(ws + O_ZA); const float* RV = (const float*)(ws + O_RV); const bf16_t* WS = (const bf16_t*)(ws + O_WS);
    bf16_t* OA = (bf16_t*)(ws + O_OA);
    const float* ggv = P.in[I_GGV]; const float* gb = P.in[I_GB];
    LAS bf16_t* vt = (LAS bf16_t*)lds;
    LAS float* mx = (LAS float*)(lds + 34816);
    const int sr = tid >> 4, cp = tid & 15;
    for (int item = blockIdx.x; item < 520 * 8; item += gridDim.x) {
        const int ci = item >> 3, g = item & 7; const bool sample = ci >= 512;
        const int row0 = sample ? MP + (ci - 512) * 64 : ci * 128, L = sample ? 64 : 128;
        u32x4 gvr[4], ur[4]; float rvr[4];
#pragma unroll
        for (int p = 0; p < 4; ++p) {
            const int s = p * 32 + sr; const int row = row0 + (s < L ? s : 0);
            gvr[p] = *(const u32x4*)(ZA + (size_t)row * 2048 + 1024 + g * 128 + 8 * cp);
            ur[p] = *(const u32x4*)(ZA + (size_t)row * 2048 + g * 128 + 8 * cp);
            rvr[p] = RV[row];
        }
        const f32x4 g0 = *(const f32x4*)(ggv + g * 128 + 8 * cp), g1 = *(const f32x4*)(ggv + g * 128 + 8 * cp + 4);
        __syncthreads();
#pragma unroll
        for (int p = 0; p < 4; ++p) {
            const int s = p * 32 + sr;
            if (s < L) {
                const int row = row0 + s; const u32x4 a = gvr[p]; const float rv = rvr[p];
                float v[8] = {gelu_tanh(bflo(a.x)) * rv * g0.x, gelu_tanh(bfhi(a.x)) * rv * g0.y, gelu_tanh(bflo(a.y)) * rv * g0.z, gelu_tanh(bfhi(a.y)) * rv * g0.w, gelu_tanh(bflo(a.z)) * rv * g1.x, gelu_tanh(bfhi(a.z)) * rv * g1.y, gelu_tanh(bflo(a.w)) * rv * g1.z, gelu_tanh(bfhi(a.w)) * rv * g1.w};
                if (sample) { float* dst = P.out + OUT_GV + (size_t)(row - MP) * 1024 + g * 128 + 8 * cp; *(f32x4*)dst = (f32x4){v[0], v[1], v[2], v[3]}; *(f32x4*)(dst + 4) = (f32x4){v[4], v[5], v[6], v[7]}; }
#pragma unroll
                for (int j = 0; j < 8; ++j) vt[(8 * cp + j) * 136 + s] = f2bf(v[j]);
            }
        }
        __syncthreads();
        const int tb = wid & 3, ch = wid >> 2;
        if (32 * tb < L) {
            f32x16 acc0, acc1;
#pragma unroll
            for (int i = 0; i < 16; ++i) { acc0[i] = 0.f; acc1[i] = 0.f; }
            const bf16_t* wp = WS + ((size_t)g * 128 + 32 * tb + l32) * 128 + 8 * hh;
            const LAS bf16_t* b0p = vt + (64 * ch + l32) * 136 + 8 * hh; const LAS bf16_t* b1p = b0p + 32 * 136;
            const int nks = 2 * (tb + 1);
            for (int ks = 0; ks < nks; ++ks) {
                const bf16x8 a = *(const bf16x8*)(wp + 16 * ks);
                const bf16x8 b0 = *(const LAS bf16x8*)(b0p + 16 * ks), b1 = *(const LAS bf16x8*)(b1p + 16 * ks);
                acc0 = __builtin_amdgcn_mfma_f32_32x32x16_bf16(a, b0, acc0, 0, 0, 0);
                acc1 = __builtin_amdgcn_mfma_f32_32x32x16_bf16(a, b1, acc1, 0, 0, 0);
            }
#pragma unroll
            for (int i = 0; i < 16; ++i) {
                const int t = 32 * tb + (i & 3) + 8 * (i >> 2) + 4 * hh;
                mx[t * 132 + 64 * ch + l32] = acc0[i]; mx[t * 132 + 64 * ch + 32 + l32] = acc1[i];
            }
        }
        __syncthreads();
#pragma unroll
        for (int p = 0; p < 4; ++p) {
            const int t = p * 32 + sr;
            if (t < L) {
                const int row = row0 + t; const float bias = gb[g * 128 + t];
                const f32x4 m0 = *(const LAS f32x4*)(mx + t * 132 + 8 * cp), m1 = *(const LAS f32x4*)(mx + t * 132 + 8 * cp + 4);
                const u32x4 a = ur[p];
                u32x4 w;
                w.x = pk2(gelu_tanh(bflo(a.x)) * (m0.x + bias), gelu_tanh(bfhi(a.x)) * (m0.y + bias)); w.y = pk2(gelu_tanh(bflo(a.y)) * (m0.z + bias), gelu_tanh(bfhi(a.y)) * (m0.w + bias));
                w.z = pk2(gelu_tanh(bflo(a.z)) * (m1.x + bias), gelu_tanh(bfhi(a.z)) * (m1.y + bias)); w.w = pk2(gelu_tanh(bflo(a.w)) * (m1.z + bias), gelu_tanh(bfhi(a.w)) * (m1.w + bias));
                *(u32x4*)(OA + (size_t)row * 1024 + g * 128 + 8 * cp) = w;
            }
        }
    }
}

__device__ __forceinline__ void qkfinal_phase(const Params& P, const int wv_) {
    int tid_; asm volatile("v_mbcnt_lo_u32_b32 %0, -1, 0\n\tv_mbcnt_hi_u32_b32 %0, -1, %0" : "=v"(tid_)); tid_ += 64 * wv_;
    const int tid = tid_, lane = tid & 63, wid = tid >> 6;
    const int gw = blockIdx.x * 8 + wid, ngw = gridDim.x * 8;
    unsigned char* ws = P.ws;
    bf16_t* QR = (bf16_t*)(ws + O_QR); bf16_t* KF = (bf16_t*)(ws + O_KF); const float* KR = (const float*)(ws + O_KR);
    const float* gqn = P.in[I_GQN]; const float* gkn = P.in[I_GKN];
    const int h = lane >> 3, sub = lane & 7;
    constexpr float QSCALE = 0.10206207261596575f * 1.4426950408889634f;
    for (int itemb = gw; itemb < MT + MKV; itemb += 4 * ngw) {
        u32x4 na[4]; u32x2 qb[4]; f32x4 kb[4];
#pragma unroll
        for (int q = 0; q < 4; ++q) {
            const int item = min(itemb + q * ngw, MT + MKV - 1);
            const bool isq = item < MT; const int row = isq ? item : item - MT;
            const bf16_t* p = (isq ? QR : KF) + (size_t)row * 768 + h * 96;
            na[q] = *(const u32x4*)(p + 8 * sub);
            qb[q] = (u32x2){0u, 0u}; kb[q] = (f32x4){0.f, 0.f, 0.f, 0.f};
            if (isq) qb[q] = *(const u32x2*)(p + 64 + 4 * sub); else kb[q] = *(const f32x4*)(KR + (size_t)row * 32 + 4 * sub);
        }
#pragma unroll
        for (int q = 0; q < 4; ++q) {
            const int item = itemb + q * ngw;
            if (item < MT + MKV) {
                const bool isq = item < MT; const int row = isq ? item : item - MT;
                bf16_t* p = (isq ? QR : KF) + (size_t)row * 768 + h * 96;
                const u32x4 a = na[q];
                float nope[8] = {bflo(a.x), bfhi(a.x), bflo(a.y), bfhi(a.y), bflo(a.z), bfhi(a.z), bflo(a.w), bfhi(a.w)};
                float rp[4];
                if (isq) {
                    const u32x2 b = qb[q];
                    const float raw[4] = {bflo(b.x), bfhi(b.x), bflo(b.y), bfhi(b.y)};
                    const float pos = pos_of(row);
#pragma unroll
                    for (int j = 0; j < 4; ++j) { const float partner = __shfl_xor(raw[j], 4); float sn, cs; rope_sc(pos, (4 * sub + j) & 15, sn, cs);
                        rp[j] = (sub < 4) ? raw[j] * cs - partner * sn : partner * sn + raw[j] * cs; }
                } else { rp[0] = kb[q].x; rp[1] = kb[q].y; rp[2] = kb[q].z; rp[3] = kb[q].w; }
                float ss = 0.f;
#pragma unroll
                for (int j = 0; j < 8; ++j) ss += nope[j] * nope[j];
#pragma unroll
                for (int j = 0; j < 4; ++j) ss += rp[j] * rp[j];
                ss += __shfl_xor(ss, 1); ss += __shfl_xor(ss, 2); ss += __shfl_xor(ss, 4);
                const float r = rsqrtf(ss * (1.0f / 96.0f) + EPSF) * (isq ? QSCALE : 1.0f);
                const float* gn = isq ? gqn : gkn;
                const f32x4 g0 = *(const f32x4*)(gn + 8 * sub), g1 = *(const f32x4*)(gn + 8 * sub + 4), g2 = *(const f32x4*)(gn + 64 + 4 * sub);
                u32x4 w; w.x = pk2(nope[0] * r * g0.x, nope[1] * r * g0.y); w.y = pk2(nope[2] * r * g0.z, nope[3] * r * g0.w); w.z = pk2(nope[4] * r * g1.x, nope[5] * r * g1.y); w.w = pk2(nope[6] * r * g1.z, nope[7] * r * g1.w);
                u32x2 w2; w2.x = pk2(rp[0] * r * g2.x, rp[1] * r * g2.y); w2.y = pk2(rp[2] * r * g2.z, rp[3] * r * g2.w);
                *(u32x4*)(p + 8 * sub) = w; *(u32x2*)(p + 64 + 4 * sub) = w2;
            }
        }
    }
}

constexpr int N_ATT_ITEMS = 64 + 2048;
__device__ __forceinline__ void attn_phase(const Params& P, LAS unsigned char* lds, int cidx, const int wv_) {
    int tid_; asm volatile("v_mbcnt_lo_u32_b32 %0, -1, 0\n\tv_mbcnt_hi_u32_b32 %0, -1, %0" : "=v"(tid_)); tid_ += 64 * wv_;
    const int tid = tid_, lane = tid & 63, wid = __builtin_amdgcn_readfirstlane(tid >> 6), l32 = lane & 31, hh = lane >> 5;
    unsigned char* ws = P.ws;
    const bf16_t* QR = (const bf16_t*)(ws + O_QR); const bf16_t* KF = (const bf16_t*)(ws + O_KF); const bf16_t* VT = (const bf16_t*)(ws + O_VT);
    bf16_t* OB = (bf16_t*)(ws + O_OB);
    unsigned* counter = (unsigned*)(ws + O_CTL) + cidx;
    LAS unsigned* slot = (LAS unsigned*)(lds + 45056);
    const int k0key = tid / 12, k0part = tid % 12, k1key = (tid + 512) / 12, k1part = (tid + 512) % 12; const bool has1 = tid < 256;
    const int vdv = tid >> 3, vpart = tid & 7;
    for (;;) {
        __syncthreads();
        if (tid == 0) *slot = atomicAdd(counter, 1u);
        __syncthreads();
        const int item = (int)*slot;
        if (item >= N_ATT_ITEMS) break;
        const bool sample = item < 64;
        int b, h, nt, qrow0, wlim;
        if (sample) { b = item >> 3; h = item & 7; nt = 65; qrow0 = MP + b * 64; wlim = 64; }
        else { const int j = item - 64, qb = 7 - (j >> 8), bh = j & 255; b = bh >> 3; h = bh & 7; nt = 4 * qb + 4; qrow0 = b * 2048 + qb * 256; wlim = 4 * qb + (wid >> 1); }
        const bool wvalid = sample ? (wid < 2) : true;
        bf16x8 qf[6];
        if (wvalid) { const int qrow = qrow0 + 32 * wid + l32; const bf16_t* qp = QR + (size_t)qrow * 768 + h * 96 + 8 * hh;
            u32x4 qraw[6];
#pragma unroll
            for (int ks = 0; ks < 6; ++ks) qraw[ks] = *(const u32x4*)(qp + 16 * ks);
            float qv[6][8];
#pragma unroll
            for (int ks = 0; ks < 6; ++ks) { qv[ks][0] = bflo(qraw[ks].x); qv[ks][1] = bfhi(qraw[ks].x); qv[ks][2] = bflo(qraw[ks].y); qv[ks][3] = bfhi(qraw[ks].y);
                qv[ks][4] = bflo(qraw[ks].z); qv[ks][5] = bfhi(qraw[ks].z); qv[ks][6] = bflo(qraw[ks].w); qv[ks][7] = bfhi(qraw[ks].w); }
            const float pos = pos_of(qrow);
#pragma unroll
            for (int j = 0; j < 8; ++j) { float sn, cs; rope_sc(pos, 8 * hh + j, sn, cs); const float x1 = qv[4][j], x2 = qv[5][j]; qv[4][j] = x1 * cs - x2 * sn; qv[5][j] = x1 * sn + x2 * cs; }
            float ss = 0.f;
#pragma unroll
            for (int ks = 0; ks < 6; ++ks)
#pragma unroll
                for (int j = 0; j < 8; ++j) ss += qv[ks][j] * qv[ks][j];
            ss += __shfl_xor(ss, 32);
            const float rq = rsqrtf(ss * (1.0f / 96.0f) + EPSF) * (0.10206207261596575f * 1.4426950408889634f);
            const float* gqn = P.in[I_GQN];
#pragma unroll
            for (int ks = 0; ks < 6; ++ks) { const f32x4 g0 = *(const f32x4*)(gqn + 16 * ks + 8 * hh), g1 = *(const f32x4*)(gqn + 16 * ks + 8 * hh + 4);
                u32x4 w; w.x = pk2(qv[ks][0] * rq * g0.x, qv[ks][1] * rq * g0.y); w.y = pk2(qv[ks][2] * rq * g0.z, qv[ks][3] * rq * g0.w);
                w.z = pk2(qv[ks][4] * rq * g1.x, qv[ks][5] * rq * g1.y); w.w = pk2(qv[ks][6] * rq * g1.z, qv[ks][7] * rq * g1.w);
                qf[ks] = __builtin_bit_cast(bf16x8, w); } }
        else {
#pragma unroll
            for (int ks = 0; ks < 6; ++ks) qf[ks] = (bf16x8){0, 0, 0, 0, 0, 0, 0, 0}; }
        f32x16 O0, O1;
#pragma unroll
        for (int i = 0; i < 16; ++i) { O0[i] = 0.f; O1[i] = 0.f; }
        float mrun = -1e30f, lrun = 0.f;
        u32x4 kr0, kr1 = {0u, 0u, 0u, 0u}, vr;
#define ATT_TROW(kt) (sample ? ((kt) < 64 ? MT + b * 4096 + (kt) * 64 : MP + b * 64) : b * 2048 + (kt) * 64)
#define ATT_ISSUE(kt) do { const size_t krow = (size_t)ATT_TROW(kt); \
            kr0 = *(const u32x4*)(KF + (krow + k0key) * 768 + h * 96 + k0part * 8); \
            if (has1) kr1 = *(const u32x4*)(KF + (krow + k1key) * 768 + h * 96 + k1part * 8); \
            vr = *(const u32x4*)(VT + (size_t)(h * 64 + vdv) * MKV + krow + vpart * 8); } while (0)
#define ATT_COMMIT(bufi) do { *(LAS u32x4*)(lds + (bufi) * 13312 + k0key * 208 + k0part * 16) = kr0; \
            if (has1) *(LAS u32x4*)(lds + (bufi) * 13312 + k1key * 208 + k1part * 16) = kr1; \
            *(LAS u32x4*)(lds + 26624 + (bufi) * 9216 + vdv * 144 + vpart * 16) = vr; } while (0)
        ATT_ISSUE(0); ATT_COMMIT(0);
        __syncthreads();
        for (int kt = 0; kt < nt; ++kt) {
            const int buf = kt & 1;
            if (kt + 1 < nt) ATT_ISSUE(kt + 1);
            if (wvalid && kt <= wlim) {
                const LAS unsigned char* kb = lds + buf * 13312 + l32 * 208 + hh * 16;
                const LAS unsigned char* vb = lds + 26624 + buf * 9216 + l32 * 144 + hh * 8;
                f32x16 S0, S1;
#pragma unroll
                for (int i = 0; i < 16; ++i) { S0[i] = 0.f; S1[i] = 0.f; }
#pragma unroll
                for (int ks = 0; ks < 6; ++ks) {
                    const bf16x8 a0 = *(const LAS bf16x8*)(kb + ks * 32), a1 = *(const LAS bf16x8*)(kb + 32 * 208 + ks * 32);
                    S0 = __builtin_amdgcn_mfma_f32_32x32x16_bf16(a0, qf[ks], S0, 0, 0, 0);
                    S1 = __builtin_amdgcn_mfma_f32_32x32x16_bf16(a1, qf[ks], S1, 0, 0, 0);
                }
                float mx = S0[0];
#pragma unroll
                for (int i = 1; i < 16; ++i) mx = fmaxf(mx, S0[i]);
#pragma unroll
                for (int i = 0; i < 16; ++i) mx = fmaxf(mx, S1[i]);
                mx = fmaxf(mx, __shfl_xor(mx, 32));
                const float mnew = fmaxf(mrun, mx), alpha = fast_exp2(mrun - mnew); mrun = mnew;
                float ps = 0.f;
#pragma unroll
                for (int i = 0; i < 16; ++i) { S0[i] = fast_exp2(S0[i] - mnew); ps += S0[i]; }
#pragma unroll
                for (int i = 0; i < 16; ++i) { S1[i] = fast_exp2(S1[i] - mnew); ps += S1[i]; }
                lrun = lrun * alpha + ps;
#pragma unroll
                for (int i = 0; i < 16; ++i) { O0[i] *= alpha; O1[i] *= alpha; }
#pragma unroll
                for (int kk = 0; kk < 4; ++kk) {
                    u32x4 pw;
                    if (kk == 0) { pw.x = pk2(S0[0], S0[1]); pw.y = pk2(S0[2], S0[3]); pw.z = pk2(S0[4], S0[5]); pw.w = pk2(S0[6], S0[7]); }
                    else if (kk == 1) { pw.x = pk2(S0[8], S0[9]); pw.y = pk2(S0[10], S0[11]); pw.z = pk2(S0[12], S0[13]); pw.w = pk2(S0[14], S0[15]); }
                    else if (kk == 2) { pw.x = pk2(S1[0], S1[1]); pw.y = pk2(S1[2], S1[3]); pw.z = pk2(S1[4], S1[5]); pw.w = pk2(S1[6], S1[7]); }
                    else { pw.x = pk2(S1[8], S1[9]); pw.y = pk2(S1[10], S1[11]); pw.z = pk2(S1[12], S1[13]); pw.w = pk2(S1[14], S1[15]); }
                    const bf16x8 pb = __builtin_bit_cast(bf16x8, pw);
                    const u32x2 lo0 = *(const LAS u32x2*)(vb + kk * 32), hi0 = *(const LAS u32x2*)(vb + kk * 32 + 16);
                    const u32x2 lo1 = *(const LAS u32x2*)(vb + 32 * 144 + kk * 32), hi1 = *(const LAS u32x2*)(vb + 32 * 144 + kk * 32 + 16);
                    const u32x4 va0 = {lo0.x, lo0.y, hi0.x, hi0.y}, va1 = {lo1.x, lo1.y, hi1.x, hi1.y};
                    O0 = __builtin_amdgcn_mfma_f32_32x32x16_bf16(__builtin_bit_cast(bf16x8, va0), pb, O0, 0, 0, 0);
                    O1 = __builtin_amdgcn_mfma_f32_32x32x16_bf16(__builtin_bit_cast(bf16x8, va1), pb, O1, 0, 0, 0);
                }
            }
            if (kt + 1 < nt) ATT_COMMIT(buf ^ 1);
            __syncthreads();
        }
#undef ATT_TROW
#undef ATT_ISSUE
#undef ATT_COMMIT
        if (wvalid) {
            const float ltot = lrun + __shfl_xor(lrun, 32); const float inv = 1.0f / ltot;
            bf16_t* op = OB + (size_t)(qrow0 + 32 * wid + l32) * 512 + h * 64 + 4 * hh;
#pragma unroll
            for (int g4 = 0; g4 < 4; ++g4) {
                u32x2 w0; w0.x = pk2(O0[4 * g4] * inv, O0[4 * g4 + 1] * inv); w0.y = pk2(O0[4 * g4 + 2] * inv, O0[4 * g4 + 3] * inv);
                u32x2 w1; w1.x = pk2(O1[4 * g4] * inv, O1[4 * g4 + 1] * inv); w1.y = pk2(O1[4 * g4 + 2] * inv, O1[4 * g4 + 3] * inv);
                *(u32x2*)(op + 8 * g4) = w0; *(u32x2*)(op + 32 + 8 * g4) = w1;
            }
        }
    }
}

#define XB_TMO      128
#define XB_XCNT(j)  (256  + 64 * (j))
#define XB_XSUB(j)  (1280 + 64 * (j))
#define XB_XGEN(j)  (2304 + 64 * (j))
#define XB_TOP      3328
#define XB_TOPGEN   3392
#define XCD_BAR_WORDS 3456
#define XB_SPIN_CAP (1u << 18)

__device__ __forceinline__ unsigned xb_ld(unsigned* p)              { return __hip_atomic_load(p, __ATOMIC_RELAXED, __HIP_MEMORY_SCOPE_AGENT); }
__device__ __forceinline__ unsigned xb_add(unsigned* p, unsigned v) { return __hip_atomic_fetch_add(p, v, __ATOMIC_RELAXED, __HIP_MEMORY_SCOPE_AGENT); }
__device__ __forceinline__ unsigned xb_xcc_id() { return (unsigned)__builtin_amdgcn_s_getreg((3 << 11) | 20) & 0xFu; }
#define XB_SPIN(cond, bar) do { unsigned _sp = 0; while (cond) { __builtin_amdgcn_s_sleep(1); \
    if ((++_sp & 255u) == 0u) { if (xb_ld(&(bar)[XB_TMO])) break; if (_sp > XB_SPIN_CAP) { atomicAdd(&(bar)[XB_TMO], 1u); break; } } } } while (0)

struct XcdBarrier {
    unsigned* bar; unsigned x;
    volatile LAS unsigned* st;
};

__device__ __forceinline__ XcdBarrier xcd_barrier_post(unsigned* bar, volatile LAS unsigned* st) {
    XcdBarrier b; b.bar = bar; b.x = xb_xcc_id(); b.st = st;
    if (threadIdx.x == 0) (void)xb_add(&bar[XB_XCNT(b.x)], 1u);
    return b;
}
__device__ __forceinline__ void xcd_barrier_complete(unsigned* bar, unsigned x, unsigned& nloc, unsigned& nx) {
    const unsigned G = gridDim.x * gridDim.y * gridDim.z;
    unsigned sum, cnt, mine, sp = 0u;
    for (;;) {
        sum = 0u; cnt = 0u; mine = 0u;
#pragma unroll
        for (unsigned j = 0; j < 16; ++j) { const unsigned c = xb_ld(&bar[XB_XCNT(j)]); sum += c; cnt += (c > 0u) ? 1u : 0u; mine = (j == x) ? c : mine; }
        if (sum == G) break;
        __builtin_amdgcn_s_sleep(1);
        if ((++sp & 255u) == 0u) { if (xb_ld(&bar[XB_TMO])) break; if (sp > XB_SPIN_CAP) { atomicAdd(&bar[XB_TMO], 1u); break; } }
    }
    nloc = mine > 0u ? mine : 1u; nx = cnt > 0u ? cnt : 1u;
}

__device__ __forceinline__ void xcd_barrier(const XcdBarrier& b) {
    asm volatile("s_waitcnt vmcnt(0)" ::: "memory");
    __syncthreads();
    if (threadIdx.x == 0) {
        unsigned* bar = b.bar;
        __builtin_amdgcn_s_waitcnt(0);
        unsigned nloc = b.st[0], nx = b.st[1];
        if (nloc == 0u) { xcd_barrier_complete(bar, b.x, nloc, nx); b.st[0] = nloc; b.st[1] = nx; }
        const unsigned old = xb_add(&bar[XB_XSUB(b.x)], 1u);
        const unsigned gen = old / nloc;
        if (old + 1u == (gen + 1u) * nloc) {
            __builtin_amdgcn_fence(__ATOMIC_RELEASE, "agent");
            asm volatile("s_waitcnt vmcnt(0)" ::: "memory");
            const unsigned og = xb_add(&bar[XB_TOP], 1u);
            const unsigned tg = og / nx;
            if (og + 1u == (tg + 1u) * nx) xb_add(&bar[XB_TOPGEN], 1u);
            else XB_SPIN(xb_ld(&bar[XB_TOPGEN]) == tg, bar);
            __builtin_amdgcn_fence(__ATOMIC_ACQUIRE, "agent");
            xb_add(&bar[XB_XGEN(b.x)], 1u);
            asm volatile("s_waitcnt vmcnt(0)" ::: "memory");
        } else {
            XB_SPIN(xb_ld(&bar[XB_XGEN(b.x)]) == gen, bar);
            __builtin_amdgcn_fence(__ATOMIC_ACQUIRE, "agent");
            asm volatile("s_waitcnt vmcnt(0)" ::: "memory");
        }
    }
    __syncthreads();
}


__global__ void __launch_bounds__(512, 2) mk_forward(Params P) {
    extern __shared__ __attribute__((aligned(16))) unsigned char lds_raw[];
    LAS unsigned char* lds = (LAS unsigned char*)lds_raw;
    cg::grid_group grid = cg::this_grid();
    const int wv_ = __builtin_amdgcn_readfirstlane((int)(threadIdx.x >> 6));
    volatile LAS unsigned* xb_st = (volatile LAS unsigned*)(lds + 131072);
    if (threadIdx.x < 4) xb_st[threadIdx.x] = 0u;
    __syncthreads();
    const XcdBarrier xb = xcd_barrier_post((unsigned*)(P.ws + O_BAR), xb_st);
    unsigned char* ws = P.ws;
    float* MODv = (float*)(ws + O_MOD);
    float* Y = P.out + OUT_Y;
    constexpr int NPROG = NSTEPS + (PROBE_DUP >= 0 ? 1 : 0);
    for (int si = P.ph_lo; si < NPROG; ++si) {
        const int step = (PROBE_DUP >= 0 && si > PROBE_DUP) ? si - 1 : si;
        const bool rerun = (PROBE_DUP >= 0 && si == PROBE_DUP + 1);
        bool is_gemm = false, sync_after = true;
        pg8::Gemm g; g.A = nullptr; g.Bt = nullptr; g.M = 0; g.N = 0; g.K = 0; g.lda = 0; g.ldb = 0;
        Epi E; E.mode = EM_PLAIN; E.sub = 0; E.gidx = 0; E.row_off = 0; E.coef = 1.0f; E.ws = ws; E.Y = Y; E.xp = P.in[I_XP]; E.xs = P.in[I_XS]; E.bgate = P.in[I_BGATE];
        switch (step) {
        case 0: prep_phase(P, lds, wv_); break;
        case 1: modulate_phase(P.in[I_XP], P.in[I_XS], P.in[I_GFFN1], MODv, 0, 1, (bf16_t*)(ws + O_H), wv_); break;
        case 2: is_gemm = true; g.A = (const bf16_t*)(ws + O_H); g.lda = 1024; g.Bt = (const bf16_t*)(ws + O_W1U); g.M = MT; g.N = 2 * DFF; g.K = 1024; E.mode = EM_SWIGLU; break;
        case 3: is_gemm = true; g.A = (const bf16_t*)(ws + O_ACT); g.lda = DFF; g.Bt = (const bf16_t*)(ws + O_W1D); g.M = MP; g.N = 1024; g.K = DFF; E.mode = EM_RESID; E.gidx = 2; E.coef = 0.5f; break;
        case 4:
            if (blockIdx.x < 8) { is_gemm = true; g.A = (const bf16_t*)(ws + O_ACT) + (size_t)MP * DFF; g.lda = DFF; g.Bt = (const bf16_t*)(ws + O_W1D); g.M = MS; g.N = 1024; g.K = DFF; E.mode = EM_RESID; E.gidx = 2; E.coef = 0.5f; E.row_off = MP; }
            else modulate16_phase((const bf16_t*)Y, P.in[I_GMIX], MODv, 3, 4, (bf16_t*)(ws + O_H), 0, MP, 8, wv_);
            break;
        case 5: modulate16_phase((const bf16_t*)Y, P.in[I_GMIX], MODv, 3, 4, (bf16_t*)(ws + O_H), MP, MT, 0, wv_); xcd_barrier(xb);
            is_gemm = true; g.A = (const bf16_t*)(ws + O_H); g.lda = 1024; g.Bt = (const bf16_t*)(ws + O_WIN); g.M = MT; g.N = NINP; g.K = 1024; E.mode = EM_WIN; break;
        case 6: rowpost_phase(P, wv_); break;
        case 7: gmlp_phase(P, lds, wv_); break;
        case 8: is_gemm = true; sync_after = false; g.A = (const bf16_t*)(ws + O_ZS); g.lda = 768; g.Bt = (const bf16_t*)(ws + O_WUQ); g.M = MT; g.N = 768; g.K = 384; E.mode = EM_PLAIN; E.sub = 0; break;
        case 9: is_gemm = true; sync_after = false; g.A = (const bf16_t*)(ws + O_CKV); g.lda = 256; g.Bt = (const bf16_t*)(ws + O_WUK); g.M = MKV; g.N = 512; g.K = 256; E.mode = EM_KNOPE; E.bgate = P.in[I_GKN]; break;
        case 10: is_gemm = true; g.A = (const bf16_t*)(ws + O_WUV); g.lda = 256; g.Bt = (const bf16_t*)(ws + O_CKV); g.M = 512; g.N = MKV; g.K = 256; E.mode = EM_PLAIN; E.sub = 1; break;
        case 11: sync_after = false; break;
        case 12: if (blockIdx.x < 8 && !rerun) { is_gemm = true; g.A = (const bf16_t*)(ws + O_OA) + (size_t)MP * 1024; g.lda = 1024; g.Bt = (const bf16_t*)(ws + O_WBA); g.M = MS; g.N = 1024; g.K = 1024; E.mode = EM_BRA; E.row_off = MP; } break;
        case 13: is_gemm = true; g.A = (const bf16_t*)(ws + O_OA); g.lda = 1024; g.Bt = (const bf16_t*)(ws + O_WBA); g.M = MP; g.N = 1024; g.K = 1024; E.mode = EM_BRA; break;
        case 14: is_gemm = true; g.A = (const bf16_t*)(ws + O_OB); g.lda = 512; g.Bt = (const bf16_t*)(ws + O_WBB); g.M = MT; g.N = 1024; g.K = 512; E.mode = EM_BRB; break;
        case 15: is_gemm = true; g.A = (const bf16_t*)(ws + O_MG); g.lda = 1024; g.Bt = (const bf16_t*)(ws + O_WO); g.M = MP; g.N = 1024; g.K = 1024; E.mode = EM_RESID_B2B; E.gidx = 5; E.coef = 1.0f; break;
        case 16:
            if (blockIdx.x < 8) { is_gemm = true; g.A = (const bf16_t*)(ws + O_MG) + (size_t)MP * 1024; g.lda = 1024; g.Bt = (const bf16_t*)(ws + O_WO); g.M = MS; g.N = 1024; g.K = 1024; E.mode = EM_RESID_B2B; E.gidx = 5; E.coef = 1.0f; E.row_off = MP; }
            else modulate16_phase((const bf16_t*)(ws + O_X2), P.in[I_GFFN2], MODv, 6, 7, (bf16_t*)(ws + O_H), 0, MP, 8, wv_);
            break;
        case 17: modulate16_phase((const bf16_t*)(ws + O_X2), P.in[I_GFFN2], MODv, 6, 7, (bf16_t*)(ws + O_H), MP, MT, 0, wv_);
            {
                const bf16_t* x2s = (const bf16_t*)(ws + O_X2) + (size_t)MP * DM; float* ys = Y + (size_t)MP * DM;
                int t17_; asm volatile("v_mbcnt_lo_u32_b32 %0, -1, 0\n\tv_mbcnt_hi_u32_b32 %0, -1, %0" : "=v"(t17_)); t17_ += 64 * wv_;
                for (size_t i = (size_t)blockIdx.x * 512 + t17_; i < (size_t)MS * DM / 8; i += (size_t)gridDim.x * 512) {
                    const u32x4 w = *(const u32x4*)(x2s + 8 * i);
                    *(f32x4*)(ys + 8 * i) = (f32x4){bflo(w.x), bfhi(w.x), bflo(w.y), bfhi(w.y)}; *(f32x4*)(ys + 8 * i + 4) = (f32x4){bflo(w.z), bfhi(w.z), bflo(w.w), bfhi(w.w)}; }
            }
            xcd_barrier(xb);
            is_gemm = true; g.A = (const bf16_t*)(ws + O_H); g.lda = 1024; g.Bt = (const bf16_t*)(ws + O_W2U); g.M = MT; g.N = 2 * DFF; g.K = 1024; E.mode = EM_SWIGLU; break;
        case 18: is_gemm = true; g.A = (const bf16_t*)(ws + O_ACT); g.lda = DFF; g.Bt = (const bf16_t*)(ws + O_W2D); g.M = MP; g.N = 1024; g.K = DFF; E.mode = EM_RESID_B2F; E.gidx = 8; E.coef = 0.5f; break;
        default: break;
        }
        if (is_gemm) {
            const int npass = (step == 18) ? 2 : 1;
            for (int pass = 0; pass < npass; ++pass) {
                if (g.ldb == 0) g.ldb = g.K;
                int cidx = (int)((blockIdx.x + ((step == 9) ? 64 : (step == 10 ? 128 : 0))) % gridDim.x);
                if (pass == 1) {
                    const int q = (int)blockIdx.x >> 3; const int koff = q == 0 ? 0 : (q == 1 ? 768 : (q == 2 ? 1536 : 2176));
                    g.A = (const bf16_t*)(ws + O_ACT) + (size_t)MP * DFF + koff; g.lda = DFF; g.Bt = (const bf16_t*)(ws + O_W2D) + koff; g.ldb = DFF;
                    g.M = MS; g.N = 1024; g.K = q < 2 ? 768 : 640; E.mode = EM_ATOMIC; E.row_off = MP;
                    cidx = blockIdx.x < 32 ? (int)(blockIdx.x & 7) : (1 << 20);
                }
                pg8::StaticOrder S; S.init(g.M, g.N, (int)gridDim.x, cidx);
#if STAGGER_MODE
                {
                    const unsigned lvl = STAGGER_MODE == 1 ? ((blockIdx.x >> 3) & 31u) : (blockIdx.x & 7u) * 4u;
                    const unsigned long long ticks = (unsigned long long)lvl * (unsigned)(g.K / 64) * 120ull / 32ull;
                    const unsigned long long t0 = wall_clock64();
                    while (wall_clock64() - t0 < ticks) __builtin_amdgcn_s_sleep(8);
                }
#endif
                pg8::gemm_phase<Epi, pg8::StaticOrder, GEMM_ALIGN_EPI, GEMM_SP2>(lds, g, S, E, wv_);
            }
        }
        if (step == 12) attn_phase(P, lds, rerun ? 1 : 0, wv_);
        if ((sync_after || (PROBE_DUP >= 0 && si == PROBE_DUP)) && si + 1 < NPROG) { if (si == 0) grid.sync(); else xcd_barrier(xb); }
    }
}

extern "C" void kernel_launch(void* const* d_in, const int* in_sizes, int n_in, void* d_out, int out_size, void* d_ws, size_t ws_size, hipStream_t stream) {
    static int grid = 0;
    if (grid == 0) {
        if (n_in != 30 || ws_size < WS_END) { fprintf(stderr, "kernel_launch: unexpected n_in %d or ws_size %zu (< %zu)\n", n_in, ws_size, (size_t)WS_END); grid = -1; return; }
        int dev = 0, cus = 0, per_cu = 0;
        hipGetDevice(&dev);
        hipDeviceGetAttribute(&cus, hipDeviceAttributeMultiprocessorCount, dev);
        if (hipFuncSetAttribute((const void*)mk_forward, hipFuncAttributeMaxDynamicSharedMemorySize, LDS_BYTES) != hipSuccess) fprintf(stderr, "kernel_launch: hipFuncSetAttribute failed\n");
        if (hipOccupancyMaxActiveBlocksPerMultiprocessor(&per_cu, (const void*)mk_forward, 512, LDS_BYTES) != hipSuccess || per_cu < 1) fprintf(stderr, "kernel_launch: occupancy query says %d blocks per CU\n", per_cu);
        (void)hipGetLastError();
        grid = cus > 0 ? cus : 256;
    }
    if (grid < 0) return;
    if (hipMemsetAsync((unsigned char*)d_ws + O_BAR, 0, XCD_BAR_WORDS * sizeof(unsigned), stream) != hipSuccess) { fprintf(stderr, "kernel_launch: memset of the barrier words failed\n"); return; }
    Params p{};
    for (int i = 0; i < 30; ++i) p.in[i] = (const float*)d_in[i];
    p.out = (float*)d_out; p.ws = (unsigned char*)d_ws; p.ph_lo = 0; p.ph_hi = NSTEPS;
    void* args[] = {&p};
    hipError_t e = hipLaunchCooperativeKernel((const void*)mk_forward, dim3(grid), dim3(512), args, LDS_BYTES, stream);
    if (e != hipSuccess) fprintf(stderr, "kernel_launch: cooperative launch failed: %s (grid %d)\n", hipGetErrorString(e), grid);
}
```

```cpp
#include <hip/hip_runtime.h>
#include <hip/hip_cooperative_groups.h>
#include <cstdio>
#include <cstdint>
namespace cg = cooperative_groups;

namespace pg8 {
#define PG8_LAS __attribute__((address_space(3)))
typedef unsigned short bf16_t;
typedef short bf16x8 __attribute__((ext_vector_type(8)));
typedef float f32x4 __attribute__((ext_vector_type(4)));
typedef unsigned u32x4 __attribute__((ext_vector_type(4)));
constexpr int BM = 256, BK = 64, HALF = 128, HTB = HALF * BK * 2  , STAGE_BYTES = 8 * HTB, NXCD = 8, WGM = 8;

__host__ __device__ __forceinline__ int lds_byte(int r, int c) { const int st = (r >> 4) * 2 + (c >> 5), rr = r & 15, cc = c & 31, ob = rr * 64 + cc * 2; return st * 1024 + (ob ^ (((ob >> 9) & 1) << 5)); }
__host__ __device__ __forceinline__ void stage_rc(int b, int& R, int& C) { const int st = b / 1024, sb = b % 1024, swz = sb ^ (((sb >> 9) & 1) << 5); R = (st >> 1) * 16 + swz / 64; C = (st & 1) * 32 + (swz % 64) / 2; }
__host__ __device__ __forceinline__ int perm32(int rho) { const int n = rho >> 4, i = rho & 15; return 8 * (i >> 2) + 4 * n + (i & 3); }

struct Unit { int pm, pn; };
struct Gemm { const bf16_t* A; const bf16_t* Bt; int M, N, K, lda, ldb; };

struct StaticOrder {
    int nM, nN, nwg, G, c;
    __host__ __device__ void init(int M, int N, int G_, int c_) { nM = M / BM; nN = N / BM; nwg = nM * nN; G = G_; c = c_; }
    __host__ __device__ bool next(int i, Unit& u) const {
        const long L = (long)i * G + c; if (L >= nwg) return false;
        int wgid = (int)L; { const int q = nwg / NXCD, r = nwg % NXCD, xcd = wgid % NXCD, off = wgid / NXCD; wgid = (xcd < r ? xcd * (q + 1) : r * (q + 1) + (xcd - r) * q) + off; }
        const int nig = WGM * nN, gid = wgid / nig, fm = gid * WGM, gsz = (nM - fm) < WGM ? (nM - fm) : WGM;
        u.pm = fm + ((wgid % nig) % gsz); u.pn = (wgid % nig) / gsz; return true;
    }
    __device__ __forceinline__ void a_ready(const Unit&) const {}
    __device__ __forceinline__ void done(const Unit&) const {}
};
__device__ __forceinline__ unsigned cvt_pk_bf16(float lo, float hi) { unsigned r; asm volatile("v_cvt_pk_bf16_f32 %0, %1, %2" : "=v"(r) : "v"(lo), "v"(hi)); return r; }

template <class Epi, class Sched, bool ALIGN_EPI = false, bool SP2 = false>
__device__ __forceinline__ void gemm_phase(PG8_LAS unsigned char* lds, const Gemm g, const Sched& S, const Epi& E, const int wv_) {
    int tid_; asm volatile("v_mbcnt_lo_u32_b32 %0, -1, 0\n\tv_mbcnt_hi_u32_b32 %0, -1, %0" : "=v"(tid_)); tid_ += 64 * wv_;
    const int tid = tid_, wid = __builtin_amdgcn_readfirstlane(tid >> 6), lane = tid & 63, wr = wid >> 2, wc = wid & 3, fr = lane & 15, fq = lane >> 4;
    const int K = g.K, nt = K / BK;
    unsigned voffA[2], voffB[2];
#pragma unroll
    for (int i = 0; i < 2; ++i) { int R, C; stage_rc(tid * 16 + i * 8192, R, C); const int Rb = Epi::PERM ? ((R & ~31) + perm32(R & 31)) : R;
        voffA[i] = (unsigned)(R * g.lda + C) * 2u; voffB[i] = (unsigned)(Rb * g.ldb + C) * 2u; }
    const size_t kstep = (size_t)(BK * 2);
    const size_t hstep = (size_t)HALF * g.ldb * 2, hstepA = (size_t)HALF * g.lda * 2;
    const size_t tstep = 2 * hstep, tstepA = 2 * hstepA;
    const unsigned ldsw = (unsigned)wid * 1024u;
    const int aoff = lds_byte(wr * 64 + fr, fq * 8), boff = lds_byte(wc * 32 + fr, fq * 8);
#define PG8_SA(b, h) (((b) * 2 + (h)) * HTB)
#define PG8_SB(b, h) ((4 + (b) * 2 + (h)) * HTB)
#define PG8_STAGE(bufoff, gbase, voff) do { _Pragma("unroll") for (int _i = 0; _i < 2; ++_i) \
        __builtin_amdgcn_global_load_lds((const unsigned*)((const char*)(gbase) + (voff)[_i]), (PG8_LAS unsigned*)(lds + (bufoff) + ldsw + _i * 8192), 16, 0, 0); } while (0)
#define PG8_LDA(dst, b, h) do { _Pragma("unroll") for (int m = 0; m < 4; ++m) _Pragma("unroll") for (int k = 0; k < 2; ++k) dst[m][k] = *(const PG8_LAS bf16x8*)(lds + PG8_SA(b, h) + aoff + m * 2048 + k * 1024); } while (0)
#define PG8_LDB(dst, b, h) do { _Pragma("unroll") for (int n = 0; n < 2; ++n) _Pragma("unroll") for (int k = 0; k < 2; ++k) dst[n][k] = *(const PG8_LAS bf16x8*)(lds + PG8_SB(b, h) + boff + n * 2048 + k * 1024); } while (0)
#define PG8_MMA(ai, bj, At, Bt) do { __builtin_amdgcn_s_setprio(1); _Pragma("unroll") for (int m = 0; m < 4; ++m) _Pragma("unroll") for (int n = 0; n < 2; ++n) _Pragma("unroll") for (int k = 0; k < 2; ++k) \
        acc[ai][bj][m][n] = __builtin_amdgcn_mfma_f32_16x16x32_bf16(Bt[n][k], At[m][k], acc[ai][bj][m][n], 0, 0, 0); __builtin_amdgcn_s_setprio(0); } while (0)
#define PG8_WAIT_V(n) asm volatile("s_waitcnt vmcnt(" #n ")" ::: "memory")
#define PG8_WAIT_L(n) asm volatile("s_waitcnt lgkmcnt(" #n ")" ::: "memory")
#define PG8_BAR __builtin_amdgcn_s_barrier()
#define PG8_SCHED __builtin_amdgcn_sched_barrier(0)
    Unit cur, nxt; int ui = 0;
    if (!S.next(0, cur)) return;
    f32x4 acc[2][2][4][2];
#pragma unroll
    for (int a = 0; a < 2; ++a)
#pragma unroll
        for (int b = 0; b < 2; ++b)
#pragma unroll
            for (int m = 0; m < 4; ++m)
#pragma unroll
                for (int n = 0; n < 2; ++n) acc[a][b][m][n] = (f32x4){0.f, 0.f, 0.f, 0.f};
    bf16x8 At[4][2], B0[2][2], B1[2][2];
    const char* cA = (const char*)g.A + (size_t)cur.pm * tstepA; const char* cB = (const char*)g.Bt + (size_t)cur.pn * tstep;
    S.a_ready(cur);
    if constexpr (SP2) {
        PG8_STAGE(PG8_SB(0, 0), cB, voffB); PG8_STAGE(PG8_SB(0, 1), cB + hstep, voffB); PG8_STAGE(PG8_SA(0, 0), cA, voffA); PG8_STAGE(PG8_SA(0, 1), cA + hstepA, voffA);
        if (wr == 1) PG8_BAR;
        PG8_WAIT_V(2); PG8_BAR;
        PG8_STAGE(PG8_SB(1, 0), cB + kstep, voffB); PG8_STAGE(PG8_SA(1, 0), cA + kstep, voffA); PG8_STAGE(PG8_SB(1, 1), cB + hstep + kstep, voffB);
        PG8_WAIT_V(6); PG8_BAR;
    } else {
        PG8_STAGE(PG8_SB(0, 0), cB, voffB); PG8_STAGE(PG8_SA(0, 0), cA, voffA); PG8_STAGE(PG8_SB(0, 1), cB + hstep, voffB); PG8_STAGE(PG8_SA(0, 1), cA + hstepA, voffA);
        if (wr == 1) PG8_BAR;
        PG8_WAIT_V(4); PG8_BAR;
        PG8_STAGE(PG8_SB(1, 0), cB + kstep, voffB); PG8_STAGE(PG8_SA(1, 0), cA + kstep, voffA); PG8_STAGE(PG8_SB(1, 1), cB + hstep + kstep, voffB);
        PG8_WAIT_V(6); PG8_BAR;
    }
    for (;;) {
        const bool has_next = S.next(ui + 1, nxt);
        const char* nA = has_next ? (const char*)g.A + (size_t)nxt.pm * tstepA : cA; const char* nB = has_next ? (const char*)g.Bt + (size_t)nxt.pn * tstep : cB;
        for (int t = 0; t < nt; t += 2) {
            const bool last = (t == nt - 2);
            const char* a1 = cA + (size_t)(t + 1) * kstep;
            const char* a2 = last ? nA : cA + (size_t)(t + 2) * kstep; const char* b2 = last ? nB : cB + (size_t)(t + 2) * kstep;
            const char* a3 = a2 + kstep; const char* b3 = b2 + kstep;
            if (last && has_next) S.a_ready(nxt);
            if constexpr (SP2) {
            PG8_LDB(B0, 0, 0); PG8_LDB(B1, 0, 1); PG8_SCHED; PG8_LDA(At, 0, 0); PG8_STAGE(PG8_SA(1, 1), a1 + hstepA, voffA);
            PG8_WAIT_V(8); PG8_WAIT_L(0); PG8_BAR; PG8_MMA(0, 0, At, B0); PG8_MMA(0, 1, At, B1); PG8_BAR; PG8_SCHED;
            PG8_LDA(At, 0, 1); PG8_STAGE(PG8_SB(0, 0), b2, voffB); PG8_STAGE(PG8_SB(0, 1), b2 + hstep, voffB); PG8_STAGE(PG8_SA(0, 0), a2, voffA);
            PG8_WAIT_V(8); PG8_WAIT_L(0); PG8_BAR; PG8_MMA(1, 0, At, B0); PG8_MMA(1, 1, At, B1); PG8_BAR; PG8_SCHED;
            PG8_LDB(B0, 1, 0); PG8_LDB(B1, 1, 1); PG8_SCHED; PG8_LDA(At, 1, 0); PG8_STAGE(PG8_SA(0, 1), a2 + hstepA, voffA);
            PG8_WAIT_V(8); PG8_WAIT_L(0); PG8_BAR; PG8_MMA(0, 0, At, B0); PG8_MMA(0, 1, At, B1); PG8_BAR; PG8_SCHED;
            PG8_LDA(At, 1, 1); PG8_STAGE(PG8_SB(1, 0), b3, voffB); PG8_STAGE(PG8_SB(1, 1), b3 + hstep, voffB); PG8_STAGE(PG8_SA(1, 0), a3, voffA);
            PG8_WAIT_V(8); PG8_WAIT_L(0); PG8_BAR; PG8_MMA(1, 0, At, B0); PG8_MMA(1, 1, At, B1); PG8_BAR; PG8_SCHED;
            } else {
            PG8_LDB(B0, 0, 0); PG8_SCHED; PG8_LDA(At, 0, 0); PG8_STAGE(PG8_SA(1, 1), a1 + hstepA, voffA);
            PG8_WAIT_L(8); PG8_BAR; PG8_WAIT_L(0); PG8_MMA(0, 0, At, B0); PG8_BAR; PG8_SCHED;
            PG8_LDB(B1, 0, 1); PG8_STAGE(PG8_SB(0, 0), b2, voffB);
            PG8_BAR; PG8_WAIT_L(0); PG8_MMA(0, 1, At, B1); PG8_BAR;
            PG8_LDA(At, 0, 1); PG8_STAGE(PG8_SA(0, 0), a2, voffA);
            PG8_BAR; PG8_WAIT_L(0); PG8_MMA(1, 0, At, B0); PG8_BAR; PG8_SCHED;
            PG8_STAGE(PG8_SB(0, 1), b2 + hstep, voffB);
            PG8_WAIT_V(6); PG8_BAR; PG8_MMA(1, 1, At, B1); PG8_BAR;
            PG8_LDB(B0, 1, 0); PG8_SCHED; PG8_LDA(At, 1, 0); PG8_STAGE(PG8_SA(0, 1), a2 + hstepA, voffA);
            PG8_WAIT_L(8); PG8_BAR; PG8_WAIT_L(0); PG8_MMA(0, 0, At, B0); PG8_BAR; PG8_SCHED;
            PG8_LDB(B1, 1, 1); PG8_STAGE(PG8_SB(1, 0), b3, voffB);
            PG8_BAR; PG8_WAIT_L(0); PG8_MMA(0, 1, At, B1); PG8_BAR;
            PG8_LDA(At, 1, 1); PG8_STAGE(PG8_SA(1, 0), a3, voffA);
            PG8_BAR; PG8_WAIT_L(0); PG8_MMA(1, 0, At, B0); PG8_BAR; PG8_SCHED;
            PG8_STAGE(PG8_SB(1, 1), b3 + hstep, voffB);
            PG8_WAIT_V(6); PG8_BAR; PG8_MMA(1, 1, At, B1); PG8_BAR;
            }
        }
        if constexpr (ALIGN_EPI) { if (wr == 0) PG8_BAR; }
        if constexpr (!Epi::AFTER_DRAIN) { E(acc, cur, wr, wc, fr, fq); S.done(cur); }
        if (!has_next) break;
#pragma unroll
        for (int a = 0; a < 2; ++a)
#pragma unroll
            for (int b = 0; b < 2; ++b)
#pragma unroll
                for (int m = 0; m < 4; ++m)
#pragma unroll
                    for (int n = 0; n < 2; ++n) acc[a][b][m][n] = (f32x4){0.f, 0.f, 0.f, 0.f};
        cur = nxt; cA = nA; cB = nB; ++ui;
        if constexpr (ALIGN_EPI) { if (wr == 1) PG8_BAR; }
    }
    PG8_WAIT_V(0);
    if constexpr (!ALIGN_EPI) { if (wr == 0) PG8_BAR; }
    PG8_BAR;
    if constexpr (Epi::AFTER_DRAIN) { E.fused(acc, cur, wr, wc, fr, fq, lds, wid, lane); S.done(cur); }
#undef PG8_SA
#undef PG8_SB
#undef PG8_STAGE
#undef PG8_LDA
#undef PG8_LDB
#undef PG8_MMA
#undef PG8_WAIT_V
#undef PG8_WAIT_L
#undef PG8_BAR
#undef PG8_SCHED
}
}

#define LAS __attribute__((address_space(3)))
using pg8::bf16_t; using pg8::bf16x8; using pg8::f32x4; using pg8::u32x4;
typedef float f32x16 __attribute__((ext_vector_type(16)));
typedef float f32x2 __attribute__((ext_vector_type(2)));
typedef unsigned u32x2 __attribute__((ext_vector_type(2)));
typedef __bf16 bf16x2v __attribute__((ext_vector_type(2)));

constexpr int DM = 1024, MP = 65536, MS = 512, MT = MP + MS  , MC = 32768, MKV = MT + MC  ;
constexpr int DFF = 2816, NINP = 4864, NMODC = 9216;
constexpr float EPSF = 1e-6f;
constexpr int LDS_BYTES = 131072 + 256;
constexpr int NSTEPS = 19;
#define STAGGER_MODE 0
#define GEMM_ALIGN_EPI true
#define GEMM_SP2 true
#define PROBE_DUP -1

constexpr size_t al256(size_t x) { return (x + 255) & ~(size_t)255; }
constexpr size_t O_CTL = 0;
constexpr size_t O_MOD = 256;
constexpr size_t O_RV  = al256(O_MOD + (size_t)40 * NMODC * 4);
constexpr size_t O_W1U = al256(O_RV + (size_t)MT * 4);
constexpr size_t O_W1D = O_W1U + (size_t)2 * DFF * DM * 2;
constexpr size_t O_W2U = O_W1D + (size_t)DM * DFF * 2;
constexpr size_t O_W2D = O_W2U + (size_t)2 * DFF * DM * 2;
constexpr size_t O_WIN = O_W2D + (size_t)DM * DFF * 2;
constexpr size_t O_WUQ = O_WIN + (size_t)NINP * DM * 2;
constexpr size_t O_WUK = O_WUQ + (size_t)768 * 384 * 2;
constexpr size_t O_WUV = O_WUK + (size_t)512 * 256 * 2;
constexpr size_t O_WBA = O_WUV + (size_t)512 * 256 * 2;
constexpr size_t O_WBB = O_WBA + (size_t)1024 * 1024 * 2;
constexpr size_t O_WO  = O_WBB + (size_t)1024 * 512 * 2;
constexpr size_t O_WS  = O_WO + (size_t)1024 * 1024 * 2;
constexpr size_t O_H   = al256(O_WS + (size_t)8 * 128 * 128 * 2);
constexpr size_t O_ZA  = O_H + (size_t)MT * 1024 * 2;
constexpr size_t O_G   = O_ZA + (size_t)MT * 2048 * 2;
constexpr size_t O_ZS  = O_G + (size_t)MT * 2048 * 2;
constexpr size_t O_KF  = O_ZS + (size_t)MT * 768 * 2;
constexpr size_t O_CKV = O_KF + (size_t)MKV * 768 * 2;
constexpr size_t O_KR  = O_CKV + (size_t)MKV * 256 * 2;
constexpr size_t O_KRSS = O_KR + (size_t)MKV * 32 * 4;
constexpr size_t O_BAR = al256(O_KRSS + (size_t)MKV * 4);
constexpr size_t O_T2 = O_BAR + 16384;
constexpr size_t WS_END = O_T2 + (size_t)MS * 1024 * 2;
constexpr size_t O_ACT = O_ZA;
constexpr size_t O_QR  = O_ZA;
constexpr size_t O_VT  = O_ZA + (size_t)MT * 768 * 2;
constexpr size_t O_T   = O_ZA;
constexpr size_t O_MG  = O_ZA + (size_t)MT * 1024 * 2;
constexpr size_t O_OB  = O_ZS;
constexpr size_t O_X2  = O_ZS;
constexpr size_t O_OA  = O_H;
static_assert((size_t)MT * 768 * 2 + (size_t)512 * MKV * 2 <= (size_t)MT * 2048 * 2, "QR+VT must fit in ZA");
static_assert((size_t)MT * DFF * 2 <= (size_t)MT * 4096 * 2, "ACT must fit in ZA+G");

constexpr size_t OUT_Y = 0;
constexpr size_t OUT_CKVP = (size_t)MT * 1024;
constexpr size_t OUT_KRP = OUT_CKVP + (size_t)MP * 256;
constexpr size_t OUT_CKVS = OUT_KRP + (size_t)MP * 32;
constexpr size_t OUT_KRS = OUT_CKVS + (size_t)MS * 256;
constexpr size_t OUT_GV = OUT_KRS + (size_t)MS * 32;

enum { I_XP = 0, I_XS, I_CP, I_CS, I_CCKV, I_CKR, I_WMOD, I_BMOD, I_GFFN1, I_W1U, I_W1D, I_GMIX, I_WIN, I_GGV, I_GWS, I_GB, I_GQL, I_WUQ, I_GKVL, I_WUK, I_WUV,
       I_GQN, I_GKN, I_BGATE, I_WBA, I_WBB, I_WO, I_GFFN2, I_W2U, I_W2D };

struct Params {
    const float* in[30];
    float* out;
    unsigned char* ws;
    int ph_lo, ph_hi;
};

__device__ __forceinline__ unsigned pk2(float lo, float hi) { f32x2 v = {lo, hi}; bf16x2v b = __builtin_convertvector(v, bf16x2v); return __builtin_bit_cast(unsigned, b); }
__device__ __forceinline__ float bflo(unsigned w) { return __uint_as_float(w << 16); }
__device__ __forceinline__ float bfhi(unsigned w) { return __uint_as_float(w & 0xffff0000u); }
__device__ __forceinline__ float bf2f(bf16_t b) { return __uint_as_float((unsigned)b << 16); }
__device__ __forceinline__ bf16_t f2bf(float x) { return (bf16_t)(pk2(x, 0.f) & 0xffffu); }
__device__ __forceinline__ float wave_sum(float v) {
#pragma unroll
    for (int o = 1; o < 64; o <<= 1) v += __shfl_xor(v, o);
    return v;
}
__device__ __forceinline__ float fast_exp2(float x) { return __builtin_amdgcn_exp2f(x); }
__device__ __forceinline__ float sigmoidf_(float x) { return __builtin_amdgcn_rcpf(1.0f + fast_exp2(-1.4426950408889634f * x)); }
__device__ __forceinline__ float siluf_(float x) { return x * sigmoidf_(x); }
__device__ __forceinline__ float gelu_tanh(float x) { const float y = 1.5957691216057308f * (x + 0.044715f * x * x * x); return x * sigmoidf_(y); }
__device__ __forceinline__ int batch_of(int row) { return row < MP ? (row >> 11) : 32 + ((row - MP) >> 6); }
__device__ __forceinline__ float pos_of(int row) { return row < MP ? (float)(row & 2047) : (float)(4096 + ((row - MP) & 63)); }
__device__ __forceinline__ void rope_sc(float pos, int i, float& sn, float& cs) {
    const float freq = exp2f(-(float)i * (13.287712379549449f / 16.0f));
    const float ang = pos * freq;
    float rev = ang * 0.15915494309189535f; rev = rev - floorf(rev);
    sn = __builtin_amdgcn_sinf(rev); cs = __builtin_amdgcn_cosf(rev);
}

enum { EM_SWIGLU = 0, EM_RESID, EM_WIN, EM_PLAIN, EM_KNOPE, EM_BRA, EM_BRB, EM_RESID_B2B, EM_RESID_B2F, EM_ATOMIC };
struct Epi {
    static constexpr bool PERM = true, AFTER_DRAIN = false;
    int mode, sub, gidx, row_off; float coef;
    unsigned char* ws; float* Y; const float* xp; const float* xs; const float* bgate;
    __device__ __forceinline__ void operator()(const f32x4 (&acc)[2][2][4][2], const pg8::Unit& u, int wr, int wc, int fr, int fq) const {
        const int row0 = row_off + u.pm * 256 + wr * 64 + fr, cl = wc * 32 + 8 * fq;
        const float* MODv = (const float*)(ws + O_MOD);
        bf16_t* O = (bf16_t*)(ws + (mode == EM_SWIGLU ? O_ACT : mode == EM_KNOPE ? O_KF : mode == EM_BRA ? O_T : mode == EM_BRB ? O_MG : (sub == 0 ? O_QR : O_VT)));
        if (mode == EM_BRA && (row_off + u.pm * 256) >= MP) O = (bf16_t*)(ws + O_T2) - (size_t)MP * 1024;
        const int ldc = sub == 0 ? 768 : MKV;
        const bool srows = (row_off + u.pm * 256) >= MP;
        const bf16_t* G = (const bf16_t*)(ws + O_G); const bf16_t* T = srows ? (const bf16_t*)(ws + O_T2) - (size_t)MP * 1024 : (const bf16_t*)(ws + O_T);
        bf16_t* ZA = (bf16_t*)(ws + O_ZA); bf16_t* Gw = (bf16_t*)(ws + O_G); bf16_t* ZS = (bf16_t*)(ws + O_ZS);
        const bf16_t* xb = (mode == EM_RESID_B2B) ? (const bf16_t*)Y : (const bf16_t*)(ws + O_X2);
        bf16_t* yb = (mode == EM_RESID) ? (bf16_t*)Y : (bf16_t*)(ws + O_X2);
        if (mode == EM_SWIGLU) {
#pragma unroll
            for (int ai = 0; ai < 2; ++ai)
#pragma unroll
                for (int m = 0; m < 4; ++m) {
                    const int r = row0 + ai * 128 + m * 16;
                    float o[8];
#pragma unroll
                    for (int n = 0; n < 2; ++n)
#pragma unroll
                        for (int j = 0; j < 4; ++j) { const float g = acc[ai][0][m][n][j], uu = acc[ai][1][m][n][j]; o[4 * n + j] = siluf_(g) * uu; }
                    u32x4 w; w.x = pk2(o[0], o[1]); w.y = pk2(o[2], o[3]); w.z = pk2(o[4], o[5]); w.w = pk2(o[6], o[7]);
                    *(u32x4*)(O + (size_t)r * DFF + u.pn * 128 + cl) = w;
                }
        } else if (mode == EM_RESID) {
            const int c0 = u.pn * 256 + cl;
#pragma unroll
            for (int ai = 0; ai < 2; ++ai) {
                f32x4 gg[2][2];
                const float* gt = MODv + (size_t)batch_of(row0 + ai * 128) * NMODC + gidx * DM;
#pragma unroll
                for (int bj = 0; bj < 2; ++bj)
#pragma unroll
                    for (int n = 0; n < 2; ++n) gg[bj][n] = *(const f32x4*)(gt + c0 + bj * 128 + 4 * n) * coef;
#pragma unroll
                for (int mh = 0; mh < 2; ++mh) {
                    f32x4 bs[2][2][2];
#pragma unroll
                    for (int mm = 0; mm < 2; ++mm) { const int r = row0 + ai * 128 + (2 * mh + mm) * 16; const float* base = (r < MP) ? xp + (size_t)r * DM : xs + (size_t)(r - MP) * DM;
#pragma unroll
                        for (int bj = 0; bj < 2; ++bj)
#pragma unroll
                            for (int n = 0; n < 2; ++n) bs[mm][bj][n] = *(const f32x4*)(base + c0 + bj * 128 + 4 * n); }
                    asm volatile("" ::: "memory");
#pragma unroll
                    for (int mm = 0; mm < 2; ++mm) { const int m = 2 * mh + mm; const int r = row0 + ai * 128 + m * 16;
#pragma unroll
                        for (int bj = 0; bj < 2; ++bj) {
                            const f32x4 o0 = bs[mm][bj][0] + gg[bj][0] * acc[ai][bj][m][0], o1 = bs[mm][bj][1] + gg[bj][1] * acc[ai][bj][m][1];
                            u32x4 w; w.x = pk2(o0[0], o0[1]); w.y = pk2(o0[2], o0[3]); w.z = pk2(o1[0], o1[1]); w.w = pk2(o1[2], o1[3]);
                            *(u32x4*)(yb + (size_t)r * DM + c0 + bj * 128) = w;
                        } }
                    asm volatile("" ::: "memory");
                }
            }
        } else if (mode == EM_RESID_B2B || mode == EM_RESID_B2F) {
            const int c0 = u.pn * 256 + cl;
            const bool tof32 = (mode == EM_RESID_B2F);
#pragma unroll
            for (int ai = 0; ai < 2; ++ai) {
                u32x4 bs[4][2]; f32x4 gg[2][2];
                const bf16_t* xrow = xb + (size_t)(row0 + ai * 128) * DM + c0;
#pragma unroll
                for (int m = 0; m < 4; ++m)
#pragma unroll
                    for (int bj = 0; bj < 2; ++bj) bs[m][bj] = *(const u32x4*)(xrow + (size_t)m * 16 * DM + bj * 128);
                const float* gt = MODv + (size_t)batch_of(row0 + ai * 128) * NMODC + gidx * DM;
#pragma unroll
                for (int bj = 0; bj < 2; ++bj)
#pragma unroll
                    for (int n = 0; n < 2; ++n) gg[bj][n] = *(const f32x4*)(gt + c0 + bj * 128 + 4 * n) * coef;
                asm volatile("" ::: "memory");
#pragma unroll
                for (int m = 0; m < 4; ++m) {
                    const int r = row0 + ai * 128 + m * 16;
#pragma unroll
                    for (int bj = 0; bj < 2; ++bj) {
                        const u32x4 bw = bs[m][bj];
                        const f32x4 b0 = {bflo(bw.x), bfhi(bw.x), bflo(bw.y), bfhi(bw.y)}, b1 = {bflo(bw.z), bfhi(bw.z), bflo(bw.w), bfhi(bw.w)};
                        const f32x4 o0 = b0 + gg[bj][0] * acc[ai][bj][m][0], o1 = b1 + gg[bj][1] * acc[ai][bj][m][1];
                        if (tof32) { float* yo = Y + (size_t)r * DM + c0 + bj * 128; *(f32x4*)yo = o0; *(f32x4*)(yo + 4) = o1; }
                        else { u32x4 w; w.x = pk2(o0[0], o0[1]); w.y = pk2(o0[2], o0[3]); w.z = pk2(o1[0], o1[1]); w.w = pk2(o1[2], o1[3]);
                               *(u32x4*)(yb + (size_t)r * DM + c0 + bj * 128) = w; }
                    }
                }
                asm volatile("" ::: "memory");
            }
        } else if (mode == EM_ATOMIC) {
            const int c0 = u.pn * 256 + cl;
#pragma unroll
            for (int ai = 0; ai < 2; ++ai) {
                f32x4 gg[2][2];
                const float* gt = MODv + (size_t)batch_of(row0 + ai * 128) * NMODC + gidx * DM;
#pragma unroll
                for (int bj = 0; bj < 2; ++bj)
#pragma unroll
                    for (int n = 0; n < 2; ++n) gg[bj][n] = *(const f32x4*)(gt + c0 + bj * 128 + 4 * n) * coef;
#pragma unroll
                for (int m = 0; m < 4; ++m) { float* yo = Y + (size_t)(row0 + ai * 128 + m * 16) * DM + c0;
#pragma unroll
                    for (int bj = 0; bj < 2; ++bj)
#pragma unroll
                        for (int n = 0; n < 2; ++n) { const f32x4 v = gg[bj][n] * acc[ai][bj][m][n];
#pragma unroll
                            for (int j = 0; j < 4; ++j) __hip_atomic_fetch_add(yo + bj * 128 + 4 * n + j, v[j], __ATOMIC_RELAXED, __HIP_MEMORY_SCOPE_AGENT); } }
            }
        } else if (mode == EM_WIN) {
            const int sel = u.pn < 8 ? 0 : (u.pn < 16 ? 1 : 2);
#pragma unroll
            for (int ai = 0; ai < 2; ++ai)
#pragma unroll
                for (int m = 0; m < 4; ++m) {
                    const int r = row0 + ai * 128 + m * 16;
#pragma unroll
                    for (int bj = 0; bj < 2; ++bj) {
                        float o[8];
#pragma unroll
                        for (int n = 0; n < 2; ++n)
#pragma unroll
                            for (int j = 0; j < 4; ++j) o[4 * n + j] = acc[ai][bj][m][n][j];
                        bf16_t* dst;
                        if (sel == 0) {
                            const int c = u.pn * 256 + bj * 128 + cl;
                            dst = ZA + (size_t)r * 2048 + c;
                        } else if (sel == 1) {
                            const int c = (u.pn - 8) * 256 + bj * 128 + cl;
                            const f32x4 b0 = *(const f32x4*)(bgate + c), b1 = *(const f32x4*)(bgate + c + 4);
#pragma unroll
                            for (int j = 0; j < 4; ++j) { o[j] = sigmoidf_(o[j] + b0[j]); o[4 + j] = sigmoidf_(o[4 + j] + b1[j]); }
                            dst = Gw + (size_t)r * 2048 + c;
                        } else {
                            const int c = (u.pn - 16) * 256 + bj * 128 + cl;
                            dst = ZS + (size_t)r * 768 + c;
                        }
                        u32x4 w; w.x = pk2(o[0], o[1]); w.y = pk2(o[2], o[3]); w.z = pk2(o[4], o[5]); w.w = pk2(o[6], o[7]);
                        *(u32x4*)dst = w;
                    }
                }
        } else if (mode == EM_KNOPE) {
            const int head = u.pn * 4 + wc;
            const float* gkn = bgate;
            const float* KRp = (const float*)(ws + O_KR); const float* KSS = (const float*)(ws + O_KRSS);
            f32x4 gn[2][2], gr[2];
#pragma unroll
            for (int bj = 0; bj < 2; ++bj) { gn[bj][0] = *(const f32x4*)(gkn + bj * 32 + 8 * fq); gn[bj][1] = *(const f32x4*)(gkn + bj * 32 + 8 * fq + 4); }
            gr[0] = *(const f32x4*)(gkn + 64 + 8 * fq); gr[1] = *(const f32x4*)(gkn + 64 + 8 * fq + 4);
#pragma unroll
            for (int ai = 0; ai < 2; ++ai)
#pragma unroll
                for (int m = 0; m < 4; ++m) {
                    const int r = row0 + ai * 128 + m * 16;
                    const f32x4 k0 = *(const f32x4*)(KRp + (size_t)r * 32 + 8 * fq), k1 = *(const f32x4*)(KRp + (size_t)r * 32 + 8 * fq + 4);
                    const float krss = KSS[r];
                    float ss = 0.f;
#pragma unroll
                    for (int bj = 0; bj < 2; ++bj)
#pragma unroll
                        for (int n = 0; n < 2; ++n) { const f32x4 v = acc[ai][bj][m][n]; ss += (v[0] * v[0] + v[1] * v[1]) + (v[2] * v[2] + v[3] * v[3]); }
                    ss += __shfl_xor(ss, 16); ss += __shfl_xor(ss, 32);
                    const float rinv = rsqrtf((ss + krss) * (1.0f / 96.0f) + EPSF);
                    bf16_t* dst = O + (size_t)r * 768 + head * 96;
#pragma unroll
                    for (int bj = 0; bj < 2; ++bj) {
                        const f32x4 v0 = acc[ai][bj][m][0] * gn[bj][0] * rinv, v1 = acc[ai][bj][m][1] * gn[bj][1] * rinv;
                        u32x4 w; w.x = pk2(v0[0], v0[1]); w.y = pk2(v0[2], v0[3]); w.z = pk2(v1[0], v1[1]); w.w = pk2(v1[2], v1[3]);
                        *(u32x4*)(dst + bj * 32 + 8 * fq) = w;
                    }
                    { const f32x4 v0 = k0 * gr[0] * rinv, v1 = k1 * gr[1] * rinv;
                      u32x4 w; w.x = pk2(v0[0], v0[1]); w.y = pk2(v0[2], v0[3]); w.z = pk2(v1[0], v1[1]); w.w = pk2(v1[2], v1[3]);
                      *(u32x4*)(dst + 64 + 8 * fq) = w; }
                }
        } else if (mode == EM_PLAIN) {
#pragma unroll
            for (int ai = 0; ai < 2; ++ai)
#pragma unroll
                for (int m = 0; m < 4; ++m) {
                    const int r = row0 + ai * 128 + m * 16;
#pragma unroll
                    for (int bj = 0; bj < 2; ++bj) {
                        const int c = u.pn * 256 + bj * 128 + cl;
                        const f32x4 v0 = acc[ai][bj][m][0], v1 = acc[ai][bj][m][1];
                        u32x4 w; w.x = pk2(v0[0], v0[1]); w.y = pk2(v0[2], v0[3]); w.z = pk2(v1[0], v1[1]); w.w = pk2(v1[2], v1[3]);
                        *(u32x4*)(O + (size_t)r * ldc + c) = w;
                    }
                }
        } else {
            const int c0 = u.pn * 256 + cl;
            const bool isb = (mode == EM_BRB);
#pragma unroll
            for (int ai = 0; ai < 2; ++ai) {
                u32x4 gs[4][2], ts[4][2];
                const bf16_t* grow = G + (size_t)(row0 + ai * 128) * 2048 + (isb ? 1024 : 0) + c0;
                const bf16_t* trow = T + (size_t)(row0 + ai * 128) * 1024 + c0;
#pragma unroll
                for (int m = 0; m < 4; ++m)
#pragma unroll
                    for (int bj = 0; bj < 2; ++bj) { gs[m][bj] = *(const u32x4*)(grow + (size_t)m * 16 * 2048 + bj * 128);
                        ts[m][bj] = isb ? *(const u32x4*)(trow + (size_t)m * 16 * 1024 + bj * 128) : (u32x4){0u, 0u, 0u, 0u}; }
                asm volatile("" ::: "memory");
#pragma unroll
                for (int m = 0; m < 4; ++m) { const int r = row0 + ai * 128 + m * 16;
#pragma unroll
                    for (int bj = 0; bj < 2; ++bj) {
                        const u32x4 gw = gs[m][bj], tw = ts[m][bj];
                        const f32x4 v0 = acc[ai][bj][m][0], v1 = acc[ai][bj][m][1];
                        float o[8];
                        o[0] = bflo(gw.x) * v0[0]; o[1] = bfhi(gw.x) * v0[1]; o[2] = bflo(gw.y) * v0[2]; o[3] = bfhi(gw.y) * v0[3];
                        o[4] = bflo(gw.z) * v1[0]; o[5] = bfhi(gw.z) * v1[1]; o[6] = bflo(gw.w) * v1[2]; o[7] = bfhi(gw.w) * v1[3];
                        if (isb) { o[0] += bflo(tw.x); o[1] += bfhi(tw.x); o[2] += bflo(tw.y); o[3] += bfhi(tw.y);
                                   o[4] += bflo(tw.z); o[5] += bfhi(tw.z); o[6] += bflo(tw.w); o[7] += bfhi(tw.w); }
                        u32x4 w; w.x = pk2(o[0], o[1]); w.y = pk2(o[2], o[3]); w.z = pk2(o[4], o[5]); w.w = pk2(o[6], o[7]);
                        *(u32x4*)(O + (size_t)r * 1024 + c0 + bj * 128) = w;
                    } }
                asm volatile("" ::: "memory");
            }
        }
    }
};

template <class MapF>
__device__ __forceinline__ void conv_wT(const float* __restrict__ W, int K, int Nsrc, bf16_t* __restrict__ Bt, int Ndst, MapF map, size_t gtid, size_t gsz) {
    const size_t total = (size_t)Ndst * (size_t)(K / 8);
    for (size_t i = gtid; i < total; i += gsz) {
        const int n = (int)(i % (size_t)Ndst), kb = (int)(i / (size_t)Ndst);
        const int src = map(n);
        u32x4 o = {0u, 0u, 0u, 0u};
        if (src >= 0) {
            const float* p = W + (size_t)(kb * 8) * Nsrc + src;
            const float v0 = p[0], v1 = p[(size_t)Nsrc], v2 = p[(size_t)2 * Nsrc], v3 = p[(size_t)3 * Nsrc], v4 = p[(size_t)4 * Nsrc], v5 = p[(size_t)5 * Nsrc], v6 = p[(size_t)6 * Nsrc], v7 = p[(size_t)7 * Nsrc];
            o.x = pk2(v0, v1); o.y = pk2(v2, v3); o.z = pk2(v4, v5); o.w = pk2(v6, v7);
        }
        *(u32x4*)(Bt + (size_t)n * K + kb * 8) = o;
    }
}
struct MapId { __device__ __forceinline__ int operator()(int n) const { return n; } };
struct MapUp { __device__ __forceinline__ int operator()(int n) const { const int t = n >> 8, l = n & 255; return l < 128 ? t * 128 + l : DFF + t * 128 + (l - 128); } };
struct MapUk { __device__ __forceinline__ int operator()(int n) const { const int pn = n >> 8, bj = (n >> 7) & 1, wc = (n >> 5) & 3, x = n & 31; return (pn * 4 + wc) * 64 + bj * 32 + x; } };
struct MapIn { __device__ __forceinline__ int operator()(int n) const { return n < 2048 ? n : (n < 4096 ? 2720 + (n - 2048) : (n < 4768 ? 2048 + (n - 4096) : -1)); } };

__device__ __forceinline__ void prep_phase(const Params& P, LAS unsigned char* lds, const int wv_) {
    int tid_; asm volatile("v_mbcnt_lo_u32_b32 %0, -1, 0\n\tv_mbcnt_hi_u32_b32 %0, -1, %0" : "=v"(tid_)); tid_ += 64 * wv_;
    const int tid = tid_, lane = tid & 63, wid = __builtin_amdgcn_readfirstlane(tid >> 6);
    const size_t gtid = (size_t)blockIdx.x * 512 + tid, gsz = (size_t)gridDim.x * 512;
    unsigned char* ws = P.ws;
    if (gtid < 64) ((unsigned*)(ws + O_CTL))[gtid] = 0u;
    if (blockIdx.x < NMODC / 64) {
        const int n0 = blockIdx.x * 64;
        const float* cp = P.in[I_CP]; const float* cs = P.in[I_CS]; const float* wm = P.in[I_WMOD];
        LAS float* sc = (LAS float*)lds;
        float acc[40];
#pragma unroll
        for (int b = 0; b < 40; ++b) acc[b] = 0.f;
        for (int half = 0; half < 2; ++half) {
            __syncthreads();
            for (int i = tid; i < 40 * 512; i += 512) { const int b = i >> 9, k = i & 511; const float c = b < 32 ? cp[b * 1024 + half * 512 + k] : cs[(b - 32) * 1024 + half * 512 + k]; sc[i] = siluf_(c); }
            __syncthreads();
            for (int kk = 0; kk < 64; kk += 4) {
                const int kl = wid * 64 + kk; const size_t kg = (size_t)(half * 512 + kl);
                const float w0 = wm[kg * NMODC + n0 + lane], w1 = wm[(kg + 1) * NMODC + n0 + lane], w2 = wm[(kg + 2) * NMODC + n0 + lane], w3 = wm[(kg + 3) * NMODC + n0 + lane];
#pragma unroll
                for (int b = 0; b < 40; ++b) { const f32x4 s = *(const LAS f32x4*)(sc + b * 512 + kl); acc[b] += s.x * w0 + s.y * w1 + s.z * w2 + s.w * w3; }
            }
        }
        __syncthreads();
        LAS float* red = (LAS float*)lds;
#pragma unroll
        for (int b = 0; b < 40; ++b) red[(wid * 40 + b) * 64 + lane] = acc[b];
        __syncthreads();
        float* MODv = (float*)(ws + O_MOD); const float* bm = P.in[I_BMOD];
        for (int i = tid; i < 40 * 64; i += 512) { const int b = i >> 6, l = i & 63; float s = bm[n0 + l];
#pragma unroll
            for (int w = 0; w < 8; ++w) s += red[(w * 40 + b) * 64 + l];
            MODv[(size_t)b * NMODC + n0 + l] = s; }
        __syncthreads();
    }
    conv_wT(P.in[I_W1U], 1024, 2 * DFF, (bf16_t*)(ws + O_W1U), 2 * DFF, MapUp(), gtid, gsz);
    conv_wT(P.in[I_W2U], 1024, 2 * DFF, (bf16_t*)(ws + O_W2U), 2 * DFF, MapUp(), gtid, gsz);
    conv_wT(P.in[I_W1D], DFF, 1024, (bf16_t*)(ws + O_W1D), 1024, MapId(), gtid, gsz);
    conv_wT(P.in[I_W2D], DFF, 1024, (bf16_t*)(ws + O_W2D), 1024, MapId(), gtid, gsz);
    conv_wT(P.in[I_WIN], 1024, 4768, (bf16_t*)(ws + O_WIN), NINP, MapIn(), gtid, gsz);
    conv_wT(P.in[I_WUQ], 384, 768, (bf16_t*)(ws + O_WUQ), 768, MapId(), gtid, gsz);
    conv_wT(P.in[I_WUK], 256, 512, (bf16_t*)(ws + O_WUK), 512, MapUk(), gtid, gsz);
    conv_wT(P.in[I_WUV], 256, 512, (bf16_t*)(ws + O_WUV), 512, MapId(), gtid, gsz);
    conv_wT(P.in[I_WBA], 1024, 1024, (bf16_t*)(ws + O_WBA), 1024, MapId(), gtid, gsz);
    conv_wT(P.in[I_WBB], 512, 1024, (bf16_t*)(ws + O_WBB), 1024, MapId(), gtid, gsz);
    conv_wT(P.in[I_WO], 1024, 1024, (bf16_t*)(ws + O_WO), 1024, MapId(), gtid, gsz);
    { const float* w = P.in[I_GWS]; bf16_t* o = (bf16_t*)(ws + O_WS);
      for (size_t i = gtid; i < (size_t)8 * 128 * 128; i += gsz) { const int s = (int)(i & 127), t = (int)((i >> 7) & 127); o[i] = f2bf(s <= t ? w[i] : 0.f); } }
    { const float* c = P.in[I_CCKV]; bf16_t* o = (bf16_t*)(ws + O_CKV) + (size_t)MT * 256;
      for (size_t i = gtid; i < (size_t)MC * 256 / 4; i += gsz) { const f32x4 v = *(const f32x4*)(c + 4 * i); u32x2 w; w.x = pk2(v.x, v.y); w.y = pk2(v.z, v.w); *(u32x2*)(o + 4 * i) = w; }
      const float* kr = P.in[I_CKR]; float* ko = (float*)(ws + O_KR) + (size_t)MT * 32; float* kss = (float*)(ws + O_KRSS) + MT;
      for (size_t i = gtid; i < (size_t)MC; i += gsz) { float ss = 0.f;
#pragma unroll
          for (int j = 0; j < 8; ++j) { const f32x4 v = *(const f32x4*)(kr + 32 * i + 4 * j); *(f32x4*)(ko + 32 * i + 4 * j) = v; ss += (v.x * v.x + v.y * v.y) + (v.z * v.z + v.w * v.w); }
          kss[i] = ss; } }
}

__device__ __forceinline__ void modulate_phase(const float* xp, const float* xs, const float* g, const float* MODv, int ish, int isc, bf16_t* H, const int wv_) {
    int tid_; asm volatile("v_mbcnt_lo_u32_b32 %0, -1, 0\n\tv_mbcnt_hi_u32_b32 %0, -1, %0" : "=v"(tid_)); tid_ += 64 * wv_;
    const int tid = tid_, lane = tid & 63, wid = tid >> 6;
    const int gw = blockIdx.x * 8 + wid, ngw = gridDim.x * 8;
    f32x4 v[4][4], vn[4][4];
#define MOD_LOAD(dst, rb) do { _Pragma("unroll") for (int q = 0; q < 4; ++q) { const int row_ = (rb) + q * ngw; \
            if (row_ < MT) { const float* x_ = row_ < MP ? xp + (size_t)row_ * DM : xs + (size_t)(row_ - MP) * DM; \
                _Pragma("unroll") for (int j = 0; j < 4; ++j) dst[q][j] = *(const f32x4*)(x_ + 4 * lane + 256 * j); } \
            else { _Pragma("unroll") for (int j = 0; j < 4; ++j) dst[q][j] = (f32x4){0.f, 0.f, 0.f, 0.f}; } } } while (0)
    MOD_LOAD(v, gw);
    for (int rowb = gw; rowb < MT; rowb += 4 * ngw) {
        if (rowb + 4 * ngw < MT) MOD_LOAD(vn, rowb + 4 * ngw);
        float ss[4];
#pragma unroll
        for (int q = 0; q < 4; ++q) { float t = 0.f;
#pragma unroll
            for (int j = 0; j < 4; ++j) t += (v[q][j].x * v[q][j].x + v[q][j].y * v[q][j].y) + (v[q][j].z * v[q][j].z + v[q][j].w * v[q][j].w);
            ss[q] = wave_sum(t); }
#pragma unroll
        for (int q = 0; q < 4; ++q) {
            const int row = rowb + q * ngw;
            if (row < MT) {
                const float* mb = MODv + (size_t)batch_of(row) * NMODC;
                const float r = rsqrtf(ss[q] * (1.0f / 1024.0f) + EPSF);
#pragma unroll
                for (int j = 0; j < 4; ++j) {
                    const int c = 4 * lane + 256 * j;
                    const f32x4 gg = *(const f32x4*)(g + c), sc = *(const f32x4*)(mb + isc * DM + c), sh = *(const f32x4*)(mb + ish * DM + c);
                    const f32x4 o = (v[q][j] * r) * gg * (sc + 1.0f) + sh;
                    u32x2 w; w.x = pk2(o.x, o.y); w.y = pk2(o.z, o.w);
                    *(u32x2*)(H + (size_t)row * DM + c) = w;
                }
            }
        }
#pragma unroll
        for (int q = 0; q < 4; ++q)
#pragma unroll
            for (int j = 0; j < 4; ++j) v[q][j] = vn[q][j];
    }
#undef MOD_LOAD
}

__device__ __forceinline__ void modulate16_phase(const bf16_t* X, const float* g, const float* MODv, int ish, int isc, bf16_t* H, int row_begin, int row_end, int blk_first, const int wv_) {
    int tid_; asm volatile("v_mbcnt_lo_u32_b32 %0, -1, 0\n\tv_mbcnt_hi_u32_b32 %0, -1, %0" : "=v"(tid_)); tid_ += 64 * wv_;
    const int tid = tid_, lane = tid & 63, wid = tid >> 6;
    if ((int)blockIdx.x < blk_first) return;
    const int gw = ((int)blockIdx.x - blk_first) * 8 + wid, ngw = ((int)gridDim.x - blk_first) * 8;
    for (int rowb = row_begin + gw; rowb < row_end; rowb += 4 * ngw) {
        u32x4 v[4][2]; float ss[4];
#pragma unroll
        for (int q = 0; q < 4; ++q) {
            const int row = min(rowb + q * ngw, row_end - 1);
#pragma unroll
            for (int j = 0; j < 2; ++j) v[q][j] = *(const u32x4*)(X + (size_t)row * DM + 8 * lane + 512 * j);
        }
#pragma unroll
        for (int q = 0; q < 4; ++q) { float t = 0.f;
#pragma unroll
            for (int j = 0; j < 2; ++j) { const unsigned w[4] = {v[q][j].x, v[q][j].y, v[q][j].z, v[q][j].w};
#pragma unroll
                for (int e = 0; e < 4; ++e) { const float lo = bflo(w[e]), hi = bfhi(w[e]); t += lo * lo + hi * hi; } }
            ss[q] = wave_sum(t); }
#pragma unroll
        for (int q = 0; q < 4; ++q) {
            const int row = rowb + q * ngw;
            if (row < row_end) {
                const float* mb = MODv + (size_t)batch_of(row) * NMODC;
                const float r = rsqrtf(ss[q] * (1.0f / 1024.0f) + EPSF);
#pragma unroll
                for (int j = 0; j < 2; ++j) {
                    const int c = 8 * lane + 512 * j;
                    const unsigned w[4] = {v[q][j].x, v[q][j].y, v[q][j].z, v[q][j].w};
                    unsigned ow[4];
#pragma unroll
                    for (int e = 0; e < 2; ++e) {
                        const f32x4 gg = *(const f32x4*)(g + c + 4 * e), sc = *(const f32x4*)(mb + isc * DM + c + 4 * e), sh = *(const f32x4*)(mb + ish * DM + c + 4 * e);
                        const f32x4 x = {bflo(w[2 * e]), bfhi(w[2 * e]), bflo(w[2 * e + 1]), bfhi(w[2 * e + 1])};
                        const f32x4 o = (x * r) * gg * (sc + 1.0f) + sh;
                        ow[2 * e] = pk2(o.x, o.y); ow[2 * e + 1] = pk2(o.z, o.w);
                    }
                    *(u32x4*)(H + (size_t)row * DM + c) = (u32x4){ow[0], ow[1], ow[2], ow[3]};
                }
            }
        }
    }
}

__device__ __forceinline__ void rowpost_phase(const Params& P, const int wv_) {
    int tid_; asm volatile("v_mbcnt_lo_u32_b32 %0, -1, 0\n\tv_mbcnt_hi_u32_b32 %0, -1, %0" : "=v"(tid_)); tid_ += 64 * wv_;
    const int tid = tid_, lane = tid & 63, wid = tid >> 6;
    const int gw = blockIdx.x * 8 + wid, ngw = gridDim.x * 8;
    unsigned char* ws = P.ws;
    const bf16_t* ZA = (const bf16_t*)(ws + O_ZA); bf16_t* ZS = (bf16_t*)(ws + O_ZS); float* RV = (float*)(ws + O_RV);
    bf16_t* CKV = (bf16_t*)(ws + O_CKV); float* KR = (float*)(ws + O_KR);
    const float* gql = P.in[I_GQL]; const float* gkv = P.in[I_GKVL];
    for (int rowb = gw; rowb < MT; rowb += 2 * ngw) {
        u32x4 va[2], vb[2], qa[2]; u32x2 ka[2]; float kr[2];
#pragma unroll
        for (int q = 0; q < 2; ++q) {
            const int row = min(rowb + q * ngw, MT - 1);
            const u32x4* p = (const u32x4*)(ZA + (size_t)row * 2048 + 1024 + 16 * lane); va[q] = p[0]; vb[q] = p[1];
            const bf16_t* zs = ZS + (size_t)row * 768;
            qa[q] = (u32x4){0u, 0u, 0u, 0u}; if (lane < 48) qa[q] = *(const u32x4*)(zs + 8 * lane);
            ka[q] = *(const u32x2*)(zs + 384 + 4 * lane);
            kr[q] = lane < 32 ? bf2f(zs[640 + lane]) : 0.f;
        }
#pragma unroll
        for (int q = 0; q < 2; ++q) {
            const int row = rowb + q * ngw;
            if (row < MT) {
                bf16_t* zs = ZS + (size_t)row * 768;
                { const unsigned w[8] = {va[q].x, va[q].y, va[q].z, va[q].w, vb[q].x, vb[q].y, vb[q].z, vb[q].w}; float ss = 0.f;
#pragma unroll
                  for (int j = 0; j < 8; ++j) { const float lo = gelu_tanh(bflo(w[j])), hi = gelu_tanh(bfhi(w[j])); ss += lo * lo + hi * hi; }
                  ss = wave_sum(ss); if (lane == 0) RV[row] = rsqrtf(ss * (1.0f / 1024.0f) + EPSF); }
                { const u32x4 a = qa[q];
                  float qv[8] = {bflo(a.x), bfhi(a.x), bflo(a.y), bfhi(a.y), bflo(a.z), bfhi(a.z), bflo(a.w), bfhi(a.w)}; float ss = 0.f;
#pragma unroll
                  for (int j = 0; j < 8; ++j) ss += qv[j] * qv[j];
                  ss = wave_sum(ss); const float r = rsqrtf(ss * (1.0f / 384.0f) + EPSF);
                  if (lane < 48) { const f32x4 g0 = *(const f32x4*)(gql + 8 * lane), g1 = *(const f32x4*)(gql + 8 * lane + 4);
                    u32x4 w; w.x = pk2(qv[0] * r * g0.x, qv[1] * r * g0.y); w.y = pk2(qv[2] * r * g0.z, qv[3] * r * g0.w); w.z = pk2(qv[4] * r * g1.x, qv[5] * r * g1.y); w.w = pk2(qv[6] * r * g1.z, qv[7] * r * g1.w);
                    *(u32x4*)(zs + 8 * lane) = w; } }
                { const u32x2 a = ka[q]; float v[4] = {bflo(a.x), bfhi(a.x), bflo(a.y), bfhi(a.y)};
                  float ss = (v[0] * v[0] + v[1] * v[1]) + (v[2] * v[2] + v[3] * v[3]); ss = wave_sum(ss); const float r = rsqrtf(ss * (1.0f / 256.0f) + EPSF);
                  const f32x4 g4 = *(const f32x4*)(gkv + 4 * lane); f32x4 o = {v[0] * r * g4.x, v[1] * r * g4.y, v[2] * r * g4.z, v[3] * r * g4.w};
                  float* dst = row < MP ? P.out + OUT_CKVP + (size_t)row * 256 : P.out + OUT_CKVS + (size_t)(row - MP) * 256;
                  *(f32x4*)(dst + 4 * lane) = o; u32x2 w; w.x = pk2(o.x, o.y); w.y = pk2(o.z, o.w); *(u32x2*)(CKV + (size_t)row * 256 + 4 * lane) = w; }
                { const float val = kr[q]; const float partner = __shfl_xor(val, 16); float sn, cs; rope_sc(pos_of(row), lane & 15, sn, cs);
                  const float o = (lane < 16) ? val * cs - partner * sn : partner * sn + val * cs;
                  if (lane < 32) { KR[(size_t)row * 32 + lane] = o; float* dst = row < MP ? P.out + OUT_KRP + (size_t)row * 32 : P.out + OUT_KRS + (size_t)(row - MP) * 32; dst[lane] = o; }
                  const float oss = wave_sum(lane < 32 ? o * o : 0.f); if (lane == 0) ((float*)(ws + O_KRSS))[row] = oss; }
            }
        }
    }
}

__device__ __forceinline__ void gmlp_phase(const Params& P, LAS unsigned char* lds, const int wv_) {
    int tid_; asm volatile("v_mbcnt_lo_u32_b32 %0, -1, 0\n\tv_mbcnt_hi_u32_b32 %0, -1, %0" : "=v"(tid_)); tid_ += 64 * wv_;
    const int tid = tid_, lane = tid & 63, wid = __builtin_amdgcn_readfirstlane(tid >> 6), l32 = lane & 31, hh = lane >> 5;
    unsigned char* ws = P.ws;
    const bf16_t* ZA = (const bf16_t*)(ws + O_ZA); const float* RV = (const float*)(ws + O_RV); const bf16_t* WS = (const bf16_t*)(ws + O_WS);
    bf16_t* OA = (bf16_t*)(ws + O_OA);
    const float* ggv = P.in[I_GGV]; const float* gb = P.in[I_GB];
    LAS bf16_t* vt = (LAS bf16_t*)lds;
    LAS float* mx = (LAS float*)(lds + 34816);
    const int sr = tid >> 4, cp = tid & 15;
    for (int item = blockIdx.x; item < 520 * 8; item += gridDim.x) {
        const int ci = item >> 3, g = item & 7; const bool sample = ci >= 512;
        const int row0 = sample ? MP + (ci - 512) * 64 : ci * 128, L = sample ? 64 : 128;
        u32x4 gvr[4], ur[4]; float rvr[4];
#pragma unroll
        for (int p = 0; p < 4; ++p) {
            const int s = p * 32 + sr; const int row = row0 + (s < L ? s : 0);
            gvr[p] = *(const u32x4*)(ZA + (size_t)row * 2048 + 1024 + g * 128 + 8 * cp);
            ur[p] = *(const u32x4*)(ZA + (size_t)row * 2048 + g * 128 + 8 * cp);
            rvr[p] = RV[row];
        }
        const f32x4 g0 = *(const f32x4*)(ggv + g * 128 + 8 * cp), g1 = *(const f32x4*)(ggv + g * 128 + 8 * cp + 4);
        __syncthreads();
#pragma unroll
        for (int p = 0; p < 4; ++p) {
            const int s = p * 32 + sr;
            if (s < L) {
                const int row = row0 + s; const u32x4 a = gvr[p]; const float rv = rvr[p];
                float v[8] = {gelu_tanh(bflo(a.x)) * rv * g0.x, gelu_tanh(bfhi(a.x)) * rv * g0.y, gelu_tanh(bflo(a.y)) * rv * g0.z, gelu_tanh(bfhi(a.y)) * rv * g0.w, gelu_tanh(bflo(a.z)) * rv * g1.x, gelu_tanh(bfhi(a.z)) * rv * g1.y, gelu_tanh(bflo(a.w)) * rv * g1.z, gelu_tanh(bfhi(a.w)) * rv * g1.w};
                if (sample) { float* dst = P.out + OUT_GV + (size_t)(row - MP) * 1024 + g * 128 + 8 * cp; *(f32x4*)dst = (f32x4){v[0], v[1], v[2], v[3]}; *(f32x4*)(dst + 4) = (f32x4){v[4], v[5], v[6], v[7]}; }
#pragma unroll
                for (int j = 0; j < 8; ++j) vt[(8 * cp + j) * 136 + s] = f2bf(v[j]);
            }
        }
        __syncthreads();
        const int tb = wid & 3, ch = wid >> 2;
        if (32 * tb < L) {
            f32x16 acc0, acc1;
#pragma unroll
            for (int i = 0; i < 16; ++i) { acc0[i] = 0.f; acc1[i] = 0.f; }
            const bf16_t* wp = WS + ((size_t)g * 128 + 32 * tb + l32) * 128 + 8 * hh;
            const LAS bf16_t* b0p = vt + (64 * ch + l32) * 136 + 8 * hh; const LAS bf16_t* b1p = b0p + 32 * 136;
            const int nks = 2 * (tb + 1);
            for (int ks = 0; ks < nks; ++ks) {
                const bf16x8 a = *(const bf16x8*)(wp + 16 * ks);
                const bf16x8 b0 = *(const LAS bf16x8*)(b0p + 16 * ks), b1 = *(const LAS bf16x8*)(b1p + 16 * ks);
                acc0 = __builtin_amdgcn_mfma_f32_32x32x16_bf16(a, b0, acc0, 0, 0, 0);
                acc1 = __builtin_amdgcn_mfma_f32_32x32x16_bf16(a, b1, acc1, 0, 0, 0);
            }
#pragma unroll
            for (int i = 0; i < 16; ++i) {
                const int t = 32 * tb + (i & 3) + 8 * (i >> 2) + 4 * hh;
                mx[t * 132 + 64 * ch + l32] = acc0[i]; mx[t * 132 + 64 * ch + 32 + l32] = acc1[i];
            }
        }
        __syncthreads();
#pragma unroll
        for (int p = 0; p < 4; ++p) {
            const int t = p * 32 + sr;
            if (t < L) {
                const int row = row0 + t; const float bias = gb[g * 128 + t];
                const f32x4 m0 = *(const LAS f32x4*)(mx + t * 132 + 8 * cp), m1 = *(const LAS f32x4*)(mx + t * 132 + 8 * cp + 4);
                const u32x4 a = ur[p];
                u32x4 w;
                w.x = pk2(gelu_tanh(bflo(a.x)) * (m0.x + bias), gelu_tanh(bfhi(a.x)) * (m0.y + bias)); w.y = pk2(gelu_tanh(bflo(a.y)) * (m0.z + bias), gelu_tanh(bfhi(a.y)) * (m0.w + bias));
                w.z = pk2(gelu_tanh(bflo(a.z)) * (m1.x + bias), gelu_tanh(bfhi(a.z)) * (m1.y + bias)); w.w = pk2(gelu_tanh(bflo(a.w)) * (m1.z + bias), gelu_tanh(bfhi(a.w)) * (m1.w + bias));
                *(u32x4*)(OA + (size_t)row * 1024 + g * 128 + 8 * cp) = w;
            }
        }
    }
}

__device__ __forceinline__ void qkfinal_phase(const Params& P, const int wv_) {
    int tid_; asm volatile("v_mbcnt_lo_u32_b32 %0, -1, 0\n\tv_mbcnt_hi_u32_b32 %0, -1, %0" : "=v"(tid_)); tid_ += 64 * wv_;
    const int tid = tid_, lane = tid & 63, wid = tid >> 6;
    const int gw = blockIdx.x * 8 + wid, ngw = gridDim.x * 8;
    unsigned char* ws = P.ws;
    bf16_t* QR = (bf16_t*)(ws + O_QR); bf16_t* KF = (bf16_t*)(ws + O_KF); const float* KR = (const float*)(ws + O_KR);
    const float* gqn = P.in[I_GQN]; const float* gkn = P.in[I_GKN];
    const int h = lane >> 3, sub = lane & 7;
    constexpr float QSCALE = 0.10206207261596575f * 1.4426950408889634f;
    for (int itemb = gw; itemb < MT + MKV; itemb += 4 * ngw) {
        u32x4 na[4]; u32x2 qb[4]; f32x4 kb[4];
#pragma unroll
        for (int q = 0; q < 4; ++q) {
            const int item = min(itemb + q * ngw, MT + MKV - 1);
            const bool isq = item < MT; const int row = isq ? item : item - MT;
            const bf16_t* p = (isq ? QR : KF) + (size_t)row * 768 + h * 96;
            na[q] = *(const u32x4*)(p + 8 * sub);
            qb[q] = (u32x2){0u, 0u}; kb[q] = (f32x4){0.f, 0.f, 0.f, 0.f};
            if (isq) qb[q] = *(const u32x2*)(p + 64 + 4 * sub); else kb[q] = *(const f32x4*)(KR + (size_t)row * 32 + 4 * sub);
        }
#pragma unroll
        for (int q = 0; q < 4; ++q) {
            const int item = itemb + q * ngw;
            if (item < MT + MKV) {
                const bool isq = item < MT; const int row = isq ? item : item - MT;
                bf16_t* p = (isq ? QR : KF) + (size_t)row * 768 + h * 96;
                const u32x4 a = na[q];
                float nope[8] = {bflo(a.x), bfhi(a.x), bflo(a.y), bfhi(a.y), bflo(a.z), bfhi(a.z), bflo(a.w), bfhi(a.w)};
                float rp[4];
                if (isq) {
                    const u32x2 b = qb[q];
                    const float raw[4] = {bflo(b.x), bfhi(b.x), bflo(b.y), bfhi(b.y)};
                    const float pos = pos_of(row);
#pragma unroll
                    for (int j = 0; j < 4; ++j) { const float partner = __shfl_xor(raw[j], 4); float sn, cs; rope_sc(pos, (4 * sub + j) & 15, sn, cs);
                        rp[j] = (sub < 4) ? raw[j] * cs - partner * sn : partner * sn + raw[j] * cs; }
                } else { rp[0] = kb[q].x; rp[1] = kb[q].y; rp[2] = kb[q].z; rp[3] = kb[q].w; }
                float ss = 0.f;
#pragma unroll
                for (int j = 0; j < 8; ++j) ss += nope[j] * nope[j];
#pragma unroll
                for (int j = 0; j < 4; ++j) ss += rp[j] * rp[j];
                ss += __shfl_xor(ss, 1); ss += __shfl_xor(ss, 2); ss += __shfl_xor(ss, 4);
                const float r = rsqrtf(ss * (1.0f / 96.0f) + EPSF) * (isq ? QSCALE : 1.0f);
                const float* gn = isq ? gqn : gkn;
                const f32x4 g0 = *(const f32x4*)(gn + 8 * sub), g1 = *(const f32x4*)(gn + 8 * sub + 4), g2 = *(const f32x4*)(gn + 64 + 4 * sub);
                u32x4 w; w.x = pk2(nope[0] * r * g0.x, nope[1] * r * g0.y); w.y = pk2(nope[2] * r * g0.z, nope[3] * r * g0.w); w.z = pk2(nope[4] * r * g1.x, nope[5] * r * g1.y); w.w = pk2(nope[6] * r * g1.z, nope[7] * r * g1.w);
                u32x2 w2; w2.x = pk2(rp[0] * r * g2.x, rp[1] * r * g2.y); w2.y = pk2(rp[2] * r * g2.z, rp[3] * r * g2.w);
                *(u32x4*)(p + 8 * sub) = w; *(u32x2*)(p + 64 + 4 * sub) = w2;
            }
        }
    }
}

constexpr int N_ATT_ITEMS = 64 + 2048;
__device__ __forceinline__ void attn_phase(const Params& P, LAS unsigned char* lds, int cidx, const int wv_) {
    int tid_; asm volatile("v_mbcnt_lo_u32_b32 %0, -1, 0\n\tv_mbcnt_hi_u32_b32 %0, -1, %0" : "=v"(tid_)); tid_ += 64 * wv_;
    const int tid = tid_, lane = tid & 63, wid = __builtin_amdgcn_readfirstlane(tid >> 6), l32 = lane & 31, hh = lane >> 5;
    unsigned char* ws = P.ws;
    const bf16_t* QR = (const bf16_t*)(ws + O_QR); const bf16_t* KF = (const bf16_t*)(ws + O_KF); const bf16_t* VT = (const bf16_t*)(ws + O_VT);
    bf16_t* OB = (bf16_t*)(ws + O_OB);
    unsigned* counter = (unsigned*)(ws + O_CTL) + cidx;
    LAS unsigned* slot = (LAS unsigned*)(lds + 45056);
    const int k0key = tid / 12, k0part = tid % 12, k1key = (tid + 512) / 12, k1part = (tid + 512) % 12; const bool has1 = tid < 256;
    const int vdv = tid >> 3, vpart = tid & 7;
    for (;;) {
        __syncthreads();
        if (tid == 0) *slot = atomicAdd(counter, 1u);
        __syncthreads();
        const int item = (int)*slot;
        if (item >= N_ATT_ITEMS) break;
        const bool sample = item < 64;
        int b, h, nt, qrow0, wlim;
        if (sample) { b = item >> 3; h = item & 7; nt = 65; qrow0 = MP + b * 64; wlim = 64; }
        else { const int j = item - 64, qb = 7 - (j >> 8), bh = j & 255; b = bh >> 3; h = bh & 7; nt = 4 * qb + 4; qrow0 = b * 2048 + qb * 256; wlim = 4 * qb + (wid >> 1); }
        const bool wvalid = sample ? (wid < 2) : true;
        bf16x8 qf[6];
        if (wvalid) { const int qrow = qrow0 + 32 * wid + l32; const bf16_t* qp = QR + (size_t)qrow * 768 + h * 96 + 8 * hh;
            u32x4 qraw[6];
#pragma unroll
            for (int ks = 0; ks < 6; ++ks) qraw[ks] = *(const u32x4*)(qp + 16 * ks);
            float qv[6][8];
#pragma unroll
            for (int ks = 0; ks < 6; ++ks) { qv[ks][0] = bflo(qraw[ks].x); qv[ks][1] = bfhi(qraw[ks].x); qv[ks][2] = bflo(qraw[ks].y); qv[ks][3] = bfhi(qraw[ks].y);
                qv[ks][4] = bflo(qraw[ks].z); qv[ks][5] = bfhi(qraw[ks].z); qv[ks][6] = bflo(qraw[ks].w); qv[ks][7] = bfhi(qraw[ks].w); }
            const float pos = pos_of(qrow);
#pragma unroll
            for (int j = 0; j < 8; ++j) { float sn, cs; rope_sc(pos, 8 * hh + j, sn, cs); const float x1 = qv[4][j], x2 = qv[5][j]; qv[4][j] = x1 * cs - x2 * sn; qv[5][j] = x1 * sn + x2 * cs; }
            float ss = 0.f;
#pragma unroll
            for (int ks = 0; ks < 6; ++ks)
#pragma unroll
                for (int j = 0; j < 8; ++j) ss += qv[ks][j] * qv[ks][j];
            ss += __shfl_xor(ss, 32);
            const float rq = rsqrtf(ss * (1.0f / 96.0f) + EPSF) * (0.10206207261596575f * 1.4426950408889634f);
            const float* gqn = P.in[I_GQN];
#pragma unroll
            for (int ks = 0; ks < 6; ++ks) { const f32x4 g0 = *(const f32x4*)(gqn + 16 * ks + 8 * hh), g1 = *(const f32x4*)(gqn + 16 * ks + 8 * hh + 4);
                u32x4 w; w.x = pk2(qv[ks][0] * rq * g0.x, qv[ks][1] * rq * g0.y); w.y = pk2(qv[ks][2] * rq * g0.z, qv[ks][3] * rq * g0.w);
                w.z = pk2(qv[ks][4] * rq * g1.x, qv[ks][5] * rq * g1.y); w.w = pk2(qv[ks][6] * rq * g1.z, qv[ks][7] * rq * g1.w);
                qf[ks] = __builtin_bit_cast(bf16x8, w); } }
        else {
#pragma unroll
            for (int ks = 0; ks < 6; ++ks) qf[ks] = (bf16x8){0, 0, 0, 0, 0, 0, 0, 0}; }
        f32x16 O0, O1;
#pragma unroll
        for (int i = 0; i < 16; ++i) { O0[i] = 0.f; O1[i] = 0.f; }
        float mrun = -1e30f, lrun = 0.f;
        u32x4 kr0, kr1 = {0u, 0u, 0u, 0u}, vr;
#define ATT_TROW(kt) (sample ? ((kt) < 64 ? MT + b * 4096 + (kt) * 64 : MP + b * 64) : b * 2048 + (kt) * 64)
#define ATT_ISSUE(kt) do { const size_t krow = (size_t)ATT_TROW(kt); \
            kr0 = *(const u32x4*)(KF + (krow + k0key) * 768 + h * 96 + k0part * 8); \
            if (has1) kr1 = *(const u32x4*)(KF + (krow + k1key) * 768 + h * 96 + k1part * 8); \
            vr = *(const u32x4*)(VT + (size_t)(h * 64 + vdv) * MKV + krow + vpart * 8); } while (0)
#define ATT_COMMIT(bufi) do { *(LAS u32x4*)(lds + (bufi) * 13312 + k0key * 208 + k0part * 16) = kr0; \
            if (has1) *(LAS u32x4*)(lds + (bufi) * 13312 + k1key * 208 + k1part * 16) = kr1; \
            *(LAS u32x4*)(lds + 26624 + (bufi) * 9216 + vdv * 144 + vpart * 16) = vr; } while (0)
        ATT_ISSUE(0); ATT_COMMIT(0);
        __syncthreads();
        for (int kt = 0; kt < nt; ++kt) {
            const int buf = kt & 1;
            if (kt + 1 < nt) ATT_ISSUE(kt + 1);
            if (wvalid && kt <= wlim) {
                const LAS unsigned char* kb = lds + buf * 13312 + l32 * 208 + hh * 16;
                const LAS unsigned char* vb = lds + 26624 + buf * 9216 + l32 * 144 + hh * 8;
                f32x16 S0, S1;
#pragma unroll
                for (int i = 0; i < 16; ++i) { S0[i] = 0.f; S1[i] = 0.f; }
#pragma unroll
                for (int ks = 0; ks < 6; ++ks) {
                    const bf16x8 a0 = *(const LAS bf16x8*)(kb + ks * 32), a1 = *(const LAS bf16x8*)(kb + 32 * 208 + ks * 32);
                    S0 = __builtin_amdgcn_mfma_f32_32x32x16_bf16(a0, qf[ks], S0, 0, 0, 0);
                    S1 = __builtin_amdgcn_mfma_f32_32x32x16_bf16(a1, qf[ks], S1, 0, 0, 0);
                }
                float mx = S0[0];
#pragma unroll
                for (int i = 1; i < 16; ++i) mx = fmaxf(mx, S0[i]);
#pragma unroll
                for (int i = 0; i < 16; ++i) mx = fmaxf(mx, S1[i]);
                mx = fmaxf(mx, __shfl_xor(mx, 32));
                const float mnew = fmaxf(mrun, mx), alpha = fast_exp2(mrun - mnew); mrun = mnew;
                float ps = 0.f;
#pragma unroll
                for (int i = 0; i < 16; ++i) { S0[i] = fast_exp2(S0[i] - mnew); ps += S0[i]; }
#pragma unroll
                for (int i = 0; i < 16; ++i) { S1[i] = fast_exp2(S1[i] - mnew); ps += S1[i]; }
                lrun = lrun * alpha + ps;
#pragma unroll
                for (int i = 0; i < 16; ++i) { O0[i] *= alpha; O1[i] *= alpha; }
#pragma unroll
                for (int kk = 0; kk < 4; ++kk) {
                    u32x4 pw;
                    if (kk == 0) { pw.x = pk2(S0[0], S0[1]); pw.y = pk2(S0[2], S0[3]); pw.z = pk2(S0[4], S0[5]); pw.w = pk2(S0[6], S0[7]); }
                    else if (kk == 1) { pw.x = pk2(S0[8], S0[9]); pw.y = pk2(S0[10], S0[11]); pw.z = pk2(S0[12], S0[13]); pw.w = pk2(S0[14], S0[15]); }
                    else if (kk == 2) { pw.x = pk2(S1[0], S1[1]); pw.y = pk2(S1[2], S1[3]); pw.z = pk2(S1[4], S1[5]); pw.w = pk2(S1[6], S1[7]); }
                    else { pw.x = pk2(S1[8], S1[9]); pw.y = pk2(S1[10], S1[11]); pw.z = pk2(S1[12], S1[13]); pw.w = pk2(S1[14], S1[15]); }
                    const bf16x8 pb = __builtin_bit_cast(bf16x8, pw);
                    const u32x2 lo0 = *(const LAS u32x2*)(vb + kk * 32), hi0 = *(const LAS u32x2*)(vb + kk * 32 + 16);
                    const u32x2 lo1 = *(const LAS u32x2*)(vb + 32 * 144 + kk * 32), hi1 = *(const LAS u32x2*)(vb + 32 * 144 + kk * 32 + 16);
                    const u32x4 va0 = {lo0.x, lo0.y, hi0.x, hi0.y}, va1 = {lo1.x, lo1.y, hi1.x, hi1.y};
                    O0 = __builtin_amdgcn_mfma_f32_32x32x16_bf16(__builtin_bit_cast(bf16x8, va0), pb, O0, 0, 0, 0);
                    O1 = __builtin_amdgcn_mfma_f32_32x32x16_bf16(__builtin_bit_cast(bf16x8, va1), pb, O1, 0, 0, 0);
                }
            }
            if (kt + 1 < nt) ATT_COMMIT(buf ^ 1);
            __syncthreads();
        }
#undef ATT_TROW
#undef ATT_ISSUE
#undef ATT_COMMIT
        if (wvalid) {
            const float ltot = lrun + __shfl_xor(lrun, 32); const float inv = 1.0f / ltot;
            bf16_t* op = OB + (size_t)(qrow0 + 32 * wid + l32) * 512 + h * 64 + 4 * hh;
#pragma unroll
            for (int g4 = 0; g4 < 4; ++g4) {
                u32x2 w0; w0.x = pk2(O0[4 * g4] * inv, O0[4 * g4 + 1] * inv); w0.y = pk2(O0[4 * g4 + 2] * inv, O0[4 * g4 + 3] * inv);
                u32x2 w1; w1.x = pk2(O1[4 * g4] * inv, O1[4 * g4 + 1] * inv); w1.y = pk2(O1[4 * g4 + 2] * inv, O1[4 * g4 + 3] * inv);
                *(u32x2*)(op + 8 * g4) = w0; *(u32x2*)(op + 32 + 8 * g4) = w1;
            }
        }
    }
}

#define XB_TMO      128
#define XB_XCNT(j)  (256  + 64 * (j))
#define XB_XSUB(j)  (1280 + 64 * (j))
#define XB_XGEN(j)  (2304 + 64 * (j))
#define XB_TOP      3328
#define XB_TOPGEN   3392
#define XCD_BAR_WORDS 3456
#define XB_SPIN_CAP (1u << 18)

__device__ __forceinline__ unsigned xb_ld(unsigned* p)              { return __hip_atomic_load(p, __ATOMIC_RELAXED, __HIP_MEMORY_SCOPE_AGENT); }
__device__ __forceinline__ unsigned xb_add(unsigned* p, unsigned v) { return __hip_atomic_fetch_add(p, v, __ATOMIC_RELAXED, __HIP_MEMORY_SCOPE_AGENT); }
__device__ __forceinline__ unsigned xb_xcc_id() { return (unsigned)__builtin_amdgcn_s_getreg((3 << 11) | 20) & 0xFu; }
#define XB_SPIN(cond, bar) do { unsigned _sp = 0; while (cond) { __builtin_amdgcn_s_sleep(1); \
    if ((++_sp & 255u) == 0u) { if (xb_ld(&(bar)[XB_TMO])) break; if (_sp > XB_SPIN_CAP) { atomicAdd(&(bar)[XB_TMO], 1u); break; } } } } while (0)

struct XcdBarrier {
    unsigned* bar; unsigned x;
    volatile LAS unsigned* st;
};

__device__ __forceinline__ XcdBarrier xcd_barrier_post(unsigned* bar, volatile LAS unsigned* st) {
    XcdBarrier b; b.bar = bar; b.x = xb_xcc_id(); b.st = st;
    if (threadIdx.x == 0) (void)xb_add(&bar[XB_XCNT(b.x)], 1u);
    return b;
}
__device__ __forceinline__ void xcd_barrier_complete(unsigned* bar, unsigned x, unsigned& nloc, unsigned& nx) {
    const unsigned G = gridDim.x * gridDim.y * gridDim.z;
    unsigned sum, cnt, mine, sp = 0u;
    for (;;) {
        sum = 0u; cnt = 0u; mine = 0u;
#pragma unroll
        for (unsigned j = 0; j < 16; ++j) { const unsigned c = xb_ld(&bar[XB_XCNT(j)]); sum += c; cnt += (c > 0u) ? 1u : 0u; mine = (j == x) ? c : mine; }
        if (sum == G) break;
        __builtin_amdgcn_s_sleep(1);
        if ((++sp & 255u) == 0u) { if (xb_ld(&bar[XB_TMO])) break; if (sp > XB_SPIN_CAP) { atomicAdd(&bar[XB_TMO], 1u); break; } }
    }
    nloc = mine > 0u ? mine : 1u; nx = cnt > 0u ? cnt : 1u;
}

__device__ __forceinline__ void xcd_barrier(const XcdBarrier& b) {
    asm volatile("s_waitcnt vmcnt(0)" ::: "memory");
    __syncthreads();
    if (threadIdx.x == 0) {
        unsigned* bar = b.bar;
        __builtin_amdgcn_s_waitcnt(0);
        unsigned nloc = b.st[0], nx = b.st[1];
        if (nloc == 0u) { xcd_barrier_complete(bar, b.x, nloc, nx); b.st[0] = nloc; b.st[1] = nx; }
        const unsigned old = xb_add(&bar[XB_XSUB(b.x)], 1u);
        const unsigned gen = old / nloc;
        if (old + 1u == (gen + 1u) * nloc) {
            __builtin_amdgcn_fence(__ATOMIC_RELEASE, "agent");
            asm volatile("s_waitcnt vmcnt(0)" ::: "memory");
            const unsigned og = xb_add(&bar[XB_TOP], 1u);
            const unsigned tg = og / nx;
            if (og + 1u == (tg + 1u) * nx) xb_add(&bar[XB_TOPGEN], 1u);
            else XB_SPIN(xb_ld(&bar[XB_TOPGEN]) == tg, bar);
            __builtin_amdgcn_fence(__ATOMIC_ACQUIRE, "agent");
            xb_add(&bar[XB_XGEN(b.x)], 1u);
            asm volatile("s_waitcnt vmcnt(0)" ::: "memory");
        } else {
            XB_SPIN(xb_ld(&bar[XB_XGEN(b.x)]) == gen, bar);
            __builtin_amdgcn_fence(__ATOMIC_ACQUIRE, "agent");
            asm volatile("s_waitcnt vmcnt(0)" ::: "memory");
        }
    }
    __syncthreads();
}


__global__ void __launch_bounds__(512, 2) mk_forward(Params P) {
    extern __shared__ __attribute__((aligned(16))) unsigned char lds_raw[];
    LAS unsigned char* lds = (LAS unsigned char*)lds_raw;
    cg::grid_group grid = cg::this_grid();
    const int wv_ = __builtin_amdgcn_readfirstlane((int)(threadIdx.x >> 6));
    volatile LAS unsigned* xb_st = (volatile LAS unsigned*)(lds + 131072);
    if (threadIdx.x < 4) xb_st[threadIdx.x] = 0u;
    __syncthreads();
    const XcdBarrier xb = xcd_barrier_post((unsigned*)(P.ws + O_BAR), xb_st);
    unsigned char* ws = P.ws;
    float* MODv = (float*)(ws + O_MOD);
    float* Y = P.out + OUT_Y;
    constexpr int NPROG = NSTEPS + (PROBE_DUP >= 0 ? 1 : 0);
    for (int si = P.ph_lo; si < NPROG; ++si) {
        const int step = (PROBE_DUP >= 0 && si > PROBE_DUP) ? si - 1 : si;
        const bool rerun = (PROBE_DUP >= 0 && si == PROBE_DUP + 1);
        bool is_gemm = false, sync_after = true;
        pg8::Gemm g; g.A = nullptr; g.Bt = nullptr; g.M = 0; g.N = 0; g.K = 0; g.lda = 0; g.ldb = 0;
        Epi E; E.mode = EM_PLAIN; E.sub = 0; E.gidx = 0; E.row_off = 0; E.coef = 1.0f; E.ws = ws; E.Y = Y; E.xp = P.in[I_XP]; E.xs = P.in[I_XS]; E.bgate = P.in[I_BGATE];
        switch (step) {
        case 0: prep_phase(P, lds, wv_); break;
        case 1: modulate_phase(P.in[I_XP], P.in[I_XS], P.in[I_GFFN1], MODv, 0, 1, (bf16_t*)(ws + O_H), wv_); break;
        case 2: is_gemm = true; g.A = (const bf16_t*)(ws + O_H); g.lda = 1024; g.Bt = (const bf16_t*)(ws + O_W1U); g.M = MT; g.N = 2 * DFF; g.K = 1024; E.mode = EM_SWIGLU; break;
        case 3: is_gemm = true; g.A = (const bf16_t*)(ws + O_ACT); g.lda = DFF; g.Bt = (const bf16_t*)(ws + O_W1D); g.M = MP; g.N = 1024; g.K = DFF; E.mode = EM_RESID; E.gidx = 2; E.coef = 0.5f; break;
        case 4:
            if (blockIdx.x < 8) { is_gemm = true; g.A = (const bf16_t*)(ws + O_ACT) + (size_t)MP * DFF; g.lda = DFF; g.Bt = (const bf16_t*)(ws + O_W1D); g.M = MS; g.N = 1024; g.K = DFF; E.mode = EM_RESID; E.gidx = 2; E.coef = 0.5f; E.row_off = MP; }
            else modulate16_phase((const bf16_t*)Y, P.in[I_GMIX], MODv, 3, 4, (bf16_t*)(ws + O_H), 0, MP, 8, wv_);
            break;
        case 5: modulate16_phase((const bf16_t*)Y, P.in[I_GMIX], MODv, 3, 4, (bf16_t*)(ws + O_H), MP, MT, 0, wv_); xcd_barrier(xb);
            is_gemm = true; g.A = (const bf16_t*)(ws + O_H); g.lda = 1024; g.Bt = (const bf16_t*)(ws + O_WIN); g.M = MT; g.N = NINP; g.K = 1024; E.mode = EM_WIN; break;
        case 6: rowpost_phase(P, wv_); break;
        case 7: gmlp_phase(P, lds, wv_); break;
        case 8: is_gemm = true; sync_after = false; g.A = (const bf16_t*)(ws + O_ZS); g.lda = 768; g.Bt = (const bf16_t*)(ws + O_WUQ); g.M = MT; g.N = 768; g.K = 384; E.mode = EM_PLAIN; E.sub = 0; break;
        case 9: is_gemm = true; sync_after = false; g.A = (const bf16_t*)(ws + O_CKV); g.lda = 256; g.Bt = (const bf16_t*)(ws + O_WUK); g.M = MKV; g.N = 512; g.K = 256; E.mode = EM_KNOPE; E.bgate = P.in[I_GKN]; break;
        case 10: is_gemm = true; g.A = (const bf16_t*)(ws + O_WUV); g.lda = 256; g.Bt = (const bf16_t*)(ws + O_CKV); g.M = 512; g.N = MKV; g.K = 256; E.mode = EM_PLAIN; E.sub = 1; break;
        case 11: sync_after = false; break;
        case 12: if (blockIdx.x < 8 && !rerun) { is_gemm = true; g.A = (const bf16_t*)(ws + O_OA) + (size_t)MP * 1024; g.lda = 1024; g.Bt = (const bf16_t*)(ws + O_WBA); g.M = MS; g.N = 1024; g.K = 1024; E.mode = EM_BRA; E.row_off = MP; } break;
        case 13: is_gemm = true; g.A = (const bf16_t*)(ws + O_OA); g.lda = 1024; g.Bt = (const bf16_t*)(ws + O_WBA); g.M = MP; g.N = 1024; g.K = 1024; E.mode = EM_BRA; break;
        case 14: is_gemm = true; g.A = (const bf16_t*)(ws + O_OB); g.lda = 512; g.Bt = (const bf16_t*)(ws + O_WBB); g.M = MT; g.N = 1024; g.K = 512; E.mode = EM_BRB; break;
        case 15: is_gemm = true; g.A = (const bf16_t*)(ws + O_MG); g.lda = 1024; g.Bt = (const bf16_t*)(ws + O_WO); g.M = MP; g.N = 1024; g.K = 1024; E.mode = EM_RESID_B2B; E.gidx = 5; E.coef = 1.0f; break;
        case 16:
            if (blockIdx.x < 8) { is_gemm = true; g.A = (const bf16_t*)(ws + O_MG) + (size_t)MP * 1024; g.lda = 1024; g.Bt = (const bf16_t*)(ws + O_WO); g.M = MS; g.N = 1024; g.K = 1024; E.mode = EM_RESID_B2B; E.gidx = 5; E.coef = 1.0f; E.row_off = MP; }
            else modulate16_phase((const bf16_t*)(ws + O_X2), P.in[I_GFFN2], MODv, 6, 7, (bf16_t*)(ws + O_H), 0, MP, 8, wv_);
            break;
        case 17: modulate16_phase((const bf16_t*)(ws + O_X2), P.in[I_GFFN2], MODv, 6, 7, (bf16_t*)(ws + O_H), MP, MT, 0, wv_);
            {
                const bf16_t* x2s = (const bf16_t*)(ws + O_X2) + (size_t)MP * DM; float* ys = Y + (size_t)MP * DM;
                int t17_; asm volatile("v_mbcnt_lo_u32_b32 %0, -1, 0\n\tv_mbcnt_hi_u32_b32 %0, -1, %0" : "=v"(t17_)); t17_ += 64 * wv_;
                for (size_t i = (size_t)blockIdx.x * 512 + t17_; i < (size_t)MS * DM / 8; i += (size_t)gridDim.x * 512) {
                    const u32x4 w = *(const u32x4*)(x2s + 8 * i);
                    *(f32x4*)(ys + 8 * i) = (f32x4){bflo(w.x), bfhi(w.x), bflo(w.y), bfhi(w.y)}; *(f32x4*)(ys + 8 * i + 4) = (f32x4){bflo(w.z), bfhi(w.z), bflo(w.w), bfhi(w.w)}; }
            }
            xcd_barrier(xb);
            is_gemm = true; g.A = (const bf16_t*)(ws + O_H); g.lda = 1024; g.Bt = (const bf16_t*)(ws + O_W2U); g.M = MT; g.N = 2 * DFF; g.K = 1024; E.mode = EM_SWIGLU; break;
        case 18: is_gemm = true; g.A = (const bf16_t*)(ws + O_ACT); g.lda = DFF; g.Bt = (const bf16_t*)(ws + O_W2D); g.M = MP; g.N = 1024; g.K = DFF; E.mode = EM_RESID_B2F; E.gidx = 8; E.coef = 0.5f; break;
        default: break;
        }
        if (is_gemm) {
            const int npass = (step == 18) ? 2 : 1;
            for (int pass = 0; pass < npass; ++pass) {
                if (g.ldb == 0) g.ldb = g.K;
                int cidx = (int)((blockIdx.x + ((step == 9) ? 64 : (step == 10 ? 128 : 0))) % gridDim.x);
                if (pass == 1) {
                    const int q = (int)blockIdx.x >> 3; const int koff = q == 0 ? 0 : (q == 1 ? 768 : (q == 2 ? 1536 : 2176));
                    g.A = (const bf16_t*)(ws + O_ACT) + (size_t)MP * DFF + koff; g.lda = DFF; g.Bt = (const bf16_t*)(ws + O_W2D) + koff; g.ldb = DFF;
                    g.M = MS; g.N = 1024; g.K = q < 2 ? 768 : 640; E.mode = EM_ATOMIC; E.row_off = MP;
                    cidx = blockIdx.x < 32 ? (int)(blockIdx.x & 7) : (1 << 20);
                }
                pg8::StaticOrder S; S.init(g.M, g.N, (int)gridDim.x, cidx);
#if STAGGER_MODE
                {
                    const unsigned lvl = STAGGER_MODE == 1 ? ((blockIdx.x >> 3) & 31u) : (blockIdx.x & 7u) * 4u;
                    const unsigned long long ticks = (unsigned long long)lvl * (unsigned)(g.K / 64) * 120ull / 32ull;
                    const unsigned long long t0 = wall_clock64();
                    while (wall_clock64() - t0 < ticks) __builtin_amdgcn_s_sleep(8);
                }
#endif
                pg8::gemm_phase<Epi, pg8::StaticOrder, GEMM_ALIGN_EPI, GEMM_SP2>(lds, g, S, E, wv_);
            }
        }
        if (step == 12) attn_phase(P, lds, rerun ? 1 : 0, wv_);
        if ((sync_after || (PROBE_DUP >= 0 && si == PROBE_DUP)) && si + 1 < NPROG) { if (P.ph_lo < 0) grid.sync(); else xcd_barrier(xb); }
    }
}

extern "C" void kernel_launch(void* const* d_in, const int* in_sizes, int n_in, void* d_out, int out_size, void* d_ws, size_t ws_size, hipStream_t stream) {
    static int grid = 0;
    if (grid == 0) {
        if (n_in != 30 || ws_size < WS_END) { fprintf(stderr, "kernel_launch: unexpected n_in %d or ws_size %zu (< %zu)\n", n_in, ws_size, (size_t)WS_END); grid = -1; return; }
        int dev = 0, cus = 0, per_cu = 0;
        hipGetDevice(&dev);
        hipDeviceGetAttribute(&cus, hipDeviceAttributeMultiprocessorCount, dev);
        if (hipFuncSetAttribute((const void*)mk_forward, hipFuncAttributeMaxDynamicSharedMemorySize, LDS_BYTES) != hipSuccess) fprintf(stderr, "kernel_launch: hipFuncSetAttribute failed\n");
        if (hipOccupancyMaxActiveBlocksPerMultiprocessor(&per_cu, (const void*)mk_forward, 512, LDS_BYTES) != hipSuccess || per_cu < 1) fprintf(stderr, "kernel_launch: occupancy query says %d blocks per CU\n", per_cu);
        (void)hipGetLastError();
        grid = cus > 0 ? cus : 256;
    }
    if (grid < 0) return;
    if (hipMemsetAsync((unsigned char*)d_ws + O_BAR, 0, XCD_BAR_WORDS * sizeof(unsigned), stream) != hipSuccess) { fprintf(stderr, "kernel_launch: memset of the barrier words failed\n"); return; }
    Params p{};
    for (int i = 0; i < 30; ++i) p.in[i] = (const float*)d_in[i];
    p.out = (float*)d_out; p.ws = (unsigned char*)d_ws; p.ph_lo = 0; p.ph_hi = NSTEPS;
    void* args[] = {&p};
    hipError_t e = hipLaunchCooperativeKernel((const void*)mk_forward, dim3(grid), dim3(512), args, LDS_BYTES, stream);
    if (e != hipSuccess) fprintf(stderr, "kernel_launch: cooperative launch failed: %s (grid %d)\n", hipGetErrorString(e), grid);
}
```
